# Optimizing an MI355X kernel written in HIP

```python
import math
import jax, jax.numpy as jnp
from jax import lax
import numpy as np

D_MODEL = 1024
BATCH = 8
SEQ = 4096
DEPTH = 1

CHUNK = 64
Q_BLOCK = 128
MEM_TOKENS = 256
D_MIX = D_MODEL
RWKV_HEAD = 64
RWKV_WIDTH = D_MIX // 2
RWKV_HEADS = RWKV_WIDTH // RWKV_HEAD
DECAY_LORA = 64
AAA_LORA = 64
GATE_LORA = 128
RWKV_COLS = 3 * RWKV_WIDTH + DECAY_LORA + AAA_LORA + GATE_LORA
GN_EPS = 64e-5
DIFF_WIDTH = D_MIX - RWKV_WIDTH
DIFF_HEADS = 4
DIFF_VDIM = DIFF_WIDTH // DIFF_HEADS
DIFF_QKDIM = DIFF_VDIM // 2
DIFF_COLS = 3 * DIFF_WIDTH
D_IN_TOTAL = RWKV_COLS + DIFF_COLS
MEM_HEADS = 4
MEM_HEAD_DIM = D_MODEL // MEM_HEADS
D_FF = 4 * D_MODEL
RMS_EPS = 1e-5
NEG_INF = -1e30

kernel_name = "hymba_rwkv7_diffattn_memory_block"


def rms_norm(x, w, eps=RMS_EPS):
    xf = x.astype(jnp.float32)
    y = xf * lax.rsqrt(jnp.mean(jnp.square(xf), axis=-1, keepdims=True) + eps)
    return (y * w.astype(jnp.float32)).astype(x.dtype)


def rwkv7_scan(r, decay, k, v, kk, a):
    B, S, H, N = r.shape
    xs = tuple(jnp.moveaxis(t, 1, 0) for t in (r, decay, k, v, kk, a))

    def step(state, inp):
        r_t, w_t, k_t, v_t, kk_t, a_t = inp
        sa = jnp.einsum("bhvk,bhk->bhv", state, -kk_t)
        state = (state * w_t[:, :, None, :]
                 + sa[..., None] * (kk_t * a_t)[:, :, None, :]
                 + v_t[..., None] * k_t[:, :, None, :])
        y = jnp.einsum("bhvk,bhk->bhv", state, r_t)
        return state, y

    s0 = jnp.zeros((B, H, N, N), jnp.float32)
    _, ys = lax.scan(step, s0, xs)
    return jnp.moveaxis(ys, 0, 1)


def rwkv7_group(p, mu, w0, w_dec_up, a0, a_up, g_up, k_k, k_a, r_k, lnx_w, lnx_b):
    B, S, _ = p.shape
    p_prev = jnp.pad(p, ((0, 0), (1, 0), (0, 0)))[:, :-1]
    p = p + (p_prev - p) * mu
    r, k, v, wd, ad, gd = jnp.split(
        p, [RWKV_WIDTH, 2 * RWKV_WIDTH, 3 * RWKV_WIDTH,
            3 * RWKV_WIDTH + DECAY_LORA, 3 * RWKV_WIDTH + DECAY_LORA + AAA_LORA], axis=-1)
    f32 = jnp.float32
    w_log = -jax.nn.softplus(-(w0 + jnp.tanh(wd) @ w_dec_up)) - 0.5
    decay = jnp.exp(-jnp.exp(w_log.astype(f32)))
    a = jax.nn.sigmoid((a0 + ad @ a_up).astype(f32))
    g = jax.nn.sigmoid(gd) @ g_up
    heads = lambda t: t.astype(f32).reshape(B, S, RWKV_HEADS, RWKV_HEAD)
    kk = heads(k * k_k)
    kk = kk / jnp.maximum(jnp.sqrt(jnp.sum(jnp.square(kk), -1, keepdims=True)), 1e-12)
    k_mod = k.astype(f32) * (1.0 + (a - 1.0) * k_a)
    rh, kh, vh, ah, wh = heads(r), heads(k_mod), heads(v), heads(a), heads(decay)
    y = rwkv7_scan(rh, wh, kh, vh, kk, ah)
    mean = jnp.mean(y, -1, keepdims=True)
    var = jnp.mean(jnp.square(y - mean), -1, keepdims=True)
    y = ((y - mean) * lax.rsqrt(var + GN_EPS)).reshape(B, S, RWKV_WIDTH)
    y = y * lnx_w + lnx_b
    bonus = jnp.sum(rh * kh * r_k, -1, keepdims=True) * vh
    y = y + bonus.reshape(B, S, RWKV_WIDTH)
    return (y * g).astype(p.dtype)


def diff_attn_group(p, lam_q1, lam_k1, lam_q2, lam_k2, subln_w, lam_init):
    B, S, _ = p.shape
    q, k, v = jnp.split(p, [DIFF_WIDTH, 2 * DIFF_WIDTH], axis=-1)
    q = q.reshape(B, S, DIFF_HEADS, 2, DIFF_QKDIM)
    k = k.reshape(B, S, DIFF_HEADS, 2, DIFF_QKDIM)
    v = v.reshape(B, S, DIFF_HEADS, DIFF_VDIM)
    q1, q2 = q[..., 0, :], q[..., 1, :]
    k1, k2 = k[..., 0, :], k[..., 1, :]
    f32 = jnp.float32
    lam = (jnp.exp(jnp.sum(lam_q1 * lam_k1).astype(f32))
           - jnp.exp(jnp.sum(lam_q2 * lam_k2).astype(f32)) + lam_init)
    scale = DIFF_QKDIM ** -0.5
    outs = []
    for qb in range(S // Q_BLOCK):
        qs, qe = qb * Q_BLOCK, (qb + 1) * Q_BLOCK
        mask = (jnp.arange(qe) // CHUNK)[None, :] <= (jnp.arange(qs, qe) // CHUNK)[:, None]
        s1 = jnp.einsum("bqhd,bkhd->bhqk", q1[:, qs:qe], k1[:, :qe]).astype(f32) * scale
        s2 = jnp.einsum("bqhd,bkhd->bhqk", q2[:, qs:qe], k2[:, :qe]).astype(f32) * scale
        p1 = jax.nn.softmax(jnp.where(mask, s1, NEG_INF), axis=-1)
        p2 = jax.nn.softmax(jnp.where(mask, s2, NEG_INF), axis=-1)
        attn = (p1 - lam * p2).astype(v.dtype)
        outs.append(jnp.einsum("bhqk,bkhd->bqhd", attn, v[:, :qe]))
    o = jnp.concatenate(outs, axis=1)
    o = rms_norm(o, subln_w) * (1.0 - lam_init)
    return o.reshape(B, S, DIFF_WIDTH)


def memory_cross_attn(hn, memn, w_mq, w_mk, w_mv, w_mo):
    B, S, _ = hn.shape
    M = memn.shape[1]
    q = (hn @ w_mq).reshape(B, S, MEM_HEADS, MEM_HEAD_DIM)
    k = (memn @ w_mk).reshape(B, M, MEM_HEADS, MEM_HEAD_DIM)
    v = (memn @ w_mv).reshape(B, M, MEM_HEADS, MEM_HEAD_DIM)
    s = jnp.einsum("bshd,bmhd->bhsm", q, k).astype(jnp.float32) * (MEM_HEAD_DIM ** -0.5)
    pr = jax.nn.softmax(s, axis=-1).astype(v.dtype)
    o = jnp.einsum("bhsm,bmhd->bshd", pr, v).reshape(B, S, D_MODEL)
    return o @ w_mo


def setup_inputs(seed: int = 0) -> dict:
    key = jax.random.key(seed)
    ks = jax.random.split(key, 32)
    f32 = jnp.float32
    nrm = lambda k, shape, s: jax.random.normal(k, shape, f32) * s
    L = DEPTH
    return {
        "x": nrm(ks[0], (BATCH, SEQ, D_MODEL), 1.0),
        "mem": nrm(ks[1], (BATCH, MEM_TOKENS, D_MODEL), 1.0),
        "norm_mix_w": 1.0 + nrm(ks[2], (L, D_MODEL), 0.05),
        "w_in": nrm(ks[3], (L, D_MODEL, D_IN_TOTAL), D_MODEL ** -0.5),
        "mu_shift": jax.random.uniform(ks[4], (L, RWKV_COLS), f32),
        "w_decay0": jnp.linspace(-6.0, -1.0, RWKV_WIDTH, dtype=f32)[None] + nrm(ks[5], (L, RWKV_WIDTH), 0.1),
        "w_decay_up": nrm(ks[6], (L, DECAY_LORA, RWKV_WIDTH), 0.1),
        "a0": nrm(ks[7], (L, RWKV_WIDTH), 0.1),
        "a_up": nrm(ks[8], (L, AAA_LORA, RWKV_WIDTH), AAA_LORA ** -0.5),
        "g_up": nrm(ks[9], (L, GATE_LORA, RWKV_WIDTH), GATE_LORA ** -0.5),
        "k_k": 0.85 + nrm(ks[10], (L, RWKV_WIDTH), 0.05),
        "k_a": 1.0 + nrm(ks[11], (L, RWKV_WIDTH), 0.05),
        "r_k": nrm(ks[12], (L, RWKV_HEADS, RWKV_HEAD), 0.1),
        "lnx_w": 1.0 + nrm(ks[13], (L, RWKV_WIDTH), 0.05),
        "lnx_b": nrm(ks[14], (L, RWKV_WIDTH), 0.02),
        "lam_q1": nrm(ks[15], (L, DIFF_QKDIM), 0.1),
        "lam_k1": nrm(ks[16], (L, DIFF_QKDIM), 0.1),
        "lam_q2": nrm(ks[17], (L, DIFF_QKDIM), 0.1),
        "lam_k2": nrm(ks[18], (L, DIFF_QKDIM), 0.1),
        "subln_w": 1.0 + nrm(ks[19], (L, DIFF_VDIM), 0.05),
        "w_out": nrm(ks[20], (L, D_MIX, D_MODEL), D_MIX ** -0.5),
        "norm_mem_w": 1.0 + nrm(ks[21], (L, D_MODEL), 0.05),
        "norm_src_w": 1.0 + nrm(ks[22], (L, D_MODEL), 0.05),
        "w_mq": nrm(ks[23], (L, D_MODEL, D_MODEL), D_MODEL ** -0.5),
        "w_mk": nrm(ks[24], (L, D_MODEL, D_MODEL), D_MODEL ** -0.5),
        "w_mv": nrm(ks[25], (L, D_MODEL, D_MODEL), D_MODEL ** -0.5),
        "w_mo": nrm(ks[26], (L, D_MODEL, D_MODEL), D_MODEL ** -0.5),
        "norm_mlp_w": 1.0 + nrm(ks[27], (L, D_MODEL), 0.05),
        "w_up": nrm(ks[28], (L, D_MODEL, D_FF), D_MODEL ** -0.5),
        "w_down": nrm(ks[29], (L, D_FF, D_MODEL), D_FF ** -0.5),
        "norm_final_w": 1.0 + nrm(ks[30], (D_MODEL,), 0.05),
    }


def reference(x, mem, norm_mix_w, w_in, mu_shift, w_decay0, w_decay_up, a0, a_up, g_up,
              k_k, k_a, r_k, lnx_w, lnx_b, lam_q1, lam_k1, lam_q2, lam_k2, subln_w, w_out,
              norm_mem_w, norm_src_w, w_mq, w_mk, w_mv, w_mo, norm_mlp_w, w_up, w_down,
              norm_final_w):
    h = x
    for l in range(DEPTH):
        lam_init = 0.8 - 0.6 * math.exp(-0.3 * l)
        proj = rms_norm(h, norm_mix_w[l]) @ w_in[l]
        p_rwkv, p_diff = proj[..., :RWKV_COLS], proj[..., RWKV_COLS:]
        y_rwkv = rwkv7_group(p_rwkv, mu_shift[l], w_decay0[l], w_decay_up[l], a0[l], a_up[l],
                             g_up[l], k_k[l], k_a[l], r_k[l], lnx_w[l], lnx_b[l])
        y_diff = diff_attn_group(p_diff, lam_q1[l], lam_k1[l], lam_q2[l], lam_k2[l],
                                 subln_w[l], lam_init)
        h = h + jnp.concatenate([y_rwkv, y_diff], axis=-1) @ w_out[l]
        h = h + memory_cross_attn(rms_norm(h, norm_mem_w[l]), rms_norm(mem, norm_src_w[l]),
                                  w_mq[l], w_mk[l], w_mv[l], w_mo[l])
        hn = rms_norm(h, norm_mlp_w[l])
        h = h + jnp.square(jax.nn.relu(hn @ w_up[l])) @ w_down[l]
    return rms_norm(h, norm_final_w)
```

```cpp
#include <hip/hip_runtime.h>
#include <hip/hip_cooperative_groups.h>
#include <cstdio>
namespace cg = cooperative_groups;

#define DI __device__ __forceinline__
typedef unsigned short u16;
using bf16x8 = __attribute__((ext_vector_type(8))) short;
using f32x4 = __attribute__((ext_vector_type(4))) float;
using u16x4 = __attribute__((ext_vector_type(4))) unsigned short;

constexpr int T_TOK = 32768, SEQ = 4096, DM = 1024;
constexpr long MiB = 1024L * 1024L;

DI u16 f2bf(float x) { unsigned u = __float_as_uint(x); u += 0x7fffu + ((u >> 16) & 1u); return (u16)(u >> 16); }
DI float bf2f(u16 h) { return __uint_as_float(((unsigned)h) << 16); }
DI float wave_sum(float v) {
#pragma unroll
  for (int o = 32; o > 0; o >>= 1) v += __shfl_xor(v, o);
  return v;
}
DI f32x4 mfma16(bf16x8 a, bf16x8 b, f32x4 c) { return __builtin_amdgcn_mfma_f32_16x16x32_bf16(a, b, c, 0, 0, 0); }
DI u16x4 pack4(f32x4 v) { u16x4 r; r[0] = f2bf(v[0]); r[1] = f2bf(v[1]); r[2] = f2bf(v[2]); r[3] = f2bf(v[3]); return r; }

struct Params {
  const float *x, *mem, *norm_mix_w, *w_in, *mu, *w0, *w_dec_up, *a0, *a_up, *g_up, *k_k, *k_a, *r_k, *lnx_w, *lnx_b;
  const float *lam_q1, *lam_k1, *lam_q2, *lam_k2, *subln_w, *w_out, *norm_mem_w, *norm_src_w, *w_mq, *w_mk, *w_mv, *w_mo;
  const float *norm_mlp_w, *w_up, *w_down, *norm_final_w;
  float* out;
  u16 *wt_in, *wt_out, *wt_mq, *wt_mk, *wt_mv, *wt_mo, *wt_up, *wt_down, *wt_dec, *wt_a, *wt_g;
  u16 *xn, *pr, *qkd, *vt, *hid, *mix, *qmem, *memn, *kmem, *vtmem, *lora_in;
  float* e_buf; u16 *asig, *gbuf;
};

DI void transpose_w(const float* __restrict__ W, u16* __restrict__ Wt, int K, int N, int bid, int nb, char* smem) {
  float(*tile)[65] = (float(*)[65])smem;
  const int tid = threadIdx.x;
  const int tn = N / 64, nt = (K / 64) * tn;
  for (int t = bid; t < nt; t += nb) {
    const int k0 = (t / tn) * 64, n0 = (t % tn) * 64;
#pragma unroll
    for (int i = 0; i < 4; ++i) {
      const int r = (tid >> 4) + i * 16, c = (tid & 15) * 4;
      const float4 v = *(const float4*)(W + (long)(k0 + r) * N + n0 + c);
      tile[r][c] = v.x; tile[r][c + 1] = v.y; tile[r][c + 2] = v.z; tile[r][c + 3] = v.w;
    }
    __syncthreads();
#pragma unroll
    for (int i = 0; i < 2; ++i) {
      const int c = tid + i * 256, n = c >> 3, kk = (c & 7) * 8;
      uint4 o;
      o.x = f2bf(tile[kk][n]) | ((unsigned)f2bf(tile[kk + 1][n]) << 16);
      o.y = f2bf(tile[kk + 2][n]) | ((unsigned)f2bf(tile[kk + 3][n]) << 16);
      o.z = f2bf(tile[kk + 4][n]) | ((unsigned)f2bf(tile[kk + 5][n]) << 16);
      o.w = f2bf(tile[kk + 6][n]) | ((unsigned)f2bf(tile[kk + 7][n]) << 16);
      *(uint4*)(Wt + (long)(n0 + n) * K + k0 + kk) = o;
    }
    __syncthreads();
  }
}

template <bool BF>
DI void rmsnorm_phase(const float* in, const float* __restrict__ w, void* outp, int rows, int bid, int nb) {
  const int lane = threadIdx.x & 63;
  const int wave = bid * 4 + (threadIdx.x >> 6), nw = nb * 4;
  for (int row = wave; row < rows; row += nw) {
    const float4* p = (const float4*)(in + (long)row * 1024);
    float4 v[4];
    float ss = 0.f;
#pragma unroll
    for (int i = 0; i < 4; ++i) {
      v[i] = p[lane + i * 64];
      ss += v[i].x * v[i].x + v[i].y * v[i].y + v[i].z * v[i].z + v[i].w * v[i].w;
    }
    ss = wave_sum(ss);
    const float rs = rsqrtf(ss * (1.f / 1024.f) + 1e-5f);
#pragma unroll
    for (int i = 0; i < 4; ++i) {
      const float4 wv = ((const float4*)w)[lane + i * 64];
      f32x4 y;
      y[0] = v[i].x * rs * wv.x; y[1] = v[i].y * rs * wv.y; y[2] = v[i].z * rs * wv.z; y[3] = v[i].w * rs * wv.w;
      if (BF) {
        *(u16x4*)((u16*)outp + (long)row * 1024 + (lane + i * 64) * 4) = pack4(y);
      } else {
        *(f32x4*)((float*)outp + (long)row * 1024 + (lane + i * 64) * 4) = y;
      }
    }
  }
}

constexpr int GBM = 128, GBN = 128, GBK = 64, GLD = 72;
template <class Epi>
DI void gemm_phase(const u16* __restrict__ A, int lda, const u16* __restrict__ Bt, int ldb, int M, int N, int K, Epi epi,
                   int bid, int nb, char* smem) {
  u16* sA = (u16*)smem;
  u16* sB = sA + 2 * GBM * GLD;
  const int tid = threadIdx.x, lane = tid & 63, wid = tid >> 6, wr = wid >> 1, wc = wid & 1;
  const int fr = lane & 15, fq = lane >> 4;
  const int ntn = N / GBN, ntiles = (M / GBM) * ntn, nk = K / GBK;
  const int lrow = tid >> 3, lkc = (tid & 7) * 8;
  for (int tile = bid; tile < ntiles; tile += nb) {
    const int tm = tile / ntn, tn = tile % ntn;
    const u16* Ag = A + (long)(tm * GBM + lrow) * lda + lkc;
    const u16* Bg = Bt + (long)(tn * GBN + lrow) * ldb + lkc;
    f32x4 acc[4][4];
#pragma unroll
    for (int m = 0; m < 4; ++m)
#pragma unroll
      for (int n = 0; n < 4; ++n) acc[m][n] = (f32x4){0.f, 0.f, 0.f, 0.f};
    uint4 ra[4], rb[4];
#pragma unroll
    for (int i = 0; i < 4; ++i) {
      ra[i] = *(const uint4*)(Ag + (long)(i * 32) * lda);
      rb[i] = *(const uint4*)(Bg + (long)(i * 32) * ldb);
    }
#pragma unroll
    for (int i = 0; i < 4; ++i) {
      *(uint4*)(sA + (lrow + i * 32) * GLD + lkc) = ra[i];
      *(uint4*)(sB + (lrow + i * 32) * GLD + lkc) = rb[i];
    }
    __syncthreads();
    for (int kt = 0; kt < nk; ++kt) {
      if (kt + 1 < nk) {
#pragma unroll
        for (int i = 0; i < 4; ++i) {
          ra[i] = *(const uint4*)(Ag + (long)(i * 32) * lda + (kt + 1) * GBK);
          rb[i] = *(const uint4*)(Bg + (long)(i * 32) * ldb + (kt + 1) * GBK);
        }
      }
      const u16* a_s = sA + (kt & 1) * GBM * GLD;
      const u16* b_s = sB + (kt & 1) * GBN * GLD;
#pragma unroll
      for (int ks = 0; ks < 2; ++ks) {
        bf16x8 af[4], bfr[4];
#pragma unroll
        for (int m = 0; m < 4; ++m) af[m] = *(const bf16x8*)(a_s + (wr * 64 + m * 16 + fr) * GLD + ks * 32 + fq * 8);
#pragma unroll
        for (int n = 0; n < 4; ++n) bfr[n] = *(const bf16x8*)(b_s + (wc * 64 + n * 16 + fr) * GLD + ks * 32 + fq * 8);
#pragma unroll
        for (int m = 0; m < 4; ++m)
#pragma unroll
          for (int n = 0; n < 4; ++n) acc[m][n] = mfma16(bfr[n], af[m], acc[m][n]);
      }
      if (kt + 1 < nk) {
        u16* a_d = sA + ((kt + 1) & 1) * GBM * GLD;
        u16* b_d = sB + ((kt + 1) & 1) * GBN * GLD;
#pragma unroll
        for (int i = 0; i < 4; ++i) {
          *(uint4*)(a_d + (lrow + i * 32) * GLD + lkc) = ra[i];
          *(uint4*)(b_d + (lrow + i * 32) * GLD + lkc) = rb[i];
        }
      }
      __syncthreads();
    }
#pragma unroll
    for (int m = 0; m < 4; ++m)
#pragma unroll
      for (int n = 0; n < 4; ++n)
        epi(tm * GBM + wr * 64 + m * 16 + fr, tn * GBN + wc * 64 + n * 16 + fq * 4, acc[m][n]);
  }
}

struct EpiWin {
  u16 *pr, *qkd, *vt;
  DI void operator()(int row, int col, f32x4 v) const {
    if (col < 1792) {
      *(u16x4*)(pr + (long)row * 1792 + col) = pack4(v);
    } else if (col < 2816) {
      *(u16x4*)(qkd + (long)row * 1024 + (col - 1792)) = pack4(v);
    } else {
      const int b = row >> 12, s = row & 4095, c = col - 2816;
#pragma unroll
      for (int j = 0; j < 4; ++j) vt[((long)(b * 512 + c + j)) * 4096 + s] = f2bf(v[j]);
    }
  }
};
struct EpiBf16 {
  u16* o; int ld;
  DI void operator()(int row, int col, f32x4 v) const { *(u16x4*)(o + (long)row * ld + col) = pack4(v); }
};
struct EpiVtMem {
  u16* o;
  DI void operator()(int row, int col, f32x4 v) const {
    const int b = row >> 8, m = row & 255;
#pragma unroll
    for (int j = 0; j < 4; ++j) o[((long)(b * 1024 + col + j)) * 256 + m] = f2bf(v[j]);
  }
};
struct EpiDecay {
  float* e; const float* w0;
  DI void operator()(int row, int col, f32x4 v) const {
    f32x4 r;
#pragma unroll
    for (int j = 0; j < 4; ++j) {
      const float z = -(w0[col + j] + v[j]);
      const float sp = fmaxf(z, 0.f) + log1pf(__expf(-fabsf(z)));
      r[j] = __expf(-sp - 0.5f);
    }
    *(f32x4*)(e + (long)row * 512 + col) = r;
  }
};
struct EpiASig {
  u16* o; const float* a0;
  DI void operator()(int row, int col, f32x4 v) const {
    f32x4 r;
#pragma unroll
    for (int j = 0; j < 4; ++j) r[j] = 1.f / (1.f + __expf(-(a0[col + j] + v[j])));
    *(u16x4*)(o + (long)row * 512 + col) = pack4(r);
  }
};
struct EpiResX {
  float* h; const float* x;
  DI void operator()(int row, int col, f32x4 v) const {
    const f32x4 xv = *(const f32x4*)(x + (long)row * 1024 + col);
    *(f32x4*)(h + (long)row * 1024 + col) = xv + v;
  }
};
struct EpiResAcc {
  float* h;
  DI void operator()(int row, int col, f32x4 v) const {
    f32x4* p = (f32x4*)(h + (long)row * 1024 + col);
    *p = *p + v;
  }
};
struct EpiRelu2 {
  u16* o;
  DI void operator()(int row, int col, f32x4 v) const {
    f32x4 r;
#pragma unroll
    for (int j = 0; j < 4; ++j) { const float t = fmaxf(v[j], 0.f); r[j] = t * t; }
    *(u16x4*)(o + (long)row * 4096 + col) = pack4(r);
  }
};

DI void rwkv_prep_phase(const Params& p, int bid, int nb) {
  const long total = (long)T_TOK * 256;
  for (long idx = (long)bid * 256 + threadIdx.x; idx < total; idx += (long)nb * 256) {
    const int t = (int)(idx >> 8), c = (int)(idx & 255);
    const float v = bf2f(p.pr[(long)t * 1792 + 1536 + c]);
    const float pv = (t & 4095) ? bf2f(p.pr[(long)(t - 1) * 1792 + 1536 + c]) : 0.f;
    const float xx = v + (pv - v) * p.mu[1536 + c];
    float y;
    if (c < 64) y = tanhf(xx);
    else if (c < 128) y = xx;
    else y = 1.f / (1.f + __expf(-xx));
    p.lora_in[idx] = f2bf(y);
  }
}

DI void rwkv_scan_seq(const Params& p, int bh, float* sh) {
  const int lane = threadIdx.x & 63;
  const int b = bh >> 3, h = bh & 7, c = h * 64 + lane;
  const float mu_r = p.mu[c], mu_k = p.mu[512 + c], mu_v = p.mu[1024 + c];
  const float kk_w = p.k_k[c], ka_w = p.k_a[c], rk_w = p.r_k[c], lw = p.lnx_w[c], lb = p.lnx_b[c];
  float st[64];
#pragma unroll
  for (int i = 0; i < 64; ++i) st[i] = 0.f;
  float rp = 0.f, kp = 0.f, vp = 0.f;
  const long tok0 = (long)b * 4096;
  u16 nr = p.pr[tok0 * 1792 + c], nk = p.pr[tok0 * 1792 + 512 + c], nv = p.pr[tok0 * 1792 + 1024 + c];
  float ne = p.e_buf[tok0 * 512 + c];
  u16 na = p.asig[tok0 * 512 + c], ng = p.gbuf[tok0 * 512 + c];
  for (int t = 0; t < 4096; ++t) {
    const float r0 = bf2f(nr), k0 = bf2f(nk), v0 = bf2f(nv), e = ne, a = bf2f(na), g = bf2f(ng);
    if (t + 1 < 4096) {
      const long tk = tok0 + t + 1;
      nr = p.pr[tk * 1792 + c]; nk = p.pr[tk * 1792 + 512 + c]; nv = p.pr[tk * 1792 + 1024 + c];
      ne = p.e_buf[tk * 512 + c]; na = p.asig[tk * 512 + c]; ng = p.gbuf[tk * 512 + c];
    }
    const float r = r0 + (rp - r0) * mu_r, k = k0 + (kp - k0) * mu_k, v = v0 + (vp - v0) * mu_v;
    rp = r0; kp = k0; vp = v0;
    const float w = __expf(-e);
    const float kkv = k * kk_w;
    const float n2 = wave_sum(kkv * kkv);
    const float kk = kkv / fmaxf(sqrtf(n2), 1e-12f);
    const float kmod = k * (1.f + (a - 1.f) * ka_w);
    const float bb = kk * a;
    __syncthreads();
    sh[lane] = w; sh[64 + lane] = kk; sh[128 + lane] = bb; sh[192 + lane] = kmod; sh[256 + lane] = r;
    __syncthreads();
    float sa = 0.f;
#pragma unroll
    for (int q = 0; q < 16; ++q) {
      const float4 k4 = *(const float4*)(sh + 64 + q * 4);
      sa += st[q * 4] * k4.x + st[q * 4 + 1] * k4.y + st[q * 4 + 2] * k4.z + st[q * 4 + 3] * k4.w;
      asm volatile("" : "+v"(sa) :: "memory");
    }
    sa = -sa;
    float y = 0.f;
#pragma unroll
    for (int q = 0; q < 16; ++q) {
      const float4 w4 = *(const float4*)(sh + q * 4);
      const float4 b4 = *(const float4*)(sh + 128 + q * 4);
      const float4 m4 = *(const float4*)(sh + 192 + q * 4);
      const float4 r4 = *(const float4*)(sh + 256 + q * 4);
      st[q * 4] = st[q * 4] * w4.x + sa * b4.x + v * m4.x; y += st[q * 4] * r4.x;
      st[q * 4 + 1] = st[q * 4 + 1] * w4.y + sa * b4.y + v * m4.y; y += st[q * 4 + 1] * r4.y;
      st[q * 4 + 2] = st[q * 4 + 2] * w4.z + sa * b4.z + v * m4.z; y += st[q * 4 + 2] * r4.z;
      st[q * 4 + 3] = st[q * 4 + 3] * w4.w + sa * b4.w + v * m4.w; y += st[q * 4 + 3] * r4.w;
      asm volatile("" : "+v"(y) :: "memory");
    }
    const float mean = wave_sum(y) * (1.f / 64.f);
    const float d = y - mean;
    const float var = wave_sum(d * d) * (1.f / 64.f);
    const float yn = d * rsqrtf(var + 64e-5f) * lw + lb;
    const float bonus = wave_sum(r * kmod * rk_w) * v;
    p.mix[(tok0 + t) * 1024 + c] = f2bf((yn + bonus) * g);
  }
}

template <int DQK, int DV, int NMAP, bool DIFF>
DI void attn_tile(const u16* __restrict__ Q, long q_stride, const u16* __restrict__ Kg, long k_stride,
                  const u16* __restrict__ Vtg, long vt_stride, int nkt, float scale, u16* __restrict__ Out, long o_stride,
                  float lam, const float* __restrict__ subw, char* smem) {
  constexpr int KW = NMAP * DQK, KLD = KW + 8, VLD = 72;
  u16* Ks = (u16*)smem;
  u16* Vs = Ks + 64 * KLD;
  const int tid = threadIdx.x, lane = tid & 63, wid = tid >> 6, fr = lane & 15, fq = lane >> 4;
  bf16x8 qf[NMAP][DQK / 32];
#pragma unroll
  for (int m = 0; m < NMAP; ++m)
#pragma unroll
    for (int ks = 0; ks < DQK / 32; ++ks)
      qf[m][ks] = *(const bf16x8*)(Q + (long)(wid * 16 + fr) * q_stride + m * DQK + ks * 32 + fq * 8);
  f32x4 o[NMAP][DV / 16];
  float mrun[NMAP], lrun[NMAP];
#pragma unroll
  for (int m = 0; m < NMAP; ++m) {
    mrun[m] = -1e30f; lrun[m] = 0.f;
#pragma unroll
    for (int dt = 0; dt < DV / 16; ++dt) o[m][dt] = (f32x4){0.f, 0.f, 0.f, 0.f};
  }
  for (int kt = 0; kt < nkt; ++kt) {
    __syncthreads();
    for (int c = tid; c < 64 * (KW / 8); c += 256) {
      const int row = c / (KW / 8), cc = (c % (KW / 8)) * 8;
      *(uint4*)(Ks + row * KLD + cc) = *(const uint4*)(Kg + (long)(kt * 64 + row) * k_stride + cc);
    }
    for (int c = tid; c < DV * 8; c += 256) {
      const int row = c >> 3, cc = (c & 7) * 8;
      *(uint4*)(Vs + row * VLD + cc) = *(const uint4*)(Vtg + (long)row * vt_stride + kt * 64 + cc);
    }
    __syncthreads();
#pragma unroll
    for (int m = 0; m < NMAP; ++m) {
      f32x4 s[4];
#pragma unroll
      for (int c = 0; c < 4; ++c) {
        s[c] = (f32x4){0.f, 0.f, 0.f, 0.f};
#pragma unroll
        for (int ks = 0; ks < DQK / 32; ++ks) {
          const bf16x8 kf = *(const bf16x8*)(Ks + (c * 16 + fr) * KLD + m * DQK + ks * 32 + fq * 8);
          s[c] = mfma16(kf, qf[m][ks], s[c]);
        }
      }
      float mx = -1e30f;
#pragma unroll
      for (int c = 0; c < 4; ++c)
#pragma unroll
        for (int j = 0; j < 4; ++j) mx = fmaxf(mx, s[c][j]);
      mx = fmaxf(mx, __shfl_xor(mx, 16));
      mx = fmaxf(mx, __shfl_xor(mx, 32));
      mx *= scale;
      const float mnew = fmaxf(mrun[m], mx);
      const float alpha = __expf(mrun[m] - mnew);
      mrun[m] = mnew;
      float psum = 0.f;
#pragma unroll
      for (int c = 0; c < 4; ++c)
#pragma unroll
        for (int j = 0; j < 4; ++j) { s[c][j] = __expf(s[c][j] * scale - mnew); psum += s[c][j]; }
      lrun[m] = lrun[m] * alpha + psum;
#pragma unroll
      for (int dt = 0; dt < DV / 16; ++dt) o[m][dt] *= alpha;
#pragma unroll
      for (int k2 = 0; k2 < 2; ++k2) {
        bf16x8 pb;
#pragma unroll
        for (int j = 0; j < 4; ++j) { pb[j] = (short)f2bf(s[2 * k2][j]); pb[4 + j] = (short)f2bf(s[2 * k2 + 1][j]); }
#pragma unroll
        for (int dt = 0; dt < DV / 16; ++dt) {
          const u16x4 lo = *(const u16x4*)(Vs + (dt * 16 + fr) * VLD + k2 * 32 + fq * 4);
          const u16x4 hi = *(const u16x4*)(Vs + (dt * 16 + fr) * VLD + k2 * 32 + 16 + fq * 4);
          bf16x8 vf;
#pragma unroll
          for (int j = 0; j < 4; ++j) { vf[j] = (short)lo[j]; vf[4 + j] = (short)hi[j]; }
          o[m][dt] = mfma16(vf, pb, o[m][dt]);
        }
      }
    }
  }
  float linv[NMAP];
#pragma unroll
  for (int m = 0; m < NMAP; ++m) {
    float l = lrun[m];
    l += __shfl_xor(l, 16);
    l += __shfl_xor(l, 32);
    linv[m] = 1.f / l;
  }
  u16* orow = Out + (long)(wid * 16 + fr) * o_stride;
  if (DIFF) {
    float ss = 0.f;
#pragma unroll
    for (int dt = 0; dt < DV / 16; ++dt)
#pragma unroll
      for (int j = 0; j < 4; ++j) {
        const float val = o[0][dt][j] * linv[0] - lam * o[NMAP - 1][dt][j] * linv[NMAP - 1];
        o[0][dt][j] = val;
        ss += val * val;
      }
    ss += __shfl_xor(ss, 16);
    ss += __shfl_xor(ss, 32);
    const float rstd = rsqrtf(ss * (1.f / DV) + 1e-5f) * 0.8f;
#pragma unroll
    for (int dt = 0; dt < DV / 16; ++dt) {
      f32x4 r;
#pragma unroll
      for (int j = 0; j < 4; ++j) r[j] = o[0][dt][j] * rstd * subw[dt * 16 + fq * 4 + j];
      *(u16x4*)(orow + dt * 16 + fq * 4) = pack4(r);
    }
  } else {
#pragma unroll
    for (int dt = 0; dt < DV / 16; ++dt) {
      f32x4 r = o[0][dt] * linv[0];
      *(u16x4*)(orow + dt * 16 + fq * 4) = pack4(r);
    }
  }
}

constexpr int SMEM_BYTES = 80 * 1024;

__global__ void __launch_bounds__(256, 2) fwd_megakernel(Params p) {
  cg::grid_group grid = cg::this_grid();
  __shared__ __attribute__((aligned(16))) char smem[SMEM_BYTES];
  const int bid = blockIdx.x, nb = gridDim.x;

  transpose_w(p.w_in, p.wt_in, 1024, 3328, bid, nb, smem);
  transpose_w(p.w_out, p.wt_out, 1024, 1024, bid, nb, smem);
  transpose_w(p.w_mq, p.wt_mq, 1024, 1024, bid, nb, smem);
  transpose_w(p.w_mk, p.wt_mk, 1024, 1024, bid, nb, smem);
  transpose_w(p.w_mv, p.wt_mv, 1024, 1024, bid, nb, smem);
  transpose_w(p.w_mo, p.wt_mo, 1024, 1024, bid, nb, smem);
  transpose_w(p.w_up, p.wt_up, 1024, 4096, bid, nb, smem);
  transpose_w(p.w_down, p.wt_down, 4096, 1024, bid, nb, smem);
  transpose_w(p.w_dec_up, p.wt_dec, 64, 512, bid, nb, smem);
  transpose_w(p.a_up, p.wt_a, 64, 512, bid, nb, smem);
  transpose_w(p.g_up, p.wt_g, 128, 512, bid, nb, smem);
  rmsnorm_phase<true>(p.x, p.norm_mix_w, p.xn, T_TOK, bid, nb);
  rmsnorm_phase<true>(p.mem, p.norm_src_w, p.memn, 2048, bid, nb);
  grid.sync();

  gemm_phase(p.xn, 1024, p.wt_in, 1024, T_TOK, 3328, 1024, EpiWin{p.pr, p.qkd, p.vt}, bid, nb, smem);
  gemm_phase(p.memn, 1024, p.wt_mk, 1024, 2048, 1024, 1024, EpiBf16{p.kmem, 1024}, bid, nb, smem);
  gemm_phase(p.memn, 1024, p.wt_mv, 1024, 2048, 1024, 1024, EpiVtMem{p.vtmem}, bid, nb, smem);
  grid.sync();

  rwkv_prep_phase(p, bid, nb);
  grid.sync();

  gemm_phase(p.lora_in, 256, p.wt_dec, 64, T_TOK, 512, 64, EpiDecay{p.e_buf, p.w0}, bid, nb, smem);
  gemm_phase(p.lora_in + 64, 256, p.wt_a, 64, T_TOK, 512, 64, EpiASig{p.asig, p.a0}, bid, nb, smem);
  gemm_phase(p.lora_in + 128, 256, p.wt_g, 128, T_TOK, 512, 128, EpiBf16{p.gbuf, 512}, bid, nb, smem);
  grid.sync();

  if (bid < 16) {
    rwkv_scan_seq(p, bid * 4 + (threadIdx.x >> 6), (float*)smem + (threadIdx.x >> 6) * 320);
  } else {
    float d1 = 0.f, d2 = 0.f;
    for (int i = 0; i < 64; ++i) { d1 += p.lam_q1[i] * p.lam_k1[i]; d2 += p.lam_q2[i] * p.lam_k2[i]; }
    const float lam = __expf(d1) - __expf(d2) + 0.2f;
    for (int idx = bid - 16; idx < 2048; idx += nb - 16) {
      const int qc = 63 - (idx >> 5), bh = idx & 31, b = bh >> 2, h = bh & 3;
      const long tq = (long)b * 4096 + qc * 64;
      attn_tile<64, 128, 2, true>(p.qkd + tq * 1024 + h * 128, 1024, p.qkd + (long)b * 4096 * 1024 + 512 + h * 128, 1024,
                                  p.vt + (long)(b * 512 + h * 128) * 4096, 4096, qc + 1, 0.125f,
                                  p.mix + tq * 1024 + 512 + h * 128, 1024, lam, p.subln_w, smem);
    }
  }
  grid.sync();

  gemm_phase(p.mix, 1024, p.wt_out, 1024, T_TOK, 1024, 1024, EpiResX{p.out, p.x}, bid, nb, smem);
  grid.sync();
  rmsnorm_phase<true>(p.out, p.norm_mem_w, p.xn, T_TOK, bid, nb);
  grid.sync();
  gemm_phase(p.xn, 1024, p.wt_mq, 1024, T_TOK, 1024, 1024, EpiBf16{p.qmem, 1024}, bid, nb, smem);
  grid.sync();
  for (int idx = bid; idx < 2048; idx += nb) {
    const int tt = idx >> 2, h = idx & 3;
    const long t0 = (long)tt * 64;
    const int b = (int)(t0 >> 12);
    attn_tile<256, 256, 1, false>(p.qmem + t0 * 1024 + h * 256, 1024, p.kmem + (long)b * 256 * 1024 + h * 256, 1024,
                                  p.vtmem + (long)(b * 1024 + h * 256) * 256, 256, 4, 0.0625f,
                                  p.mix + t0 * 1024 + h * 256, 1024, 0.f, p.subln_w, smem);
  }
  grid.sync();
  gemm_phase(p.mix, 1024, p.wt_mo, 1024, T_TOK, 1024, 1024, EpiResAcc{p.out}, bid, nb, smem);
  grid.sync();
  rmsnorm_phase<true>(p.out, p.norm_mlp_w, p.xn, T_TOK, bid, nb);
  grid.sync();
  gemm_phase(p.xn, 1024, p.wt_up, 1024, T_TOK, 4096, 1024, EpiRelu2{p.hid}, bid, nb, smem);
  grid.sync();
  gemm_phase(p.hid, 4096, p.wt_down, 4096, T_TOK, 1024, 4096, EpiResAcc{p.out}, bid, nb, smem);
  grid.sync();
  rmsnorm_phase<false>(p.out, p.norm_final_w, p.out, T_TOK, bid, nb);
}

extern "C" void kernel_launch(void* const* d_in, const int* in_sizes, int n_in, void* d_out, int out_size, void* d_ws,
                              size_t ws_size, hipStream_t stream) {
  static int grid_blocks = 0;
  if (!grid_blocks) {
    int dev = 0, cus = 0, per_cu = 0;
    hipGetDevice(&dev);
    hipDeviceGetAttribute(&cus, hipDeviceAttributeMultiprocessorCount, dev);
    hipOccupancyMaxActiveBlocksPerMultiprocessor(&per_cu, fwd_megakernel, 256, 0);
    if (per_cu > 2) per_cu = 2;
    if (per_cu < 1) per_cu = 1;
    grid_blocks = cus * per_cu;
  }
  Params p{};
  const float* const* in = (const float* const*)d_in;
  p.x = in[0]; p.mem = in[1]; p.norm_mix_w = in[2]; p.w_in = in[3]; p.mu = in[4]; p.w0 = in[5]; p.w_dec_up = in[6];
  p.a0 = in[7]; p.a_up = in[8]; p.g_up = in[9]; p.k_k = in[10]; p.k_a = in[11]; p.r_k = in[12]; p.lnx_w = in[13];
  p.lnx_b = in[14]; p.lam_q1 = in[15]; p.lam_k1 = in[16]; p.lam_q2 = in[17]; p.lam_k2 = in[18]; p.subln_w = in[19];
  p.w_out = in[20]; p.norm_mem_w = in[21]; p.norm_src_w = in[22]; p.w_mq = in[23]; p.w_mk = in[24]; p.w_mv = in[25];
  p.w_mo = in[26]; p.norm_mlp_w = in[27]; p.w_up = in[28]; p.w_down = in[29]; p.norm_final_w = in[30];
  p.out = (float*)d_out;
  char* ws = (char*)d_ws;
  u16* wbase = (u16*)ws;
  long o = 0;
  p.wt_in = wbase + o; o += 3328L * 1024;
  p.wt_out = wbase + o; o += 1024L * 1024;
  p.wt_mq = wbase + o; o += 1024L * 1024;
  p.wt_mk = wbase + o; o += 1024L * 1024;
  p.wt_mv = wbase + o; o += 1024L * 1024;
  p.wt_mo = wbase + o; o += 1024L * 1024;
  p.wt_up = wbase + o; o += 4096L * 1024;
  p.wt_down = wbase + o; o += 4096L * 1024;
  p.wt_dec = wbase + o; o += 512L * 64;
  p.wt_a = wbase + o; o += 512L * 64;
  p.wt_g = wbase + o; o += 512L * 128;
  p.xn = (u16*)(ws + 34 * MiB);
  char* big = ws + 98 * MiB;
  p.pr = (u16*)big;
  p.qkd = (u16*)(big + 112 * MiB);
  p.vt = (u16*)(big + 176 * MiB);
  p.hid = (u16*)big;
  p.mix = (u16*)(ws + 354 * MiB);
  p.qmem = (u16*)(ws + 418 * MiB);
  p.memn = (u16*)(ws + 482 * MiB);
  p.kmem = (u16*)(ws + 486 * MiB);
  p.vtmem = (u16*)(ws + 490 * MiB);
  p.lora_in = (u16*)(ws + 494 * MiB);
  p.e_buf = (float*)d_out;
  p.asig = (u16*)((char*)d_out + 64 * MiB);
  p.gbuf = (u16*)((char*)d_out + 96 * MiB);
  void* args[] = {&p};
  hipError_t e = hipLaunchCooperativeKernel((void*)fwd_megakernel, dim3(grid_blocks), dim3(256), args, 0, stream);
  if (e != hipSuccess) fprintf(stderr, "cooperative launch failed: %s (grid %d)\n", hipGetErrorString(e), grid_blocks);
}
```

```cpp
#include <hip/hip_runtime.h>
#include <hip/hip_cooperative_groups.h>
#include <cstdio>
namespace cg = cooperative_groups;

#define DI __device__ __forceinline__
typedef unsigned short u16;
using bf16x8 = __attribute__((ext_vector_type(8))) short;
using f32x4 = __attribute__((ext_vector_type(4))) float;
using u16x4 = __attribute__((ext_vector_type(4))) unsigned short;

constexpr int T_TOK = 32768, SEQ = 4096, DM = 1024;
constexpr long MiB = 1024L * 1024L;

DI u16 f2bf(float x) { unsigned u = __float_as_uint(x); u += 0x7fffu + ((u >> 16) & 1u); return (u16)(u >> 16); }
DI float bf2f(u16 h) { return __uint_as_float(((unsigned)h) << 16); }
DI float wave_sum(float v) {
#pragma unroll
  for (int o = 32; o > 0; o >>= 1) v += __shfl_xor(v, o);
  return v;
}
DI f32x4 mfma16(bf16x8 a, bf16x8 b, f32x4 c) { return __builtin_amdgcn_mfma_f32_16x16x32_bf16(a, b, c, 0, 0, 0); }
DI u16x4 pack4(f32x4 v) { u16x4 r; r[0] = f2bf(v[0]); r[1] = f2bf(v[1]); r[2] = f2bf(v[2]); r[3] = f2bf(v[3]); return r; }

struct Params {
  const float *x, *mem, *norm_mix_w, *w_in, *mu, *w0, *w_dec_up, *a0, *a_up, *g_up, *k_k, *k_a, *r_k, *lnx_w, *lnx_b;
  const float *lam_q1, *lam_k1, *lam_q2, *lam_k2, *subln_w, *w_out, *norm_mem_w, *norm_src_w, *w_mq, *w_mk, *w_mv, *w_mo;
  const float *norm_mlp_w, *w_up, *w_down, *norm_final_w;
  float* out;
  u16 *wt_in, *wt_out, *wt_mq, *wt_mk, *wt_mv, *wt_mo, *wt_up, *wt_down, *wt_dec, *wt_a, *wt_g;
  u16 *xn, *pr, *qkd, *vt, *hid, *mix, *qmem, *memn, *kmem, *vtmem, *lora_in;
  float* e_buf; u16 *asig, *gbuf;
  u16 *c_mp, *c_yh, *c_nc, *c_y0; float* c_gc;
};

DI void transpose_w(const float* __restrict__ W, u16* __restrict__ Wt, int K, int N, int bid, int nb, char* smem) {
  float(*tile)[65] = (float(*)[65])smem;
  const int tid = threadIdx.x;
  const int tn = N / 64, nt = (K / 64) * tn;
  for (int t = bid; t < nt; t += nb) {
    const int k0 = (t / tn) * 64, n0 = (t % tn) * 64;
#pragma unroll
    for (int i = 0; i < 4; ++i) {
      const int r = (tid >> 4) + i * 16, c = (tid & 15) * 4;
      const float4 v = *(const float4*)(W + (long)(k0 + r) * N + n0 + c);
      tile[r][c] = v.x; tile[r][c + 1] = v.y; tile[r][c + 2] = v.z; tile[r][c + 3] = v.w;
    }
    __syncthreads();
#pragma unroll
    for (int i = 0; i < 2; ++i) {
      const int c = tid + i * 256, n = c >> 3, kk = (c & 7) * 8;
      uint4 o;
      o.x = f2bf(tile[kk][n]) | ((unsigned)f2bf(tile[kk + 1][n]) << 16);
      o.y = f2bf(tile[kk + 2][n]) | ((unsigned)f2bf(tile[kk + 3][n]) << 16);
      o.z = f2bf(tile[kk + 4][n]) | ((unsigned)f2bf(tile[kk + 5][n]) << 16);
      o.w = f2bf(tile[kk + 6][n]) | ((unsigned)f2bf(tile[kk + 7][n]) << 16);
      *(uint4*)(Wt + (long)(n0 + n) * K + k0 + kk) = o;
    }
    __syncthreads();
  }
}

template <bool BF>
DI void rmsnorm_phase(const float* in, const float* __restrict__ w, void* outp, int rows, int bid, int nb) {
  const int lane = threadIdx.x & 63;
  const int wave = bid * 4 + (threadIdx.x >> 6), nw = nb * 4;
  for (int row = wave; row < rows; row += nw) {
    const float4* p = (const float4*)(in + (long)row * 1024);
    float4 v[4];
    float ss = 0.f;
#pragma unroll
    for (int i = 0; i < 4; ++i) {
      v[i] = p[lane + i * 64];
      ss += v[i].x * v[i].x + v[i].y * v[i].y + v[i].z * v[i].z + v[i].w * v[i].w;
    }
    ss = wave_sum(ss);
    const float rs = rsqrtf(ss * (1.f / 1024.f) + 1e-5f);
#pragma unroll
    for (int i = 0; i < 4; ++i) {
      const float4 wv = ((const float4*)w)[lane + i * 64];
      f32x4 y;
      y[0] = v[i].x * rs * wv.x; y[1] = v[i].y * rs * wv.y; y[2] = v[i].z * rs * wv.z; y[3] = v[i].w * rs * wv.w;
      if (BF) {
        *(u16x4*)((u16*)outp + (long)row * 1024 + (lane + i * 64) * 4) = pack4(y);
      } else {
        *(f32x4*)((float*)outp + (long)row * 1024 + (lane + i * 64) * 4) = y;
      }
    }
  }
}

constexpr int GBM = 128, GBN = 128, GBK = 64, GLD = 72;
template <class Epi>
DI void gemm_phase(const u16* __restrict__ A, int lda, const u16* __restrict__ Bt, int ldb, int M, int N, int K, Epi epi,
                   int bid, int nb, char* smem) {
  u16* sA = (u16*)smem;
  u16* sB = sA + 2 * GBM * GLD;
  const int tid = threadIdx.x, lane = tid & 63, wid = tid >> 6, wr = wid >> 1, wc = wid & 1;
  const int fr = lane & 15, fq = lane >> 4;
  const int ntn = N / GBN, ntiles = (M / GBM) * ntn, nk = K / GBK;
  const int lrow = tid >> 3, lkc = (tid & 7) * 8;
  for (int tile = bid; tile < ntiles; tile += nb) {
    const int tm = tile / ntn, tn = tile % ntn;
    const u16* Ag = A + (long)(tm * GBM + lrow) * lda + lkc;
    const u16* Bg = Bt + (long)(tn * GBN + lrow) * ldb + lkc;
    f32x4 acc[4][4];
#pragma unroll
    for (int m = 0; m < 4; ++m)
#pragma unroll
      for (int n = 0; n < 4; ++n) acc[m][n] = (f32x4){0.f, 0.f, 0.f, 0.f};
    uint4 ra[4], rb[4];
#pragma unroll
    for (int i = 0; i < 4; ++i) {
      ra[i] = *(const uint4*)(Ag + (long)(i * 32) * lda);
      rb[i] = *(const uint4*)(Bg + (long)(i * 32) * ldb);
    }
#pragma unroll
    for (int i = 0; i < 4; ++i) {
      *(uint4*)(sA + (lrow + i * 32) * GLD + lkc) = ra[i];
      *(uint4*)(sB + (lrow + i * 32) * GLD + lkc) = rb[i];
    }
    __syncthreads();
    for (int kt = 0; kt < nk; ++kt) {
      if (kt + 1 < nk) {
#pragma unroll
        for (int i = 0; i < 4; ++i) {
          ra[i] = *(const uint4*)(Ag + (long)(i * 32) * lda + (kt + 1) * GBK);
          rb[i] = *(const uint4*)(Bg + (long)(i * 32) * ldb + (kt + 1) * GBK);
        }
      }
      const u16* a_s = sA + (kt & 1) * GBM * GLD;
      const u16* b_s = sB + (kt & 1) * GBN * GLD;
#pragma unroll
      for (int ks = 0; ks < 2; ++ks) {
        bf16x8 af[4], bfr[4];
#pragma unroll
        for (int m = 0; m < 4; ++m) af[m] = *(const bf16x8*)(a_s + (wr * 64 + m * 16 + fr) * GLD + ks * 32 + fq * 8);
#pragma unroll
        for (int n = 0; n < 4; ++n) bfr[n] = *(const bf16x8*)(b_s + (wc * 64 + n * 16 + fr) * GLD + ks * 32 + fq * 8);
#pragma unroll
        for (int m = 0; m < 4; ++m)
#pragma unroll
          for (int n = 0; n < 4; ++n) acc[m][n] = mfma16(bfr[n], af[m], acc[m][n]);
      }
      if (kt + 1 < nk) {
        u16* a_d = sA + ((kt + 1) & 1) * GBM * GLD;
        u16* b_d = sB + ((kt + 1) & 1) * GBN * GLD;
#pragma unroll
        for (int i = 0; i < 4; ++i) {
          *(uint4*)(a_d + (lrow + i * 32) * GLD + lkc) = ra[i];
          *(uint4*)(b_d + (lrow + i * 32) * GLD + lkc) = rb[i];
        }
      }
      __syncthreads();
    }
#pragma unroll
    for (int m = 0; m < 4; ++m)
#pragma unroll
      for (int n = 0; n < 4; ++n)
        epi(tm * GBM + wr * 64 + m * 16 + fr, tn * GBN + wc * 64 + n * 16 + fq * 4, acc[m][n]);
  }
}

struct EpiWin {
  u16 *pr, *qkd, *vt;
  DI void operator()(int row, int col, f32x4 v) const {
    if (col < 1792) {
      *(u16x4*)(pr + (long)row * 1792 + col) = pack4(v);
    } else if (col < 2816) {
      *(u16x4*)(qkd + (long)row * 1024 + (col - 1792)) = pack4(v);
    } else {
      const int b = row >> 12, s = row & 4095, c = col - 2816;
#pragma unroll
      for (int j = 0; j < 4; ++j) vt[((long)(b * 512 + c + j)) * 4096 + s] = f2bf(v[j]);
    }
  }
};
struct EpiBf16 {
  u16* o; int ld;
  DI void operator()(int row, int col, f32x4 v) const { *(u16x4*)(o + (long)row * ld + col) = pack4(v); }
};
struct EpiVtMem {
  u16* o;
  DI void operator()(int row, int col, f32x4 v) const {
    const int b = row >> 8, m = row & 255;
#pragma unroll
    for (int j = 0; j < 4; ++j) o[((long)(b * 1024 + col + j)) * 256 + m] = f2bf(v[j]);
  }
};
struct EpiDecay {
  float* e; const float* w0;
  DI void operator()(int row, int col, f32x4 v) const {
    f32x4 r;
#pragma unroll
    for (int j = 0; j < 4; ++j) {
      const float z = -(w0[col + j] + v[j]);
      const float sp = fmaxf(z, 0.f) + log1pf(__expf(-fabsf(z)));
      r[j] = __expf(-sp - 0.5f);
    }
    *(f32x4*)(e + (long)row * 512 + col) = r;
  }
};
struct EpiASig {
  u16* o; const float* a0;
  DI void operator()(int row, int col, f32x4 v) const {
    f32x4 r;
#pragma unroll
    for (int j = 0; j < 4; ++j) r[j] = 1.f / (1.f + __expf(-(a0[col + j] + v[j])));
    *(u16x4*)(o + (long)row * 512 + col) = pack4(r);
  }
};
struct EpiResX {
  float* h; const float* x;
  DI void operator()(int row, int col, f32x4 v) const {
    const f32x4 xv = *(const f32x4*)(x + (long)row * 1024 + col);
    *(f32x4*)(h + (long)row * 1024 + col) = xv + v;
  }
};
struct EpiResAcc {
  float* h;
  DI void operator()(int row, int col, f32x4 v) const {
    f32x4* p = (f32x4*)(h + (long)row * 1024 + col);
    *p = *p + v;
  }
};
struct EpiRelu2 {
  u16* o;
  DI void operator()(int row, int col, f32x4 v) const {
    f32x4 r;
#pragma unroll
    for (int j = 0; j < 4; ++j) { const float t = fmaxf(v[j], 0.f); r[j] = t * t; }
    *(u16x4*)(o + (long)row * 4096 + col) = pack4(r);
  }
};

DI void rwkv_prep_phase(const Params& p, int bid, int nb) {
  const long total = (long)T_TOK * 256;
  for (long idx = (long)bid * 256 + threadIdx.x; idx < total; idx += (long)nb * 256) {
    const int t = (int)(idx >> 8), c = (int)(idx & 255);
    const float v = bf2f(p.pr[(long)t * 1792 + 1536 + c]);
    const float pv = (t & 4095) ? bf2f(p.pr[(long)(t - 1) * 1792 + 1536 + c]) : 0.f;
    const float xx = v + (pv - v) * p.mu[1536 + c];
    float y;
    if (c < 64) y = tanhf(xx);
    else if (c < 128) y = xx;
    else y = 1.f / (1.f + __expf(-xx));
    p.lora_in[idx] = f2bf(y);
  }
}

DI void rwkv_scan_seq(const Params& p, int bh, float* sh) {
  const int lane = threadIdx.x & 63;
  const int b = bh >> 3, h = bh & 7, c = h * 64 + lane;
  const float mu_r = p.mu[c], mu_k = p.mu[512 + c], mu_v = p.mu[1024 + c];
  const float kk_w = p.k_k[c], ka_w = p.k_a[c], rk_w = p.r_k[c], lw = p.lnx_w[c], lb = p.lnx_b[c];
  float st[64];
#pragma unroll
  for (int i = 0; i < 64; ++i) st[i] = 0.f;
  float rp = 0.f, kp = 0.f, vp = 0.f;
  const long tok0 = (long)b * 4096;
  u16 nr = p.pr[tok0 * 1792 + c], nk = p.pr[tok0 * 1792 + 512 + c], nv = p.pr[tok0 * 1792 + 1024 + c];
  float ne = p.e_buf[tok0 * 512 + c];
  u16 na = p.asig[tok0 * 512 + c], ng = p.gbuf[tok0 * 512 + c];
  for (int t = 0; t < 4096; ++t) {
    const float r0 = bf2f(nr), k0 = bf2f(nk), v0 = bf2f(nv), e = ne, a = bf2f(na), g = bf2f(ng);
    if (t + 1 < 4096) {
      const long tk = tok0 + t + 1;
      nr = p.pr[tk * 1792 + c]; nk = p.pr[tk * 1792 + 512 + c]; nv = p.pr[tk * 1792 + 1024 + c];
      ne = p.e_buf[tk * 512 + c]; na = p.asig[tk * 512 + c]; ng = p.gbuf[tk * 512 + c];
    }
    const float r = r0 + (rp - r0) * mu_r, k = k0 + (kp - k0) * mu_k, v = v0 + (vp - v0) * mu_v;
    rp = r0; kp = k0; vp = v0;
    const float w = __expf(-e);
    const float kkv = k * kk_w;
    const float n2 = wave_sum(kkv * kkv);
    const float kk = kkv / fmaxf(sqrtf(n2), 1e-12f);
    const float kmod = k * (1.f + (a - 1.f) * ka_w);
    const float bb = kk * a;
    __syncthreads();
    sh[lane] = w; sh[64 + lane] = kk; sh[128 + lane] = bb; sh[192 + lane] = kmod; sh[256 + lane] = r;
    __syncthreads();
    float sa = 0.f;
#pragma unroll
    for (int q = 0; q < 16; ++q) {
      const float4 k4 = *(const float4*)(sh + 64 + q * 4);
      sa += st[q * 4] * k4.x + st[q * 4 + 1] * k4.y + st[q * 4 + 2] * k4.z + st[q * 4 + 3] * k4.w;
      asm volatile("" : "+v"(sa) :: "memory");
    }
    sa = -sa;
    float y = 0.f;
#pragma unroll
    for (int q = 0; q < 16; ++q) {
      const float4 w4 = *(const float4*)(sh + q * 4);
      const float4 b4 = *(const float4*)(sh + 128 + q * 4);
      const float4 m4 = *(const float4*)(sh + 192 + q * 4);
      const float4 r4 = *(const float4*)(sh + 256 + q * 4);
      st[q * 4] = st[q * 4] * w4.x + sa * b4.x + v * m4.x; y += st[q * 4] * r4.x;
      st[q * 4 + 1] = st[q * 4 + 1] * w4.y + sa * b4.y + v * m4.y; y += st[q * 4 + 1] * r4.y;
      st[q * 4 + 2] = st[q * 4 + 2] * w4.z + sa * b4.z + v * m4.z; y += st[q * 4 + 2] * r4.z;
      st[q * 4 + 3] = st[q * 4 + 3] * w4.w + sa * b4.w + v * m4.w; y += st[q * 4 + 3] * r4.w;
      asm volatile("" : "+v"(y) :: "memory");
    }
    const float mean = wave_sum(y) * (1.f / 64.f);
    const float d = y - mean;
    const float var = wave_sum(d * d) * (1.f / 64.f);
    const float yn = d * rsqrtf(var + 64e-5f) * lw + lb;
    const float bonus = wave_sum(r * kmod * rk_w) * v;
    p.mix[(tok0 + t) * 1024 + c] = f2bf((yn + bonus) * g);
  }
}


constexpr int RLD = 72, SLOT = 64 * RLD;
DI bf16x8 ldfrag(const u16* base, int row, int kofs) { return *(const bf16x8*)(base + row * RLD + kofs); }
DI void unpack8(uint4 w, float* o) {
  o[0] = __uint_as_float(w.x << 16); o[1] = __uint_as_float(w.x & 0xffff0000u);
  o[2] = __uint_as_float(w.y << 16); o[3] = __uint_as_float(w.y & 0xffff0000u);
  o[4] = __uint_as_float(w.z << 16); o[5] = __uint_as_float(w.z & 0xffff0000u);
  o[6] = __uint_as_float(w.w << 16); o[7] = __uint_as_float(w.w & 0xffff0000u);
}
DI unsigned pk2(float a, float b) { return (unsigned)f2bf(a) | ((unsigned)f2bf(b) << 16); }
DI f32x4 unpack4(u16x4 v) { f32x4 r; r[0] = bf2f(v[0]); r[1] = bf2f(v[1]); r[2] = bf2f(v[2]); r[3] = bf2f(v[3]); return r; }
#define ZERO4 ((f32x4){0.f, 0.f, 0.f, 0.f})

DI void rwkv_chunk_prep(const Params& p, int tile, char* smem) {
  int tid_ = threadIdx.x;
  asm volatile("" : "+v"(tid_));
  const int tid = tid_, lane = tid & 63, wid = tid >> 6, fr = lane & 15, fq = lane >> 4;
  const int ch = tile & 63, bh = tile >> 6, b = bh >> 3, h = bh & 7;
  u16* S = (u16*)smem;
  u16 *S0 = S, *S1 = S + SLOT, *S2 = S + 2 * SLOT, *S3 = S + 3 * SLOT, *S4 = S + 4 * SLOT, *S5 = S + 5 * SLOT,
      *S6 = S + 6 * SLOT, *S7 = S + 7 * SLOT;
  float* Ef = (float*)S4;
  __syncthreads();
  const int t = tid >> 2, i0 = (tid & 3) * 16;
  const long tok = (long)b * 4096 + ch * 64 + t;
  const int col = h * 64 + i0;
  const bool first = (ch == 0 && t == 0);
  const u16* pc = p.pr + tok * 1792 + col;
  {
    const float4* ep = (const float4*)(p.e_buf + tok * 512 + col);
#pragma unroll
    for (int q = 0; q < 4; ++q) *(float4*)(Ef + t * 64 + i0 + q * 4) = ep[q];
  }
  __syncthreads();
  {
    const int cc = tid & 63, qq = tid >> 6;
    float s = 0.f;
#pragma unroll
    for (int tt = 0; tt < 16; ++tt) { s += Ef[(qq * 16 + tt) * 64 + cc]; Ef[(qq * 16 + tt) * 64 + cc] = s; }
  }
  __syncthreads();
  float n2 = 0.f, bon = 0.f;
#pragma unroll
  for (int hf = 0; hf < 2; ++hf) {
    const int o = hf * 8;
    float r[8], k[8], a[8], rp[8], kp[8];
    unpack8(*(const uint4*)(pc + o), r);
    unpack8(*(const uint4*)(pc + 512 + o), k);
    unpack8(*(const uint4*)(p.asig + tok * 512 + col + o), a);
    if (first) {
#pragma unroll
      for (int q = 0; q < 8; ++q) { rp[q] = 0.f; kp[q] = 0.f; }
    } else {
      unpack8(*(const uint4*)(pc - 1792 + o), rp);
      unpack8(*(const uint4*)(pc - 1792 + 512 + o), kp);
    }
#pragma unroll
    for (int q = 0; q < 8; ++q) {
      const int c = col + o + q;
      const float rr = r[q] + (rp[q] - r[q]) * p.mu[c];
      const float kx = k[q] + (kp[q] - k[q]) * p.mu[512 + c];
      const float kkv = kx * p.k_k[c];
      n2 += kkv * kkv;
      bon += rr * kx * (1.f + (a[q] - 1.f) * p.k_a[c]) * p.r_k[c];
    }
    asm volatile("" ::: "memory");
  }
  n2 += __shfl_xor(n2, 1); n2 += __shfl_xor(n2, 2);
  bon += __shfl_xor(bon, 1); bon += __shfl_xor(bon, 2);
  const float kinv = 1.f / fmaxf(sqrtf(n2), 1e-12f);
  unsigned pa[8], pbh[8], pkh[8];
  const int tq = t >> 4;
#pragma unroll
  for (int hf = 0; hf < 2; ++hf) {
    const int o = hf * 8;
    float r[8], k[8], v[8], a[8], e[8];
    {
      float rp[8], kp[8], vp[8];
      unpack8(*(const uint4*)(pc + o), r);
      unpack8(*(const uint4*)(pc + 512 + o), k);
      unpack8(*(const uint4*)(pc + 1024 + o), v);
      unpack8(*(const uint4*)(p.asig + tok * 512 + col + o), a);
      if (first) {
#pragma unroll
        for (int q = 0; q < 8; ++q) { rp[q] = 0.f; kp[q] = 0.f; vp[q] = 0.f; }
      } else {
        unpack8(*(const uint4*)(pc - 1792 + o), rp);
        unpack8(*(const uint4*)(pc - 1792 + 512 + o), kp);
        unpack8(*(const uint4*)(pc - 1792 + 1024 + o), vp);
      }
#pragma unroll
      for (int q = 0; q < 8; ++q) {
        const int c = col + o + q;
        r[q] = r[q] + (rp[q] - r[q]) * p.mu[c];
        k[q] = k[q] + (kp[q] - k[q]) * p.mu[512 + c];
        v[q] = v[q] + (vp[q] - v[q]) * p.mu[1024 + c];
      }
      const float4 e0 = *(const float4*)(p.e_buf + tok * 512 + col + o), e1 = *(const float4*)(p.e_buf + tok * 512 + col + o + 4);
      e[0] = e0.x; e[1] = e0.y; e[2] = e0.z; e[3] = e0.w; e[4] = e1.x; e[5] = e1.y; e[6] = e1.z; e[7] = e1.w;
    }
    float At[8], Bt[8], Kt[8], Rt[8], Bh[8], Kh[8], bvv[8];
#pragma unroll
    for (int q = 0; q < 8; ++q) {
      const int c = col + o + q, ii = i0 + o + q;
      const float q0 = Ef[15 * 64 + ii], q1 = Ef[31 * 64 + ii], q2 = Ef[47 * 64 + ii], q3 = Ef[63 * 64 + ii];
      float Sc = Ef[t * 64 + ii];
      if (tq > 0) Sc += q0;
      if (tq > 1) Sc += q1;
      if (tq > 2) Sc += q2;
      const float SC = q0 + q1 + q2 + q3;
      const float kkn = k[q] * p.k_k[c] * kinv, bv = kkn * a[q];
      const float km = k[q] * (1.f + (a[q] - 1.f) * p.k_a[c]);
      const float eNS = __expf(-Sc), eS = 1.f / eNS, ee = __expf(e[q]), eC = __expf(-SC);
      At[q] = -kkn * ee * eNS;
      Rt[q] = r[q] * eNS;
      Bt[q] = bv * eS;
      Kt[q] = km * eS;
      Bh[q] = bv * (eS * eC);
      Kh[q] = km * (eS * eC);
      bvv[q] = bon * v[q];
      if (t == 63) p.c_gc[(long)tile * 64 + ii] = eC;
      S7[ii * RLD + t] = f2bf(v[q]);
    }
    uint4 w0;
#define PACK8(X) w0 = make_uint4(pk2(X[0], X[1]), pk2(X[2], X[3]), pk2(X[4], X[5]), pk2(X[6], X[7]));
    PACK8(At); *(uint4*)(S0 + t * RLD + i0 + o) = w0;
    pa[hf * 4] = w0.x; pa[hf * 4 + 1] = w0.y; pa[hf * 4 + 2] = w0.z; pa[hf * 4 + 3] = w0.w;
    PACK8(Bt); *(uint4*)(S1 + t * RLD + i0 + o) = w0;
    PACK8(Kt); *(uint4*)(S2 + t * RLD + i0 + o) = w0;
    PACK8(Rt); *(uint4*)(S3 + t * RLD + i0 + o) = w0;
    PACK8(Bh);
    pbh[hf * 4] = w0.x; pbh[hf * 4 + 1] = w0.y; pbh[hf * 4 + 2] = w0.z; pbh[hf * 4 + 3] = w0.w;
    PACK8(Kh);
    pkh[hf * 4] = w0.x; pkh[hf * 4 + 1] = w0.y; pkh[hf * 4 + 2] = w0.z; pkh[hf * 4 + 3] = w0.w;
    PACK8(bvv);
    *(uint4*)(p.asig + tok * 512 + col + o) = w0;
#undef PACK8
    asm volatile("" ::: "memory");
  }
  __syncthreads();
  const int trow = wid * 16 + fr;
  f32x4 Pacc[4];
  {
    bf16x8 aF[2], rF[2];
#pragma unroll
    for (int ks = 0; ks < 2; ++ks) { aF[ks] = ldfrag(S0, trow, ks * 32 + fq * 8); rF[ks] = ldfrag(S3, trow, ks * 32 + fq * 8); }
    f32x4 lab[4];
#pragma unroll
    for (int nt = 0; nt < 4; ++nt) {
      f32x4 lak = ZERO4, prb = ZERO4, prk = ZERO4;
      lab[nt] = ZERO4;
#pragma unroll
      for (int ks = 0; ks < 2; ++ks) {
        const bf16x8 bF = ldfrag(S1, nt * 16 + fr, ks * 32 + fq * 8), kF = ldfrag(S2, nt * 16 + fr, ks * 32 + fq * 8);
        lab[nt] = mfma16(bF, aF[ks], lab[nt]);
        lak = mfma16(kF, aF[ks], lak);
        prb = mfma16(bF, rF[ks], prb);
        prk = mfma16(kF, rF[ks], prk);
      }
      const int j0 = nt * 16 + fq * 4;
#pragma unroll
      for (int jj = 0; jj < 4; ++jj) {
        const int j = j0 + jj;
        if (!(j < trow)) { lab[nt][jj] = 0.f; lak[jj] = 0.f; }
        if (!(j <= trow)) { prb[jj] = 0.f; prk[jj] = 0.f; }
      }
      *(u16x4*)(S4 + trow * RLD + j0) = pack4(lak);
      *(u16x4*)(S5 + trow * RLD + j0) = pack4(prb);
      *(u16x4*)(S6 + trow * RLD + j0) = pack4(prk);
    }
    __syncthreads();
#pragma unroll
    for (int nt = 0; nt < 4; ++nt) {
      const int j0 = nt * 16 + fq * 4;
      f32x4 pi;
#pragma unroll
      for (int jj = 0; jj < 4; ++jj) {
        const int j = j0 + jj;
        pi[jj] = (j == trow ? 1.f : 0.f);
        S1[j * RLD + trow] = f2bf(lab[nt][jj]);
      }
      Pacc[nt] = pi;
      *(u16x4*)(S0 + trow * RLD + j0) = pack4(lab[nt]);
      *(u16x4*)(S2 + trow * RLD + j0) = pack4(pi);
    }
    __syncthreads();
  }
#pragma unroll 1
  for (int it = 0; it < 5; ++it) {
    bf16x8 pF[2], xF[2];
#pragma unroll
    for (int ks = 0; ks < 2; ++ks) { pF[ks] = ldfrag(S2, trow, ks * 32 + fq * 8); xF[ks] = ldfrag(S0, trow, ks * 32 + fq * 8); }
    f32x4 xn[4];
#pragma unroll
    for (int nt = 0; nt < 4; ++nt) {
      xn[nt] = ZERO4;
#pragma unroll
      for (int ks = 0; ks < 2; ++ks) {
        const bf16x8 xtF = ldfrag(S1, nt * 16 + fr, ks * 32 + fq * 8);
        Pacc[nt] = mfma16(xtF, pF[ks], Pacc[nt]);
        xn[nt] = mfma16(xtF, xF[ks], xn[nt]);
      }
    }
    __syncthreads();
#pragma unroll
    for (int nt = 0; nt < 4; ++nt) {
      const int j0 = nt * 16 + fq * 4;
      *(u16x4*)(S2 + trow * RLD + j0) = pack4(Pacc[nt]);
      *(u16x4*)(S0 + trow * RLD + j0) = pack4(xn[nt]);
#pragma unroll
      for (int jj = 0; jj < 4; ++jj) S1[(j0 + jj) * RLD + trow] = f2bf(xn[nt][jj]);
    }
    __syncthreads();
  }
  {
    bf16x8 pF[2];
#pragma unroll
    for (int ks = 0; ks < 2; ++ks) pF[ks] = ldfrag(S2, trow, ks * 32 + fq * 8);
#pragma unroll
    for (int nt = 0; nt < 4; ++nt)
#pragma unroll
      for (int ks = 0; ks < 2; ++ks) Pacc[nt] = mfma16(ldfrag(S1, nt * 16 + fr, ks * 32 + fq * 8), pF[ks], Pacc[nt]);
    __syncthreads();
#pragma unroll
    for (int nt = 0; nt < 4; ++nt) *(u16x4*)(S2 + trow * RLD + nt * 16 + fq * 4) = pack4(Pacc[nt]);
#pragma unroll
    for (int q = 0; q < 8; ++q) {
      S0[(i0 + 2 * q) * RLD + t] = (u16)(pa[q] & 0xffffu);
      S0[(i0 + 2 * q + 1) * RLD + t] = (u16)(pa[q] >> 16);
    }
    __syncthreads();
  }
  {
    bf16x8 tF[2], lkF[2];
#pragma unroll
    for (int ks = 0; ks < 2; ++ks) { tF[ks] = ldfrag(S2, trow, ks * 32 + fq * 8); lkF[ks] = ldfrag(S4, trow, ks * 32 + fq * 8); }
    f32x4 z[4];
#pragma unroll
    for (int nt = 0; nt < 4; ++nt) {
      f32x4 w1 = ZERO4;
      z[nt] = ZERO4;
#pragma unroll
      for (int ks = 0; ks < 2; ++ks) {
        w1 = mfma16(tF[ks], ldfrag(S0, nt * 16 + fr, ks * 32 + fq * 8), w1);
        z[nt] = mfma16(lkF[ks], ldfrag(S7, nt * 16 + fr, ks * 32 + fq * 8), z[nt]);
      }
      *(u16x4*)(S1 + (nt * 16 + fr) * RLD + wid * 16 + fq * 4) = pack4(w1);
    }
    __syncthreads();
#pragma unroll
    for (int nt = 0; nt < 4; ++nt) *(u16x4*)(S0 + (nt * 16 + fr) * RLD + wid * 16 + fq * 4) = pack4(z[nt]);
    __syncthreads();
#pragma unroll
    for (int nt = 0; nt < 4; ++nt) {
      f32x4 u0 = ZERO4;
#pragma unroll
      for (int ks = 0; ks < 2; ++ks) u0 = mfma16(tF[ks], ldfrag(S0, nt * 16 + fr, ks * 32 + fq * 8), u0);
      *(u16x4*)(S4 + (nt * 16 + fr) * RLD + wid * 16 + fq * 4) = pack4(u0);
    }
    __syncthreads();
#pragma unroll
    for (int q = 0; q < 8; ++q) {
      S0[(i0 + 2 * q) * RLD + t] = (u16)(pbh[q] & 0xffffu);
      S0[(i0 + 2 * q + 1) * RLD + t] = (u16)(pbh[q] >> 16);
      S2[(i0 + 2 * q) * RLD + t] = (u16)(pkh[q] & 0xffffu);
      S2[(i0 + 2 * q + 1) * RLD + t] = (u16)(pkh[q] >> 16);
    }
    __syncthreads();
  }
  {
    bf16x8 bhF[2], khF[2], pbF[2], pkF[2];
#pragma unroll
    for (int ks = 0; ks < 2; ++ks) {
      bhF[ks] = ldfrag(S0, trow, ks * 32 + fq * 8); khF[ks] = ldfrag(S2, trow, ks * 32 + fq * 8);
      pbF[ks] = ldfrag(S5, trow, ks * 32 + fq * 8); pkF[ks] = ldfrag(S6, trow, ks * 32 + fq * 8);
    }
    u16* mp = p.c_mp + (long)tile * 4096;
    u16* yh = p.c_yh + (long)tile * 4096;
    u16* nc = p.c_nc + (long)tile * 4096;
    u16* y0 = p.c_y0 + (long)tile * 4096;
#pragma unroll
    for (int nt = 0; nt < 4; ++nt) {
      f32x4 m = ZERO4, n = ZERO4, yy = ZERO4, yz = ZERO4;
#pragma unroll
      for (int ks = 0; ks < 2; ++ks) {
        const bf16x8 w1F = ldfrag(S1, nt * 16 + fr, ks * 32 + fq * 8);
        const bf16x8 u0F = ldfrag(S4, nt * 16 + fr, ks * 32 + fq * 8);
        const bf16x8 vF = ldfrag(S7, nt * 16 + fr, ks * 32 + fq * 8);
        m = mfma16(w1F, bhF[ks], m);
        n = mfma16(bhF[ks], u0F, n);
        n = mfma16(khF[ks], vF, n);
        yy = mfma16(w1F, pbF[ks], yy);
        yz = mfma16(u0F, pbF[ks], yz);
        yz = mfma16(vF, pkF[ks], yz);
      }
      yy += unpack4(*(const u16x4*)(S3 + trow * RLD + nt * 16 + fq * 4));
      *(u16x4*)(mp + trow * 64 + nt * 16 + fq * 4) = pack4(m);
      *(u16x4*)(yh + trow * 64 + nt * 16 + fq * 4) = pack4(yy);
      *(u16x4*)(nc + ((wid * 4 + nt) * 64 + lane) * 4) = pack4(n);
      *(u16x4*)(y0 + ((wid * 4 + nt) * 64 + lane) * 4) = pack4(yz);
    }
  }
}

DI bf16x8 ldperm(const u16* rowp, int ks, int fq) {
  const u16x4 lo = *(const u16x4*)(rowp + ks * 32 + fq * 4);
  const u16x4 hi = *(const u16x4*)(rowp + ks * 32 + 16 + fq * 4);
  bf16x8 r;
#pragma unroll
  for (int j = 0; j < 4; ++j) { r[j] = (short)lo[j]; r[4 + j] = (short)hi[j]; }
  return r;
}
DI void rwkv_state_pass(const Params& p, int bh_in) {
  const int bh = __builtin_amdgcn_readfirstlane(bh_in);
  const int lane = threadIdx.x & 63, fr = lane & 15, fq = lane >> 4;
  const int b = bh >> 3, h = bh & 7;
  f32x4 hacc[4][4];
#pragma unroll
  for (int i = 0; i < 4; ++i)
#pragma unroll
    for (int j = 0; j < 4; ++j) hacc[i][j] = ZERO4;
  const int fo = fr * 64 + fq * 4;
  const int lo4 = lane * 4;
  const int to = fr * 512 + h * 64 + fq * 4;
  const int mo = fr * 1024 + h * 64 + fq * 4;
#pragma unroll 1
  for (int c = 0; c < 64; ++c) {
    const long tile = (long)bh * 64 + c;
    const u16* mp = p.c_mp + tile * 4096;
    const u16* yh = p.c_yh + tile * 4096;
    const u16* nc = p.c_nc + tile * 4096;
    const u16* y0 = p.c_y0 + tile * 4096;
    const float* gc = p.c_gc + tile * 64;
    const long tg0 = (long)b * 4096 + c * 64;
    const u16* bvp = p.asig + tg0 * 512;
    const u16* ggp = p.gbuf + tg0 * 512;
    u16* mxp = p.mix + tg0 * 1024;
    bf16x8 hf[2][4];
#pragma unroll
    for (int ks = 0; ks < 2; ++ks)
#pragma unroll
      for (int vt = 0; vt < 4; ++vt)
#pragma unroll
        for (int j = 0; j < 4; ++j) {
          hf[ks][vt][j] = (short)f2bf(hacc[2 * ks][vt][j]);
          hf[ks][vt][4 + j] = (short)f2bf(hacc[2 * ks + 1][vt][j]);
        }
#pragma unroll
    for (int tt = 0; tt < 4; ++tt) {
      bf16x8 yF[2];
#pragma unroll
      for (int ks = 0; ks < 2; ++ks) {
        const u16x4 lo = *(const u16x4*)(yh + fo + tt * 1024 + ks * 32);
        const u16x4 hi = *(const u16x4*)(yh + fo + tt * 1024 + ks * 32 + 16);
#pragma unroll
        for (int j = 0; j < 4; ++j) { yF[ks][j] = (short)lo[j]; yF[ks][4 + j] = (short)hi[j]; }
      }
      f32x4 y[4];
      float sum = 0.f;
#pragma unroll
      for (int vt = 0; vt < 4; ++vt) {
        y[vt] = unpack4(*(const u16x4*)(y0 + lo4 + (tt * 4 + vt) * 256));
#pragma unroll
        for (int ks = 0; ks < 2; ++ks) y[vt] = mfma16(hf[ks][vt], yF[ks], y[vt]);
        sum += y[vt][0] + y[vt][1] + y[vt][2] + y[vt][3];
      }
      sum += __shfl_xor(sum, 16); sum += __shfl_xor(sum, 32);
      const float mean = sum * (1.f / 64.f);
      float sq = 0.f;
#pragma unroll
      for (int vt = 0; vt < 4; ++vt)
#pragma unroll
        for (int jj = 0; jj < 4; ++jj) { y[vt][jj] -= mean; sq += y[vt][jj] * y[vt][jj]; }
      sq += __shfl_xor(sq, 16); sq += __shfl_xor(sq, 32);
      const float rstd = rsqrtf(sq * (1.f / 64.f) + 64e-5f);
#pragma unroll
      for (int vt = 0; vt < 4; ++vt) {
        const f32x4 bv = unpack4(*(const u16x4*)(bvp + to + tt * 16 * 512 + vt * 16));
        const f32x4 g = unpack4(*(const u16x4*)(ggp + to + tt * 16 * 512 + vt * 16));
        const float4 lw = *(const float4*)(p.lnx_w + h * 64 + vt * 16 + fq * 4), lb = *(const float4*)(p.lnx_b + h * 64 + vt * 16 + fq * 4);
        f32x4 o;
        o[0] = (y[vt][0] * rstd * lw.x + lb.x + bv[0]) * g[0];
        o[1] = (y[vt][1] * rstd * lw.y + lb.y + bv[1]) * g[1];
        o[2] = (y[vt][2] * rstd * lw.z + lb.z + bv[2]) * g[2];
        o[3] = (y[vt][3] * rstd * lw.w + lb.w + bv[3]) * g[3];
        *(u16x4*)(mxp + mo + tt * 16 * 1024 + vt * 16) = pack4(o);
      }
      asm volatile("" ::: "memory");
    }
#pragma unroll
    for (int it = 0; it < 4; ++it) {
      bf16x8 mF[2];
#pragma unroll
      for (int ks = 0; ks < 2; ++ks) {
        const u16x4 lo = *(const u16x4*)(mp + fo + it * 1024 + ks * 32);
        const u16x4 hi = *(const u16x4*)(mp + fo + it * 1024 + ks * 32 + 16);
#pragma unroll
        for (int j = 0; j < 4; ++j) { mF[ks][j] = (short)lo[j]; mF[ks][4 + j] = (short)hi[j]; }
      }
      const float4 g4 = *(const float4*)(gc + it * 16 + fq * 4);
#pragma unroll
      for (int vt = 0; vt < 4; ++vt) {
        const f32x4 nn = unpack4(*(const u16x4*)(nc + lo4 + (it * 4 + vt) * 256));
        f32x4 a;
        a[0] = hacc[it][vt][0] * g4.x + nn[0]; a[1] = hacc[it][vt][1] * g4.y + nn[1];
        a[2] = hacc[it][vt][2] * g4.z + nn[2]; a[3] = hacc[it][vt][3] * g4.w + nn[3];
#pragma unroll
        for (int ks = 0; ks < 2; ++ks) a = mfma16(mF[ks], hf[ks][vt], a);
        hacc[it][vt] = a;
      }
      asm volatile("" ::: "memory");
    }
  }
}

template <int DQK, int DV, int NMAP, bool DIFF>
DI void attn_tile(const u16* __restrict__ Q, long q_stride, const u16* __restrict__ Kg, long k_stride,
                  const u16* __restrict__ Vtg, long vt_stride, int nkt, float scale, u16* __restrict__ Out, long o_stride,
                  float lam, const float* __restrict__ subw, char* smem) {
  constexpr int KW = NMAP * DQK, KLD = KW + 8, VLD = 72;
  u16* Ks = (u16*)smem;
  u16* Vs = Ks + 64 * KLD;
  const int tid = threadIdx.x, lane = tid & 63, wid = tid >> 6, fr = lane & 15, fq = lane >> 4;
  bf16x8 qf[NMAP][DQK / 32];
#pragma unroll
  for (int m = 0; m < NMAP; ++m)
#pragma unroll
    for (int ks = 0; ks < DQK / 32; ++ks)
      qf[m][ks] = *(const bf16x8*)(Q + (long)(wid * 16 + fr) * q_stride + m * DQK + ks * 32 + fq * 8);
  f32x4 o[NMAP][DV / 16];
  float mrun[NMAP], lrun[NMAP];
#pragma unroll
  for (int m = 0; m < NMAP; ++m) {
    mrun[m] = -1e30f; lrun[m] = 0.f;
#pragma unroll
    for (int dt = 0; dt < DV / 16; ++dt) o[m][dt] = (f32x4){0.f, 0.f, 0.f, 0.f};
  }
  for (int kt = 0; kt < nkt; ++kt) {
    __syncthreads();
    for (int c = tid; c < 64 * (KW / 8); c += 256) {
      const int row = c / (KW / 8), cc = (c % (KW / 8)) * 8;
      *(uint4*)(Ks + row * KLD + cc) = *(const uint4*)(Kg + (long)(kt * 64 + row) * k_stride + cc);
    }
    for (int c = tid; c < DV * 8; c += 256) {
      const int row = c >> 3, cc = (c & 7) * 8;
      *(uint4*)(Vs + row * VLD + cc) = *(const uint4*)(Vtg + (long)row * vt_stride + kt * 64 + cc);
    }
    __syncthreads();
#pragma unroll
    for (int m = 0; m < NMAP; ++m) {
      f32x4 s[4];
#pragma unroll
      for (int c = 0; c < 4; ++c) {
        s[c] = (f32x4){0.f, 0.f, 0.f, 0.f};
#pragma unroll
        for (int ks = 0; ks < DQK / 32; ++ks) {
          const bf16x8 kf = *(const bf16x8*)(Ks + (c * 16 + fr) * KLD + m * DQK + ks * 32 + fq * 8);
          s[c] = mfma16(kf, qf[m][ks], s[c]);
        }
      }
      float mx = -1e30f;
#pragma unroll
      for (int c = 0; c < 4; ++c)
#pragma unroll
        for (int j = 0; j < 4; ++j) mx = fmaxf(mx, s[c][j]);
      mx = fmaxf(mx, __shfl_xor(mx, 16));
      mx = fmaxf(mx, __shfl_xor(mx, 32));
      mx *= scale;
      const float mnew = fmaxf(mrun[m], mx);
      const float alpha = __expf(mrun[m] - mnew);
      mrun[m] = mnew;
      float psum = 0.f;
#pragma unroll
      for (int c = 0; c < 4; ++c)
#pragma unroll
        for (int j = 0; j < 4; ++j) { s[c][j] = __expf(s[c][j] * scale - mnew); psum += s[c][j]; }
      lrun[m] = lrun[m] * alpha + psum;
#pragma unroll
      for (int dt = 0; dt < DV / 16; ++dt) o[m][dt] *= alpha;
#pragma unroll
      for (int k2 = 0; k2 < 2; ++k2) {
        bf16x8 pb;
#pragma unroll
        for (int j = 0; j < 4; ++j) { pb[j] = (short)f2bf(s[2 * k2][j]); pb[4 + j] = (short)f2bf(s[2 * k2 + 1][j]); }
#pragma unroll
        for (int dt = 0; dt < DV / 16; ++dt) {
          const u16x4 lo = *(const u16x4*)(Vs + (dt * 16 + fr) * VLD + k2 * 32 + fq * 4);
          const u16x4 hi = *(const u16x4*)(Vs + (dt * 16 + fr) * VLD + k2 * 32 + 16 + fq * 4);
          bf16x8 vf;
#pragma unroll
          for (int j = 0; j < 4; ++j) { vf[j] = (short)lo[j]; vf[4 + j] = (short)hi[j]; }
          o[m][dt] = mfma16(vf, pb, o[m][dt]);
        }
      }
    }
  }
  float linv[NMAP];
#pragma unroll
  for (int m = 0; m < NMAP; ++m) {
    float l = lrun[m];
    l += __shfl_xor(l, 16);
    l += __shfl_xor(l, 32);
    linv[m] = 1.f / l;
  }
  u16* orow = Out + (long)(wid * 16 + fr) * o_stride;
  if (DIFF) {
    float ss = 0.f;
#pragma unroll
    for (int dt = 0; dt < DV / 16; ++dt)
#pragma unroll
      for (int j = 0; j < 4; ++j) {
        const float val = o[0][dt][j] * linv[0] - lam * o[NMAP - 1][dt][j] * linv[NMAP - 1];
        o[0][dt][j] = val;
        ss += val * val;
      }
    ss += __shfl_xor(ss, 16);
    ss += __shfl_xor(ss, 32);
    const float rstd = rsqrtf(ss * (1.f / DV) + 1e-5f) * 0.8f;
#pragma unroll
    for (int dt = 0; dt < DV / 16; ++dt) {
      f32x4 r;
#pragma unroll
      for (int j = 0; j < 4; ++j) r[j] = o[0][dt][j] * rstd * subw[dt * 16 + fq * 4 + j];
      *(u16x4*)(orow + dt * 16 + fq * 4) = pack4(r);
    }
  } else {
#pragma unroll
    for (int dt = 0; dt < DV / 16; ++dt) {
      f32x4 r = o[0][dt] * linv[0];
      *(u16x4*)(orow + dt * 16 + fq * 4) = pack4(r);
    }
  }
}

constexpr int SMEM_BYTES = 80 * 1024;

__global__ void __launch_bounds__(256, 2) fwd_megakernel(Params p) {
  cg::grid_group grid = cg::this_grid();
  __shared__ __attribute__((aligned(16))) char smem[SMEM_BYTES];
  const int bid = blockIdx.x, nb = gridDim.x;

  transpose_w(p.w_in, p.wt_in, 1024, 3328, bid, nb, smem);
  transpose_w(p.w_out, p.wt_out, 1024, 1024, bid, nb, smem);
  transpose_w(p.w_mq, p.wt_mq, 1024, 1024, bid, nb, smem);
  transpose_w(p.w_mk, p.wt_mk, 1024, 1024, bid, nb, smem);
  transpose_w(p.w_mv, p.wt_mv, 1024, 1024, bid, nb, smem);
  transpose_w(p.w_mo, p.wt_mo, 1024, 1024, bid, nb, smem);
  transpose_w(p.w_up, p.wt_up, 1024, 4096, bid, nb, smem);
  transpose_w(p.w_down, p.wt_down, 4096, 1024, bid, nb, smem);
  transpose_w(p.w_dec_up, p.wt_dec, 64, 512, bid, nb, smem);
  transpose_w(p.a_up, p.wt_a, 64, 512, bid, nb, smem);
  transpose_w(p.g_up, p.wt_g, 128, 512, bid, nb, smem);
  rmsnorm_phase<true>(p.x, p.norm_mix_w, p.xn, T_TOK, bid, nb);
  rmsnorm_phase<true>(p.mem, p.norm_src_w, p.memn, 2048, bid, nb);
  grid.sync();

  gemm_phase(p.xn, 1024, p.wt_in, 1024, T_TOK, 3328, 1024, EpiWin{p.pr, p.qkd, p.vt}, bid, nb, smem);
  gemm_phase(p.memn, 1024, p.wt_mk, 1024, 2048, 1024, 1024, EpiBf16{p.kmem, 1024}, bid, nb, smem);
  gemm_phase(p.memn, 1024, p.wt_mv, 1024, 2048, 1024, 1024, EpiVtMem{p.vtmem}, bid, nb, smem);
  grid.sync();

  rwkv_prep_phase(p, bid, nb);
  grid.sync();

  gemm_phase(p.lora_in, 256, p.wt_dec, 64, T_TOK, 512, 64, EpiDecay{p.e_buf, p.w0}, bid, nb, smem);
  gemm_phase(p.lora_in + 64, 256, p.wt_a, 64, T_TOK, 512, 64, EpiASig{p.asig, p.a0}, bid, nb, smem);
  gemm_phase(p.lora_in + 128, 256, p.wt_g, 128, T_TOK, 512, 128, EpiBf16{p.gbuf, 512}, bid, nb, smem);
  grid.sync();

  for (int tile = bid; tile < 4096; tile += nb) rwkv_chunk_prep(p, tile, smem);
  grid.sync();
  if (bid < 16) {
    rwkv_state_pass(p, bid * 4 + (threadIdx.x >> 6));
  } else {
    float d1 = 0.f, d2 = 0.f;
    for (int i = 0; i < 64; ++i) { d1 += p.lam_q1[i] * p.lam_k1[i]; d2 += p.lam_q2[i] * p.lam_k2[i]; }
    const float lam = __expf(d1) - __expf(d2) + 0.2f;
    for (int idx = bid - 16; idx < 2048; idx += nb - 16) {
      const int qc = 63 - (idx >> 5), bh = idx & 31, b = bh >> 2, h = bh & 3;
      const long tq = (long)b * 4096 + qc * 64;
      attn_tile<64, 128, 2, true>(p.qkd + tq * 1024 + h * 128, 1024, p.qkd + (long)b * 4096 * 1024 + 512 + h * 128, 1024,
                                  p.vt + (long)(b * 512 + h * 128) * 4096, 4096, qc + 1, 0.125f,
                                  p.mix + tq * 1024 + 512 + h * 128, 1024, lam, p.subln_w, smem);
    }
  }
  grid.sync();

  gemm_phase(p.mix, 1024, p.wt_out, 1024, T_TOK, 1024, 1024, EpiResX{p.out, p.x}, bid, nb, smem);
  grid.sync();
  rmsnorm_phase<true>(p.out, p.norm_mem_w, p.xn, T_TOK, bid, nb);
  grid.sync();
  gemm_phase(p.xn, 1024, p.wt_mq, 1024, T_TOK, 1024, 1024, EpiBf16{p.qmem, 1024}, bid, nb, smem);
  grid.sync();
  for (int idx = bid; idx < 2048; idx += nb) {
    const int tt = idx >> 2, h = idx & 3;
    const long t0 = (long)tt * 64;
    const int b = (int)(t0 >> 12);
    attn_tile<256, 256, 1, false>(p.qmem + t0 * 1024 + h * 256, 1024, p.kmem + (long)b * 256 * 1024 + h * 256, 1024,
                                  p.vtmem + (long)(b * 1024 + h * 256) * 256, 256, 4, 0.0625f,
                                  p.mix + t0 * 1024 + h * 256, 1024, 0.f, p.subln_w, smem);
  }
  grid.sync();
  gemm_phase(p.mix, 1024, p.wt_mo, 1024, T_TOK, 1024, 1024, EpiResAcc{p.out}, bid, nb, smem);
  grid.sync();
  rmsnorm_phase<true>(p.out, p.norm_mlp_w, p.xn, T_TOK, bid, nb);
  grid.sync();
  gemm_phase(p.xn, 1024, p.wt_up, 1024, T_TOK, 4096, 1024, EpiRelu2{p.hid}, bid, nb, smem);
  grid.sync();
  gemm_phase(p.hid, 4096, p.wt_down, 4096, T_TOK, 1024, 4096, EpiResAcc{p.out}, bid, nb, smem);
  grid.sync();
  rmsnorm_phase<false>(p.out, p.norm_final_w, p.out, T_TOK, bid, nb);
}

extern "C" void kernel_launch(void* const* d_in, const int* in_sizes, int n_in, void* d_out, int out_size, void* d_ws,
                              size_t ws_size, hipStream_t stream) {
  static int grid_blocks = 0;
  if (!grid_blocks) {
    int dev = 0, cus = 0, per_cu = 0;
    hipGetDevice(&dev);
    hipDeviceGetAttribute(&cus, hipDeviceAttributeMultiprocessorCount, dev);
    hipOccupancyMaxActiveBlocksPerMultiprocessor(&per_cu, fwd_megakernel, 256, 0);
    if (per_cu > 2) per_cu = 2;
    if (per_cu < 1) per_cu = 1;
    grid_blocks = cus * per_cu;
  }
  Params p{};
  const float* const* in = (const float* const*)d_in;
  p.x = in[0]; p.mem = in[1]; p.norm_mix_w = in[2]; p.w_in = in[3]; p.mu = in[4]; p.w0 = in[5]; p.w_dec_up = in[6];
  p.a0 = in[7]; p.a_up = in[8]; p.g_up = in[9]; p.k_k = in[10]; p.k_a = in[11]; p.r_k = in[12]; p.lnx_w = in[13];
  p.lnx_b = in[14]; p.lam_q1 = in[15]; p.lam_k1 = in[16]; p.lam_q2 = in[17]; p.lam_k2 = in[18]; p.subln_w = in[19];
  p.w_out = in[20]; p.norm_mem_w = in[21]; p.norm_src_w = in[22]; p.w_mq = in[23]; p.w_mk = in[24]; p.w_mv = in[25];
  p.w_mo = in[26]; p.norm_mlp_w = in[27]; p.w_up = in[28]; p.w_down = in[29]; p.norm_final_w = in[30];
  p.out = (float*)d_out;
  char* ws = (char*)d_ws;
  u16* wbase = (u16*)ws;
  long o = 0;
  p.wt_in = wbase + o; o += 3328L * 1024;
  p.wt_out = wbase + o; o += 1024L * 1024;
  p.wt_mq = wbase + o; o += 1024L * 1024;
  p.wt_mk = wbase + o; o += 1024L * 1024;
  p.wt_mv = wbase + o; o += 1024L * 1024;
  p.wt_mo = wbase + o; o += 1024L * 1024;
  p.wt_up = wbase + o; o += 4096L * 1024;
  p.wt_down = wbase + o; o += 4096L * 1024;
  p.wt_dec = wbase + o; o += 512L * 64;
  p.wt_a = wbase + o; o += 512L * 64;
  p.wt_g = wbase + o; o += 512L * 128;
  p.xn = (u16*)(ws + 34 * MiB);
  char* big = ws + 98 * MiB;
  p.pr = (u16*)big;
  p.qkd = (u16*)(big + 112 * MiB);
  p.vt = (u16*)(big + 176 * MiB);
  p.hid = (u16*)big;
  p.mix = (u16*)(ws + 354 * MiB);
  p.qmem = (u16*)(ws + 418 * MiB);
  p.memn = (u16*)(ws + 482 * MiB);
  p.kmem = (u16*)(ws + 486 * MiB);
  p.vtmem = (u16*)(ws + 490 * MiB);
  p.lora_in = (u16*)(ws + 494 * MiB);
  p.e_buf = (float*)d_out;
  p.asig = (u16*)((char*)d_out + 64 * MiB);
  p.gbuf = (u16*)((char*)d_out + 96 * MiB);
  p.c_mp = p.xn; p.c_yh = p.xn + 4096L * 4096;
  p.c_nc = p.qmem; p.c_y0 = p.qmem + 4096L * 4096;
  p.c_gc = (float*)p.lora_in;
  void* args[] = {&p};
  hipError_t e = hipLaunchCooperativeKernel((void*)fwd_megakernel, dim3(grid_blocks), dim3(256), args, 0, stream);
  if (e != hipSuccess) fprintf(stderr, "cooperative launch failed: %s (grid %d)\n", hipGetErrorString(e), grid_blocks);
}
```

```cpp
#include <hip/hip_runtime.h>
#include <hip/hip_cooperative_groups.h>
#include <cstdio>
namespace cg = cooperative_groups;

#define DI __device__ __forceinline__
typedef unsigned short u16;
using bf16x8 = __attribute__((ext_vector_type(8))) short;
using f32x4 = __attribute__((ext_vector_type(4))) float;
using u16x4 = __attribute__((ext_vector_type(4))) unsigned short;

constexpr int T_TOK = 32768, SEQ = 4096, DM = 1024;
constexpr long MiB = 1024L * 1024L;

DI u16 f2bf(float x) { unsigned u = __float_as_uint(x); u += 0x7fffu + ((u >> 16) & 1u); return (u16)(u >> 16); }
DI float bf2f(u16 h) { return __uint_as_float(((unsigned)h) << 16); }
DI float wave_sum(float v) {
#pragma unroll
  for (int o = 32; o > 0; o >>= 1) v += __shfl_xor(v, o);
  return v;
}
DI f32x4 mfma16(bf16x8 a, bf16x8 b, f32x4 c) { return __builtin_amdgcn_mfma_f32_16x16x32_bf16(a, b, c, 0, 0, 0); }
DI u16x4 pack4(f32x4 v) { u16x4 r; r[0] = f2bf(v[0]); r[1] = f2bf(v[1]); r[2] = f2bf(v[2]); r[3] = f2bf(v[3]); return r; }

struct Params {
  const float *x, *mem, *norm_mix_w, *w_in, *mu, *w0, *w_dec_up, *a0, *a_up, *g_up, *k_k, *k_a, *r_k, *lnx_w, *lnx_b;
  const float *lam_q1, *lam_k1, *lam_q2, *lam_k2, *subln_w, *w_out, *norm_mem_w, *norm_src_w, *w_mq, *w_mk, *w_mv, *w_mo;
  const float *norm_mlp_w, *w_up, *w_down, *norm_final_w;
  float* out;
  u16 *wt_in, *wt_out, *wt_mq, *wt_mk, *wt_mv, *wt_mo, *wt_up, *wt_down, *wt_dec, *wt_a, *wt_g;
  u16 *xn, *pr, *qkd, *vt, *hid, *mix, *qmem, *memn, *kmem, *vtmem, *lora_in;
  float* e_buf; u16 *asig, *gbuf;
  u16 *c_mp, *c_yh, *c_nc, *c_y0; float* c_gc;
  int* counter;
};

DI void transpose_w(const float* __restrict__ W, u16* __restrict__ Wt, int K, int N, int bid, int nb, char* smem) {
  float(*tile)[65] = (float(*)[65])smem;
  const int tid = threadIdx.x;
  const int tn = N / 64, nt = (K / 64) * tn;
  for (int t = bid; t < nt; t += nb) {
    const int k0 = (t / tn) * 64, n0 = (t % tn) * 64;
#pragma unroll
    for (int i = 0; i < 4; ++i) {
      const int r = (tid >> 4) + i * 16, c = (tid & 15) * 4;
      const float4 v = *(const float4*)(W + (long)(k0 + r) * N + n0 + c);
      tile[r][c] = v.x; tile[r][c + 1] = v.y; tile[r][c + 2] = v.z; tile[r][c + 3] = v.w;
    }
    __syncthreads();
#pragma unroll
    for (int i = 0; i < 2; ++i) {
      const int c = tid + i * 256, n = c >> 3, kk = (c & 7) * 8;
      uint4 o;
      o.x = f2bf(tile[kk][n]) | ((unsigned)f2bf(tile[kk + 1][n]) << 16);
      o.y = f2bf(tile[kk + 2][n]) | ((unsigned)f2bf(tile[kk + 3][n]) << 16);
      o.z = f2bf(tile[kk + 4][n]) | ((unsigned)f2bf(tile[kk + 5][n]) << 16);
      o.w = f2bf(tile[kk + 6][n]) | ((unsigned)f2bf(tile[kk + 7][n]) << 16);
      *(uint4*)(Wt + (long)(n0 + n) * K + k0 + kk) = o;
    }
    __syncthreads();
  }
}

template <bool BF>
DI void rmsnorm_phase(const float* in, const float* __restrict__ w, void* outp, int rows, int bid, int nb) {
  const int lane = threadIdx.x & 63;
  const int wave = bid * 4 + (threadIdx.x >> 6), nw = nb * 4;
  for (int row = wave; row < rows; row += nw) {
    const float4* p = (const float4*)(in + (long)row * 1024);
    float4 v[4];
    float ss = 0.f;
#pragma unroll
    for (int i = 0; i < 4; ++i) {
      v[i] = p[lane + i * 64];
      ss += v[i].x * v[i].x + v[i].y * v[i].y + v[i].z * v[i].z + v[i].w * v[i].w;
    }
    ss = wave_sum(ss);
    const float rs = rsqrtf(ss * (1.f / 1024.f) + 1e-5f);
#pragma unroll
    for (int i = 0; i < 4; ++i) {
      const float4 wv = ((const float4*)w)[lane + i * 64];
      f32x4 y;
      y[0] = v[i].x * rs * wv.x; y[1] = v[i].y * rs * wv.y; y[2] = v[i].z * rs * wv.z; y[3] = v[i].w * rs * wv.w;
      if (BF) {
        *(u16x4*)((u16*)outp + (long)row * 1024 + (lane + i * 64) * 4) = pack4(y);
      } else {
        *(f32x4*)((float*)outp + (long)row * 1024 + (lane + i * 64) * 4) = y;
      }
    }
  }
}

constexpr int GBM = 128, GBN = 128, GBK = 64, GLD = 72;
template <int VT_FROM, class Epi>
DI void gemm_phase(const u16* __restrict__ A, int lda, const u16* __restrict__ Bt, int ldb, int M, int N, int K, Epi epi,
                   int bid, int nb, char* smem, u16* vt_out = nullptr) {
  u16* sA = (u16*)smem;
  u16* sB = sA + 2 * GBM * GLD;
  const int tid = threadIdx.x, lane = tid & 63, wid = tid >> 6, wr = wid >> 1, wc = wid & 1;
  const int fr = lane & 15, fq = lane >> 4;
  const int ntm = M / GBM, ntn = N / GBN, nk = K / GBK;
  const int lrow = tid >> 3, lkc = (tid & 7) * 8;
  const int xcd = bid & 7, li = bid >> 3, nli = nb >> 3;
  const int mx = (ntm - xcd + 7) >> 3, total = mx * ntn;
  for (int s = li; s < total; s += nli) {
    const int pf = s / (mx * 8), rem = s - pf * mx * 8;
    const int pw = min(8, ntn - pf * 8);
    const int tm = (rem / pw) * 8 + xcd, tn = pf * 8 + rem % pw;
    const u16* Ag = A + (long)(tm * GBM) * lda;
    const u16* Bg = Bt + (long)(tn * GBN) * ldb;
    const unsigned voA = (unsigned)(lrow * lda + lkc), voB = (unsigned)(lrow * ldb + lkc);
    f32x4 acc[4][4];
#pragma unroll
    for (int m = 0; m < 4; ++m)
#pragma unroll
      for (int n = 0; n < 4; ++n) acc[m][n] = (f32x4){0.f, 0.f, 0.f, 0.f};
    uint4 ra0_0, ra0_1, ra0_2, ra0_3, rb0_0, rb0_1, rb0_2, rb0_3, ra1_0, ra1_1, ra1_2, ra1_3, rb1_0, rb1_1, rb1_2, rb1_3;
#define G_LOAD1(RA, RB, KT, I)                                                     \
  RA##_##I = *(const uint4*)((Ag + ((long)(I * 32) * lda + (KT) * GBK)) + voA);    \
  RB##_##I = *(const uint4*)((Bg + ((long)(I * 32) * ldb + (KT) * GBK)) + voB);
#define G_LOAD(RA, RB, KT) G_LOAD1(RA, RB, KT, 0) G_LOAD1(RA, RB, KT, 1) G_LOAD1(RA, RB, KT, 2) G_LOAD1(RA, RB, KT, 3)
#define G_STORE1(RA, RB, BUF, I)                                                   \
  *(uint4*)(sA + (BUF) * GBM * GLD + (lrow + I * 32) * GLD + lkc) = RA##_##I;      \
  *(uint4*)(sB + (BUF) * GBN * GLD + (lrow + I * 32) * GLD + lkc) = RB##_##I;
#define G_STORE(RA, RB, BUF) G_STORE1(RA, RB, BUF, 0) G_STORE1(RA, RB, BUF, 1) G_STORE1(RA, RB, BUF, 2) G_STORE1(RA, RB, BUF, 3)
#define G_COMPUTE(BUF)                                                             \
  {                                                                                \
    const u16* a_s = sA + (BUF) * GBM * GLD;                                       \
    const u16* b_s = sB + (BUF) * GBN * GLD;                                       \
    _Pragma("unroll") for (int ks = 0; ks < 2; ++ks) {                             \
      bf16x8 af[4], bfr[4];                                                        \
      _Pragma("unroll") for (int m = 0; m < 4; ++m)                                \
        af[m] = *(const bf16x8*)(a_s + (wr * 64 + m * 16 + fr) * GLD + ks * 32 + fq * 8);  \
      _Pragma("unroll") for (int n = 0; n < 4; ++n)                                \
        bfr[n] = *(const bf16x8*)(b_s + (wc * 64 + n * 16 + fr) * GLD + ks * 32 + fq * 8); \
      _Pragma("unroll") for (int m = 0; m < 4; ++m)                                \
        _Pragma("unroll") for (int n = 0; n < 4; ++n) acc[m][n] = mfma16(bfr[n], af[m], acc[m][n]); \
    }                                                                              \
  }
    G_LOAD(ra0, rb0, 0);
    if (nk > 1) { G_LOAD(ra1, rb1, 1); }
    G_STORE(ra0, rb0, 0);
    __syncthreads();
    for (int kt = 0; kt < nk; kt += 2) {
      if (kt + 2 < nk) { G_LOAD(ra0, rb0, kt + 2); }
      G_COMPUTE(0);
      if (kt + 1 < nk) { G_STORE(ra1, rb1, 1); }
      __syncthreads();
      if (kt + 1 >= nk) break;
      if (kt + 3 < nk) { G_LOAD(ra1, rb1, kt + 3); }
      G_COMPUTE(1);
      if (kt + 2 < nk) { G_STORE(ra0, rb0, 0); }
      __syncthreads();
    }
#undef G_LOAD
#undef G_STORE
#undef G_LOAD1
#undef G_STORE1
#undef G_COMPUTE
    if (VT_FROM >= 0 && tn >= VT_FROM) {
      constexpr int TLD = 136;
      u16* Tt = (u16*)smem;
#pragma unroll
      for (int m = 0; m < 4; ++m)
#pragma unroll
        for (int n = 0; n < 4; ++n)
#pragma unroll
          for (int j = 0; j < 4; ++j)
            Tt[(wc * 64 + n * 16 + fq * 4 + j) * TLD + wr * 64 + m * 16 + fr] = f2bf(acc[m][n][j]);
      __syncthreads();
      const int colL = tid >> 1, half = tid & 1;
      const int row0 = tm * GBM, b = row0 >> 12, s0 = (row0 & 4095) + half * 64;
      const int c = (tn - VT_FROM) * GBN + colL;
      u16* dst = vt_out + ((long)(b * 512 + c)) * 4096 + s0;
#pragma unroll
      for (int i = 0; i < 8; ++i) *(uint4*)(dst + i * 8) = *(const uint4*)(Tt + colL * TLD + half * 64 + i * 8);
      __syncthreads();
    } else {
#pragma unroll
      for (int m = 0; m < 4; ++m)
#pragma unroll
        for (int n = 0; n < 4; ++n)
          epi(tm * GBM + wr * 64 + m * 16 + fr, tn * GBN + wc * 64 + n * 16 + fq * 4, acc[m][n]);
    }
  }
}

struct EpiWin {
  u16 *pr, *qkd, *vt;
  DI void operator()(int row, int col, f32x4 v) const {
    if (col < 1792) {
      *(u16x4*)(pr + (long)row * 1792 + col) = pack4(v);
    } else if (col < 2816) {
      *(u16x4*)(qkd + (long)row * 1024 + (col - 1792)) = pack4(v);
    } else {
      const int b = row >> 12, s = row & 4095, c = col - 2816;
#pragma unroll
      for (int j = 0; j < 4; ++j) vt[((long)(b * 512 + c + j)) * 4096 + s] = f2bf(v[j]);
    }
  }
};
struct EpiBf16 {
  u16* o; int ld;
  DI void operator()(int row, int col, f32x4 v) const { *(u16x4*)(o + (long)row * ld + col) = pack4(v); }
};
struct EpiVtMem {
  u16* o;
  DI void operator()(int row, int col, f32x4 v) const {
    const int b = row >> 8, m = row & 255;
#pragma unroll
    for (int j = 0; j < 4; ++j) o[((long)(b * 1024 + col + j)) * 256 + m] = f2bf(v[j]);
  }
};
struct EpiDecay {
  float* e; const float* w0;
  DI void operator()(int row, int col, f32x4 v) const {
    f32x4 r;
#pragma unroll
    for (int j = 0; j < 4; ++j) {
      const float z = -(w0[col + j] + v[j]);
      const float sp = fmaxf(z, 0.f) + log1pf(__expf(-fabsf(z)));
      r[j] = __expf(-sp - 0.5f);
    }
    *(f32x4*)(e + (long)row * 512 + col) = r;
  }
};
struct EpiASig {
  u16* o; const float* a0;
  DI void operator()(int row, int col, f32x4 v) const {
    f32x4 r;
#pragma unroll
    for (int j = 0; j < 4; ++j) r[j] = 1.f / (1.f + __expf(-(a0[col + j] + v[j])));
    *(u16x4*)(o + (long)row * 512 + col) = pack4(r);
  }
};
struct EpiResX {
  float* h; const float* x;
  DI void operator()(int row, int col, f32x4 v) const {
    const f32x4 xv = *(const f32x4*)(x + (long)row * 1024 + col);
    *(f32x4*)(h + (long)row * 1024 + col) = xv + v;
  }
};
struct EpiResAcc {
  float* h;
  DI void operator()(int row, int col, f32x4 v) const {
    f32x4* p = (f32x4*)(h + (long)row * 1024 + col);
    *p = *p + v;
  }
};
struct EpiRelu2 {
  u16* o;
  DI void operator()(int row, int col, f32x4 v) const {
    f32x4 r;
#pragma unroll
    for (int j = 0; j < 4; ++j) { const float t = fmaxf(v[j], 0.f); r[j] = t * t; }
    *(u16x4*)(o + (long)row * 4096 + col) = pack4(r);
  }
};

DI void rwkv_prep_phase(const Params& p, int bid, int nb) {
  const long total = (long)T_TOK * 256;
  for (long idx = (long)bid * 256 + threadIdx.x; idx < total; idx += (long)nb * 256) {
    const int t = (int)(idx >> 8), c = (int)(idx & 255);
    const float v = bf2f(p.pr[(long)t * 1792 + 1536 + c]);
    const float pv = (t & 4095) ? bf2f(p.pr[(long)(t - 1) * 1792 + 1536 + c]) : 0.f;
    const float xx = v + (pv - v) * p.mu[1536 + c];
    float y;
    if (c < 64) y = tanhf(xx);
    else if (c < 128) y = xx;
    else y = 1.f / (1.f + __expf(-xx));
    p.lora_in[idx] = f2bf(y);
  }
}

DI void rwkv_scan_seq(const Params& p, int bh, float* sh) {
  const int lane = threadIdx.x & 63;
  const int b = bh >> 3, h = bh & 7, c = h * 64 + lane;
  const float mu_r = p.mu[c], mu_k = p.mu[512 + c], mu_v = p.mu[1024 + c];
  const float kk_w = p.k_k[c], ka_w = p.k_a[c], rk_w = p.r_k[c], lw = p.lnx_w[c], lb = p.lnx_b[c];
  float st[64];
#pragma unroll
  for (int i = 0; i < 64; ++i) st[i] = 0.f;
  float rp = 0.f, kp = 0.f, vp = 0.f;
  const long tok0 = (long)b * 4096;
  u16 nr = p.pr[tok0 * 1792 + c], nk = p.pr[tok0 * 1792 + 512 + c], nv = p.pr[tok0 * 1792 + 1024 + c];
  float ne = p.e_buf[tok0 * 512 + c];
  u16 na = p.asig[tok0 * 512 + c], ng = p.gbuf[tok0 * 512 + c];
  for (int t = 0; t < 4096; ++t) {
    const float r0 = bf2f(nr), k0 = bf2f(nk), v0 = bf2f(nv), e = ne, a = bf2f(na), g = bf2f(ng);
    if (t + 1 < 4096) {
      const long tk = tok0 + t + 1;
      nr = p.pr[tk * 1792 + c]; nk = p.pr[tk * 1792 + 512 + c]; nv = p.pr[tk * 1792 + 1024 + c];
      ne = p.e_buf[tk * 512 + c]; na = p.asig[tk * 512 + c]; ng = p.gbuf[tk * 512 + c];
    }
    const float r = r0 + (rp - r0) * mu_r, k = k0 + (kp - k0) * mu_k, v = v0 + (vp - v0) * mu_v;
    rp = r0; kp = k0; vp = v0;
    const float w = __expf(-e);
    const float kkv = k * kk_w;
    const float n2 = wave_sum(kkv * kkv);
    const float kk = kkv / fmaxf(sqrtf(n2), 1e-12f);
    const float kmod = k * (1.f + (a - 1.f) * ka_w);
    const float bb = kk * a;
    __syncthreads();
    sh[lane] = w; sh[64 + lane] = kk; sh[128 + lane] = bb; sh[192 + lane] = kmod; sh[256 + lane] = r;
    __syncthreads();
    float sa = 0.f;
#pragma unroll
    for (int q = 0; q < 16; ++q) {
      const float4 k4 = *(const float4*)(sh + 64 + q * 4);
      sa += st[q * 4] * k4.x + st[q * 4 + 1] * k4.y + st[q * 4 + 2] * k4.z + st[q * 4 + 3] * k4.w;
      asm volatile("" : "+v"(sa) :: "memory");
    }
    sa = -sa;
    float y = 0.f;
#pragma unroll
    for (int q = 0; q < 16; ++q) {
      const float4 w4 = *(const float4*)(sh + q * 4);
      const float4 b4 = *(const float4*)(sh + 128 + q * 4);
      const float4 m4 = *(const float4*)(sh + 192 + q * 4);
      const float4 r4 = *(const float4*)(sh + 256 + q * 4);
      st[q * 4] = st[q * 4] * w4.x + sa * b4.x + v * m4.x; y += st[q * 4] * r4.x;
      st[q * 4 + 1] = st[q * 4 + 1] * w4.y + sa * b4.y + v * m4.y; y += st[q * 4 + 1] * r4.y;
      st[q * 4 + 2] = st[q * 4 + 2] * w4.z + sa * b4.z + v * m4.z; y += st[q * 4 + 2] * r4.z;
      st[q * 4 + 3] = st[q * 4 + 3] * w4.w + sa * b4.w + v * m4.w; y += st[q * 4 + 3] * r4.w;
      asm volatile("" : "+v"(y) :: "memory");
    }
    const float mean = wave_sum(y) * (1.f / 64.f);
    const float d = y - mean;
    const float var = wave_sum(d * d) * (1.f / 64.f);
    const float yn = d * rsqrtf(var + 64e-5f) * lw + lb;
    const float bonus = wave_sum(r * kmod * rk_w) * v;
    p.mix[(tok0 + t) * 1024 + c] = f2bf((yn + bonus) * g);
  }
}


constexpr int RLD = 72, SLOT = 64 * RLD;
DI bf16x8 ldfrag(const u16* base, int row, int kofs) { return *(const bf16x8*)(base + row * RLD + kofs); }
DI void unpack8(uint4 w, float* o) {
  o[0] = __uint_as_float(w.x << 16); o[1] = __uint_as_float(w.x & 0xffff0000u);
  o[2] = __uint_as_float(w.y << 16); o[3] = __uint_as_float(w.y & 0xffff0000u);
  o[4] = __uint_as_float(w.z << 16); o[5] = __uint_as_float(w.z & 0xffff0000u);
  o[6] = __uint_as_float(w.w << 16); o[7] = __uint_as_float(w.w & 0xffff0000u);
}
DI unsigned pk2(float a, float b) { return (unsigned)f2bf(a) | ((unsigned)f2bf(b) << 16); }
DI f32x4 unpack4(u16x4 v) { f32x4 r; r[0] = bf2f(v[0]); r[1] = bf2f(v[1]); r[2] = bf2f(v[2]); r[3] = bf2f(v[3]); return r; }
#define ZERO4 ((f32x4){0.f, 0.f, 0.f, 0.f})

DI void rwkv_chunk_prep(const Params& p, int tile, char* smem) {
  int tid_ = threadIdx.x;
  asm volatile("" : "+v"(tid_));
  const int tid = tid_, lane = tid & 63, wid = tid >> 6, fr = lane & 15, fq = lane >> 4;
  const int ch = tile & 63, bh = tile >> 6, b = bh >> 3, h = bh & 7;
  u16* S = (u16*)smem;
  u16 *S0 = S, *S1 = S + SLOT, *S2 = S + 2 * SLOT, *S3 = S + 3 * SLOT, *S4 = S + 4 * SLOT, *S5 = S + 5 * SLOT,
      *S6 = S + 6 * SLOT, *S7 = S + 7 * SLOT;
  float* Ef = (float*)S4;
  __syncthreads();
  const int t = tid >> 2, i0 = (tid & 3) * 16;
  const long tok = (long)b * 4096 + ch * 64 + t;
  const int col = h * 64 + i0;
  const bool first = (ch == 0 && t == 0);
  const u16* pc = p.pr + tok * 1792 + col;
  {
    const float4* ep = (const float4*)(p.e_buf + tok * 512 + col);
#pragma unroll
    for (int q = 0; q < 4; ++q) *(float4*)(Ef + t * 64 + i0 + q * 4) = ep[q];
  }
  __syncthreads();
  {
    const int cc = tid & 63, qq = tid >> 6;
    float s = 0.f;
#pragma unroll
    for (int tt = 0; tt < 16; ++tt) { s += Ef[(qq * 16 + tt) * 64 + cc]; Ef[(qq * 16 + tt) * 64 + cc] = s; }
  }
  __syncthreads();
  float n2 = 0.f, bon = 0.f;
#pragma unroll
  for (int hf = 0; hf < 2; ++hf) {
    const int o = hf * 8;
    float r[8], k[8], a[8], rp[8], kp[8];
    unpack8(*(const uint4*)(pc + o), r);
    unpack8(*(const uint4*)(pc + 512 + o), k);
    unpack8(*(const uint4*)(p.asig + tok * 512 + col + o), a);
    if (first) {
#pragma unroll
      for (int q = 0; q < 8; ++q) { rp[q] = 0.f; kp[q] = 0.f; }
    } else {
      unpack8(*(const uint4*)(pc - 1792 + o), rp);
      unpack8(*(const uint4*)(pc - 1792 + 512 + o), kp);
    }
#pragma unroll
    for (int q = 0; q < 8; ++q) {
      const int c = col + o + q;
      const float rr = r[q] + (rp[q] - r[q]) * p.mu[c];
      const float kx = k[q] + (kp[q] - k[q]) * p.mu[512 + c];
      const float kkv = kx * p.k_k[c];
      n2 += kkv * kkv;
      bon += rr * kx * (1.f + (a[q] - 1.f) * p.k_a[c]) * p.r_k[c];
    }
    asm volatile("" ::: "memory");
  }
  n2 += __shfl_xor(n2, 1); n2 += __shfl_xor(n2, 2);
  bon += __shfl_xor(bon, 1); bon += __shfl_xor(bon, 2);
  const float kinv = 1.f / fmaxf(sqrtf(n2), 1e-12f);
  unsigned pa[8], pbh[8], pkh[8];
  const int tq = t >> 4;
#pragma unroll
  for (int hf = 0; hf < 2; ++hf) {
    const int o = hf * 8;
    float r[8], k[8], v[8], a[8], e[8];
    {
      float rp[8], kp[8], vp[8];
      unpack8(*(const uint4*)(pc + o), r);
      unpack8(*(const uint4*)(pc + 512 + o), k);
      unpack8(*(const uint4*)(pc + 1024 + o), v);
      unpack8(*(const uint4*)(p.asig + tok * 512 + col + o), a);
      if (first) {
#pragma unroll
        for (int q = 0; q < 8; ++q) { rp[q] = 0.f; kp[q] = 0.f; vp[q] = 0.f; }
      } else {
        unpack8(*(const uint4*)(pc - 1792 + o), rp);
        unpack8(*(const uint4*)(pc - 1792 + 512 + o), kp);
        unpack8(*(const uint4*)(pc - 1792 + 1024 + o), vp);
      }
#pragma unroll
      for (int q = 0; q < 8; ++q) {
        const int c = col + o + q;
        r[q] = r[q] + (rp[q] - r[q]) * p.mu[c];
        k[q] = k[q] + (kp[q] - k[q]) * p.mu[512 + c];
        v[q] = v[q] + (vp[q] - v[q]) * p.mu[1024 + c];
      }
      const float4 e0 = *(const float4*)(p.e_buf + tok * 512 + col + o), e1 = *(const float4*)(p.e_buf + tok * 512 + col + o + 4);
      e[0] = e0.x; e[1] = e0.y; e[2] = e0.z; e[3] = e0.w; e[4] = e1.x; e[5] = e1.y; e[6] = e1.z; e[7] = e1.w;
    }
    float At[8], Bt[8], Kt[8], Rt[8], Bh[8], Kh[8], bvv[8];
#pragma unroll
    for (int q = 0; q < 8; ++q) {
      const int c = col + o + q, ii = i0 + o + q;
      const float q0 = Ef[15 * 64 + ii], q1 = Ef[31 * 64 + ii], q2 = Ef[47 * 64 + ii], q3 = Ef[63 * 64 + ii];
      float Sc = Ef[t * 64 + ii];
      if (tq > 0) Sc += q0;
      if (tq > 1) Sc += q1;
      if (tq > 2) Sc += q2;
      const float SC = q0 + q1 + q2 + q3;
      const float kkn = k[q] * p.k_k[c] * kinv, bv = kkn * a[q];
      const float km = k[q] * (1.f + (a[q] - 1.f) * p.k_a[c]);
      const float eNS = __expf(-Sc), eS = 1.f / eNS, ee = __expf(e[q]), eC = __expf(-SC);
      At[q] = -kkn * ee * eNS;
      Rt[q] = r[q] * eNS;
      Bt[q] = bv * eS;
      Kt[q] = km * eS;
      Bh[q] = bv * (eS * eC);
      Kh[q] = km * (eS * eC);
      bvv[q] = bon * v[q];
      if (t == 63) p.c_gc[(long)tile * 64 + ii] = eC;
      S7[ii * RLD + t] = f2bf(v[q]);
    }
    uint4 w0;
#define PACK8(X) w0 = make_uint4(pk2(X[0], X[1]), pk2(X[2], X[3]), pk2(X[4], X[5]), pk2(X[6], X[7]));
    PACK8(At); *(uint4*)(S0 + t * RLD + i0 + o) = w0;
    pa[hf * 4] = w0.x; pa[hf * 4 + 1] = w0.y; pa[hf * 4 + 2] = w0.z; pa[hf * 4 + 3] = w0.w;
    PACK8(Bt); *(uint4*)(S1 + t * RLD + i0 + o) = w0;
    PACK8(Kt); *(uint4*)(S2 + t * RLD + i0 + o) = w0;
    PACK8(Rt); *(uint4*)(S3 + t * RLD + i0 + o) = w0;
    PACK8(Bh);
    pbh[hf * 4] = w0.x; pbh[hf * 4 + 1] = w0.y; pbh[hf * 4 + 2] = w0.z; pbh[hf * 4 + 3] = w0.w;
    PACK8(Kh);
    pkh[hf * 4] = w0.x; pkh[hf * 4 + 1] = w0.y; pkh[hf * 4 + 2] = w0.z; pkh[hf * 4 + 3] = w0.w;
    PACK8(bvv);
    *(uint4*)(p.asig + tok * 512 + col + o) = w0;
#undef PACK8
    asm volatile("" ::: "memory");
  }
  __syncthreads();
  const int trow = wid * 16 + fr;
  f32x4 Pacc[4];
  {
    bf16x8 aF[2], rF[2];
#pragma unroll
    for (int ks = 0; ks < 2; ++ks) { aF[ks] = ldfrag(S0, trow, ks * 32 + fq * 8); rF[ks] = ldfrag(S3, trow, ks * 32 + fq * 8); }
    f32x4 lab[4];
#pragma unroll
    for (int nt = 0; nt < 4; ++nt) {
      f32x4 lak = ZERO4, prb = ZERO4, prk = ZERO4;
      lab[nt] = ZERO4;
#pragma unroll
      for (int ks = 0; ks < 2; ++ks) {
        const bf16x8 bF = ldfrag(S1, nt * 16 + fr, ks * 32 + fq * 8), kF = ldfrag(S2, nt * 16 + fr, ks * 32 + fq * 8);
        lab[nt] = mfma16(bF, aF[ks], lab[nt]);
        lak = mfma16(kF, aF[ks], lak);
        prb = mfma16(bF, rF[ks], prb);
        prk = mfma16(kF, rF[ks], prk);
      }
      const int j0 = nt * 16 + fq * 4;
#pragma unroll
      for (int jj = 0; jj < 4; ++jj) {
        const int j = j0 + jj;
        if (!(j < trow)) { lab[nt][jj] = 0.f; lak[jj] = 0.f; }
        if (!(j <= trow)) { prb[jj] = 0.f; prk[jj] = 0.f; }
      }
      *(u16x4*)(S4 + trow * RLD + j0) = pack4(lak);
      *(u16x4*)(S5 + trow * RLD + j0) = pack4(prb);
      *(u16x4*)(S6 + trow * RLD + j0) = pack4(prk);
    }
    __syncthreads();
#pragma unroll
    for (int nt = 0; nt < 4; ++nt) {
      const int j0 = nt * 16 + fq * 4;
      f32x4 pi;
#pragma unroll
      for (int jj = 0; jj < 4; ++jj) {
        const int j = j0 + jj;
        pi[jj] = (j == trow ? 1.f : 0.f);
        S1[j * RLD + trow] = f2bf(lab[nt][jj]);
      }
      Pacc[nt] = pi;
      *(u16x4*)(S0 + trow * RLD + j0) = pack4(lab[nt]);
      *(u16x4*)(S2 + trow * RLD + j0) = pack4(pi);
    }
    __syncthreads();
  }
#pragma unroll 1
  for (int it = 0; it < 5; ++it) {
    bf16x8 pF[2], xF[2];
#pragma unroll
    for (int ks = 0; ks < 2; ++ks) { pF[ks] = ldfrag(S2, trow, ks * 32 + fq * 8); xF[ks] = ldfrag(S0, trow, ks * 32 + fq * 8); }
    f32x4 xn[4];
#pragma unroll
    for (int nt = 0; nt < 4; ++nt) {
      xn[nt] = ZERO4;
#pragma unroll
      for (int ks = 0; ks < 2; ++ks) {
        const bf16x8 xtF = ldfrag(S1, nt * 16 + fr, ks * 32 + fq * 8);
        Pacc[nt] = mfma16(xtF, pF[ks], Pacc[nt]);
        xn[nt] = mfma16(xtF, xF[ks], xn[nt]);
      }
    }
    __syncthreads();
#pragma unroll
    for (int nt = 0; nt < 4; ++nt) {
      const int j0 = nt * 16 + fq * 4;
      *(u16x4*)(S2 + trow * RLD + j0) = pack4(Pacc[nt]);
      *(u16x4*)(S0 + trow * RLD + j0) = pack4(xn[nt]);
#pragma unroll
      for (int jj = 0; jj < 4; ++jj) S1[(j0 + jj) * RLD + trow] = f2bf(xn[nt][jj]);
    }
    __syncthreads();
  }
  {
    bf16x8 pF[2];
#pragma unroll
    for (int ks = 0; ks < 2; ++ks) pF[ks] = ldfrag(S2, trow, ks * 32 + fq * 8);
#pragma unroll
    for (int nt = 0; nt < 4; ++nt)
#pragma unroll
      for (int ks = 0; ks < 2; ++ks) Pacc[nt] = mfma16(ldfrag(S1, nt * 16 + fr, ks * 32 + fq * 8), pF[ks], Pacc[nt]);
    __syncthreads();
#pragma unroll
    for (int nt = 0; nt < 4; ++nt) *(u16x4*)(S2 + trow * RLD + nt * 16 + fq * 4) = pack4(Pacc[nt]);
#pragma unroll
    for (int q = 0; q < 8; ++q) {
      S0[(i0 + 2 * q) * RLD + t] = (u16)(pa[q] & 0xffffu);
      S0[(i0 + 2 * q + 1) * RLD + t] = (u16)(pa[q] >> 16);
    }
    __syncthreads();
  }
  {
    bf16x8 tF[2], lkF[2];
#pragma unroll
    for (int ks = 0; ks < 2; ++ks) { tF[ks] = ldfrag(S2, trow, ks * 32 + fq * 8); lkF[ks] = ldfrag(S4, trow, ks * 32 + fq * 8); }
    f32x4 z[4];
#pragma unroll
    for (int nt = 0; nt < 4; ++nt) {
      f32x4 w1 = ZERO4;
      z[nt] = ZERO4;
#pragma unroll
      for (int ks = 0; ks < 2; ++ks) {
        w1 = mfma16(tF[ks], ldfrag(S0, nt * 16 + fr, ks * 32 + fq * 8), w1);
        z[nt] = mfma16(lkF[ks], ldfrag(S7, nt * 16 + fr, ks * 32 + fq * 8), z[nt]);
      }
      *(u16x4*)(S1 + (nt * 16 + fr) * RLD + wid * 16 + fq * 4) = pack4(w1);
    }
    __syncthreads();
#pragma unroll
    for (int nt = 0; nt < 4; ++nt) *(u16x4*)(S0 + (nt * 16 + fr) * RLD + wid * 16 + fq * 4) = pack4(z[nt]);
    __syncthreads();
#pragma unroll
    for (int nt = 0; nt < 4; ++nt) {
      f32x4 u0 = ZERO4;
#pragma unroll
      for (int ks = 0; ks < 2; ++ks) u0 = mfma16(tF[ks], ldfrag(S0, nt * 16 + fr, ks * 32 + fq * 8), u0);
      *(u16x4*)(S4 + (nt * 16 + fr) * RLD + wid * 16 + fq * 4) = pack4(u0);
    }
    __syncthreads();
#pragma unroll
    for (int q = 0; q < 8; ++q) {
      S0[(i0 + 2 * q) * RLD + t] = (u16)(pbh[q] & 0xffffu);
      S0[(i0 + 2 * q + 1) * RLD + t] = (u16)(pbh[q] >> 16);
      S2[(i0 + 2 * q) * RLD + t] = (u16)(pkh[q] & 0xffffu);
      S2[(i0 + 2 * q + 1) * RLD + t] = (u16)(pkh[q] >> 16);
    }
    __syncthreads();
  }
  {
    bf16x8 bhF[2], khF[2], pbF[2], pkF[2];
#pragma unroll
    for (int ks = 0; ks < 2; ++ks) {
      bhF[ks] = ldfrag(S0, trow, ks * 32 + fq * 8); khF[ks] = ldfrag(S2, trow, ks * 32 + fq * 8);
      pbF[ks] = ldfrag(S5, trow, ks * 32 + fq * 8); pkF[ks] = ldfrag(S6, trow, ks * 32 + fq * 8);
    }
    u16* mp = p.c_mp + (long)tile * 4096;
    u16* yh = p.c_yh + (long)tile * 4096;
    u16* nc = p.c_nc + (long)tile * 4096;
    u16* y0 = p.c_y0 + (long)tile * 4096;
#pragma unroll
    for (int nt = 0; nt < 4; ++nt) {
      f32x4 m = ZERO4, n = ZERO4, yy = ZERO4, yz = ZERO4;
#pragma unroll
      for (int ks = 0; ks < 2; ++ks) {
        const bf16x8 w1F = ldfrag(S1, nt * 16 + fr, ks * 32 + fq * 8);
        const bf16x8 u0F = ldfrag(S4, nt * 16 + fr, ks * 32 + fq * 8);
        const bf16x8 vF = ldfrag(S7, nt * 16 + fr, ks * 32 + fq * 8);
        m = mfma16(w1F, bhF[ks], m);
        n = mfma16(bhF[ks], u0F, n);
        n = mfma16(khF[ks], vF, n);
        yy = mfma16(w1F, pbF[ks], yy);
        yz = mfma16(u0F, pbF[ks], yz);
        yz = mfma16(vF, pkF[ks], yz);
      }
      yy += unpack4(*(const u16x4*)(S3 + trow * RLD + nt * 16 + fq * 4));
      *(u16x4*)(mp + trow * 64 + nt * 16 + fq * 4) = pack4(m);
      *(u16x4*)(yh + trow * 64 + nt * 16 + fq * 4) = pack4(yy);
      *(u16x4*)(nc + ((wid * 4 + nt) * 64 + lane) * 4) = pack4(n);
      *(u16x4*)(y0 + ((wid * 4 + nt) * 64 + lane) * 4) = pack4(yz);
    }
  }
}

DI bf16x8 ldperm(const u16* rowp, int ks, int fq) {
  const u16x4 lo = *(const u16x4*)(rowp + ks * 32 + fq * 4);
  const u16x4 hi = *(const u16x4*)(rowp + ks * 32 + 16 + fq * 4);
  bf16x8 r;
#pragma unroll
  for (int j = 0; j < 4; ++j) { r[j] = (short)lo[j]; r[4 + j] = (short)hi[j]; }
  return r;
}
DI void rwkv_state_pass(const Params& p, int bh, char* smem) {
  const int tid = threadIdx.x, lane = tid & 63, wid = tid >> 6, fr = lane & 15, fq = lane >> 4;
  const int b = bh >> 3, h = bh & 7;
  constexpr int BUFB = 2 * SLOT * 2 + 2 * 8192;
  float* gcs = (float*)(smem + 2 * BUFB);
  float* stats = gcs + 128;
  f32x4 hacc[4];
#pragma unroll
  for (int i = 0; i < 4; ++i) hacc[i] = ZERO4;
  const int cb = h * 64 + wid * 16 + fq * 4;
  const float4 lw = *(const float4*)(p.lnx_w + cb), lb = *(const float4*)(p.lnx_b + cb);
  const int lrow = tid >> 3, lcol = (tid & 7) * 8;
  uint4 pm0, pm1, py0, py1, pn0, pn1, pz0, pz1;
  float pregc = 0.f;
  __syncthreads();
  {
    const long tile = (long)bh * 64;
    const u16 *mp = p.c_mp + tile * 4096, *yh = p.c_yh + tile * 4096, *nc = p.c_nc + tile * 4096, *y0 = p.c_y0 + tile * 4096;
    pm0 = *(const uint4*)(mp + lrow * 64 + lcol); pm1 = *(const uint4*)(mp + (lrow + 32) * 64 + lcol);
    py0 = *(const uint4*)(yh + lrow * 64 + lcol); py1 = *(const uint4*)(yh + (lrow + 32) * 64 + lcol);
    pn0 = *(const uint4*)(nc + tid * 8); pn1 = *(const uint4*)(nc + (tid + 256) * 8);
    pz0 = *(const uint4*)(y0 + tid * 8); pz1 = *(const uint4*)(y0 + (tid + 256) * 8);
    if (tid < 64) pregc = p.c_gc[tile * 64 + tid];
    u16* bf = (u16*)smem;
    *(uint4*)(bf + lrow * RLD + lcol) = pm0; *(uint4*)(bf + (lrow + 32) * RLD + lcol) = pm1;
    *(uint4*)(bf + SLOT + lrow * RLD + lcol) = py0; *(uint4*)(bf + SLOT + (lrow + 32) * RLD + lcol) = py1;
    *(uint4*)(bf + 2 * SLOT + tid * 8) = pn0; *(uint4*)(bf + 2 * SLOT + (tid + 256) * 8) = pn1;
    *(uint4*)(bf + 2 * SLOT + 4096 + tid * 8) = pz0; *(uint4*)(bf + 2 * SLOT + 4096 + (tid + 256) * 8) = pz1;
    if (tid < 64) gcs[tid] = pregc;
  }
  __syncthreads();
#pragma unroll 1
  for (int c = 0; c < 64; ++c) {
    const int cur = c & 1;
    if (c + 1 < 64) {
      const long tile = (long)bh * 64 + c + 1;
      const u16 *mp = p.c_mp + tile * 4096, *yh = p.c_yh + tile * 4096, *nc = p.c_nc + tile * 4096, *y0 = p.c_y0 + tile * 4096;
      pm0 = *(const uint4*)(mp + lrow * 64 + lcol); pm1 = *(const uint4*)(mp + (lrow + 32) * 64 + lcol);
      py0 = *(const uint4*)(yh + lrow * 64 + lcol); py1 = *(const uint4*)(yh + (lrow + 32) * 64 + lcol);
      pn0 = *(const uint4*)(nc + tid * 8); pn1 = *(const uint4*)(nc + (tid + 256) * 8);
      pz0 = *(const uint4*)(y0 + tid * 8); pz1 = *(const uint4*)(y0 + (tid + 256) * 8);
      if (tid < 64) pregc = p.c_gc[tile * 64 + tid];
    }
    const long tg0 = (long)b * 4096 + c * 64;
    u16x4 bvr[4], gr[4];
#pragma unroll
    for (int tt = 0; tt < 4; ++tt) {
      bvr[tt] = *(const u16x4*)(p.asig + (tg0 + tt * 16 + fr) * 512 + cb);
      gr[tt] = *(const u16x4*)(p.gbuf + (tg0 + tt * 16 + fr) * 512 + cb);
    }
    const u16* bf = (const u16*)(smem + cur * BUFB);
    const u16 *Lmp = bf, *Lyh = bf + SLOT, *Lnc = bf + 2 * SLOT, *Ly0 = bf + 2 * SLOT + 4096;
    bf16x8 hf[2];
#pragma unroll
    for (int ks = 0; ks < 2; ++ks)
#pragma unroll
      for (int j = 0; j < 4; ++j) {
        hf[ks][j] = (short)f2bf(hacc[2 * ks][j]);
        hf[ks][4 + j] = (short)f2bf(hacc[2 * ks + 1][j]);
      }
    f32x4 y[4];
#pragma unroll
    for (int tt = 0; tt < 4; ++tt) {
      y[tt] = unpack4(*(const u16x4*)(Ly0 + ((tt * 4 + wid) * 64 + lane) * 4));
#pragma unroll
      for (int ks = 0; ks < 2; ++ks) {
        const u16x4 lo = *(const u16x4*)(Lyh + (tt * 16 + fr) * RLD + ks * 32 + fq * 4);
        const u16x4 hi = *(const u16x4*)(Lyh + (tt * 16 + fr) * RLD + ks * 32 + 16 + fq * 4);
        bf16x8 yF;
#pragma unroll
        for (int j = 0; j < 4; ++j) { yF[j] = (short)lo[j]; yF[4 + j] = (short)hi[j]; }
        y[tt] = mfma16(hf[ks], yF, y[tt]);
      }
      float s1 = y[tt][0] + y[tt][1] + y[tt][2] + y[tt][3];
      float s2 = y[tt][0] * y[tt][0] + y[tt][1] * y[tt][1] + y[tt][2] * y[tt][2] + y[tt][3] * y[tt][3];
      s1 += __shfl_xor(s1, 16); s1 += __shfl_xor(s1, 32);
      s2 += __shfl_xor(s2, 16); s2 += __shfl_xor(s2, 32);
      if (fq == 0) *(float2*)(stats + ((cur * 4 + wid) * 64 + tt * 16 + fr) * 2) = make_float2(s1, s2);
    }
#pragma unroll
    for (int it = 0; it < 4; ++it) {
      const f32x4 nn = unpack4(*(const u16x4*)(Lnc + ((it * 4 + wid) * 64 + lane) * 4));
      const float4 g4 = *(const float4*)(gcs + cur * 64 + it * 16 + fq * 4);
      f32x4 a;
      a[0] = hacc[it][0] * g4.x + nn[0]; a[1] = hacc[it][1] * g4.y + nn[1];
      a[2] = hacc[it][2] * g4.z + nn[2]; a[3] = hacc[it][3] * g4.w + nn[3];
#pragma unroll
      for (int ks = 0; ks < 2; ++ks) {
        const u16x4 lo = *(const u16x4*)(Lmp + (it * 16 + fr) * RLD + ks * 32 + fq * 4);
        const u16x4 hi = *(const u16x4*)(Lmp + (it * 16 + fr) * RLD + ks * 32 + 16 + fq * 4);
        bf16x8 mF;
#pragma unroll
        for (int j = 0; j < 4; ++j) { mF[j] = (short)lo[j]; mF[4 + j] = (short)hi[j]; }
        a = mfma16(mF, hf[ks], a);
      }
      hacc[it] = a;
    }
    if (c + 1 < 64) {
      u16* nb_ = (u16*)(smem + (cur ^ 1) * BUFB);
      *(uint4*)(nb_ + lrow * RLD + lcol) = pm0; *(uint4*)(nb_ + (lrow + 32) * RLD + lcol) = pm1;
      *(uint4*)(nb_ + SLOT + lrow * RLD + lcol) = py0; *(uint4*)(nb_ + SLOT + (lrow + 32) * RLD + lcol) = py1;
      *(uint4*)(nb_ + 2 * SLOT + tid * 8) = pn0; *(uint4*)(nb_ + 2 * SLOT + (tid + 256) * 8) = pn1;
      *(uint4*)(nb_ + 2 * SLOT + 4096 + tid * 8) = pz0; *(uint4*)(nb_ + 2 * SLOT + 4096 + (tid + 256) * 8) = pz1;
      if (tid < 64) gcs[(cur ^ 1) * 64 + tid] = pregc;
    }
    __syncthreads();
#pragma unroll
    for (int tt = 0; tt < 4; ++tt) {
      float s1 = 0.f, s2 = 0.f;
#pragma unroll
      for (int w = 0; w < 4; ++w) {
        const float2 st = *(const float2*)(stats + ((cur * 4 + w) * 64 + tt * 16 + fr) * 2);
        s1 += st.x; s2 += st.y;
      }
      const float mean = s1 * (1.f / 64.f);
      const float var = fmaxf(s2 * (1.f / 64.f) - mean * mean, 0.f);
      const float rstd = rsqrtf(var + 64e-5f);
      const f32x4 bv = unpack4(bvr[tt]), g = unpack4(gr[tt]);
      f32x4 o;
      o[0] = ((y[tt][0] - mean) * rstd * lw.x + lb.x + bv[0]) * g[0];
      o[1] = ((y[tt][1] - mean) * rstd * lw.y + lb.y + bv[1]) * g[1];
      o[2] = ((y[tt][2] - mean) * rstd * lw.z + lb.z + bv[2]) * g[2];
      o[3] = ((y[tt][3] - mean) * rstd * lw.w + lb.w + bv[3]) * g[3];
      *(u16x4*)(p.mix + (tg0 + tt * 16 + fr) * 1024 + cb) = pack4(o);
    }
  }
}

template <int DQK, int DV, int NMAP, bool DIFF>
DI void attn_tile(const u16* __restrict__ Q, long q_stride, const u16* __restrict__ Kg, long k_stride,
                  const u16* __restrict__ Vtg, long vt_stride, int nkt, float scale, u16* __restrict__ Out, long o_stride,
                  float lam, const float* __restrict__ subw, char* smem) {
  constexpr int KW = NMAP * DQK, KLD = KW + 8, VLD = 72;
  u16* Ks = (u16*)smem;
  u16* Vs = Ks + 64 * KLD;
  const int tid = threadIdx.x, lane = tid & 63, wid = tid >> 6, fr = lane & 15, fq = lane >> 4;
  bf16x8 qf[NMAP][DQK / 32];
#pragma unroll
  for (int m = 0; m < NMAP; ++m)
#pragma unroll
    for (int ks = 0; ks < DQK / 32; ++ks)
      qf[m][ks] = *(const bf16x8*)(Q + (long)(wid * 16 + fr) * q_stride + m * DQK + ks * 32 + fq * 8);
  f32x4 o[NMAP][DV / 16];
  float mrun[NMAP], lrun[NMAP];
#pragma unroll
  for (int m = 0; m < NMAP; ++m) {
    mrun[m] = -1e30f; lrun[m] = 0.f;
#pragma unroll
    for (int dt = 0; dt < DV / 16; ++dt) o[m][dt] = (f32x4){0.f, 0.f, 0.f, 0.f};
  }
  for (int kt = 0; kt < nkt; ++kt) {
    __syncthreads();
    for (int c = tid; c < 64 * (KW / 8); c += 256) {
      const int row = c / (KW / 8), cc = (c % (KW / 8)) * 8;
      *(uint4*)(Ks + row * KLD + cc) = *(const uint4*)(Kg + (long)(kt * 64 + row) * k_stride + cc);
    }
    for (int c = tid; c < DV * 8; c += 256) {
      const int row = c >> 3, cc = (c & 7) * 8;
      *(uint4*)(Vs + row * VLD + cc) = *(const uint4*)(Vtg + (long)row * vt_stride + kt * 64 + cc);
    }
    __syncthreads();
#pragma unroll
    for (int m = 0; m < NMAP; ++m) {
      f32x4 s[4];
#pragma unroll
      for (int c = 0; c < 4; ++c) {
        s[c] = (f32x4){0.f, 0.f, 0.f, 0.f};
#pragma unroll
        for (int ks = 0; ks < DQK / 32; ++ks) {
          const bf16x8 kf = *(const bf16x8*)(Ks + (c * 16 + fr) * KLD + m * DQK + ks * 32 + fq * 8);
          s[c] = mfma16(kf, qf[m][ks], s[c]);
        }
      }
      float mx = -1e30f;
#pragma unroll
      for (int c = 0; c < 4; ++c)
#pragma unroll
        for (int j = 0; j < 4; ++j) mx = fmaxf(mx, s[c][j]);
      mx = fmaxf(mx, __shfl_xor(mx, 16));
      mx = fmaxf(mx, __shfl_xor(mx, 32));
      mx *= scale;
      const float mnew = fmaxf(mrun[m], mx);
      const float alpha = __expf(mrun[m] - mnew);
      mrun[m] = mnew;
      float psum = 0.f;
#pragma unroll
      for (int c = 0; c < 4; ++c)
#pragma unroll
        for (int j = 0; j < 4; ++j) { s[c][j] = __expf(s[c][j] * scale - mnew); psum += s[c][j]; }
      lrun[m] = lrun[m] * alpha + psum;
#pragma unroll
      for (int dt = 0; dt < DV / 16; ++dt) o[m][dt] *= alpha;
#pragma unroll
      for (int k2 = 0; k2 < 2; ++k2) {
        bf16x8 pb;
#pragma unroll
        for (int j = 0; j < 4; ++j) { pb[j] = (short)f2bf(s[2 * k2][j]); pb[4 + j] = (short)f2bf(s[2 * k2 + 1][j]); }
#pragma unroll
        for (int dt = 0; dt < DV / 16; ++dt) {
          const u16x4 lo = *(const u16x4*)(Vs + (dt * 16 + fr) * VLD + k2 * 32 + fq * 4);
          const u16x4 hi = *(const u16x4*)(Vs + (dt * 16 + fr) * VLD + k2 * 32 + 16 + fq * 4);
          bf16x8 vf;
#pragma unroll
          for (int j = 0; j < 4; ++j) { vf[j] = (short)lo[j]; vf[4 + j] = (short)hi[j]; }
          o[m][dt] = mfma16(vf, pb, o[m][dt]);
        }
      }
    }
  }
  float linv[NMAP];
#pragma unroll
  for (int m = 0; m < NMAP; ++m) {
    float l = lrun[m];
    l += __shfl_xor(l, 16);
    l += __shfl_xor(l, 32);
    linv[m] = 1.f / l;
  }
  u16* orow = Out + (long)(wid * 16 + fr) * o_stride;
  if (DIFF) {
    float ss = 0.f;
#pragma unroll
    for (int dt = 0; dt < DV / 16; ++dt)
#pragma unroll
      for (int j = 0; j < 4; ++j) {
        const float val = o[0][dt][j] * linv[0] - lam * o[NMAP - 1][dt][j] * linv[NMAP - 1];
        o[0][dt][j] = val;
        ss += val * val;
      }
    ss += __shfl_xor(ss, 16);
    ss += __shfl_xor(ss, 32);
    const float rstd = rsqrtf(ss * (1.f / DV) + 1e-5f) * 0.8f;
#pragma unroll
    for (int dt = 0; dt < DV / 16; ++dt) {
      f32x4 r;
#pragma unroll
      for (int j = 0; j < 4; ++j) r[j] = o[0][dt][j] * rstd * subw[dt * 16 + fq * 4 + j];
      *(u16x4*)(orow + dt * 16 + fq * 4) = pack4(r);
    }
  } else {
#pragma unroll
    for (int dt = 0; dt < DV / 16; ++dt) {
      f32x4 r = o[0][dt] * linv[0];
      *(u16x4*)(orow + dt * 16 + fq * 4) = pack4(r);
    }
  }
}

constexpr int SMEM_BYTES = 80 * 1024;

__global__ void __launch_bounds__(256, 2) fwd_megakernel(Params p) {
  cg::grid_group grid = cg::this_grid();
  __shared__ __attribute__((aligned(16))) char smem[SMEM_BYTES];
  const int bid = blockIdx.x, nb = gridDim.x;

  if (bid == 0 && threadIdx.x == 0) *p.counter = 0;
  transpose_w(p.w_in, p.wt_in, 1024, 3328, bid, nb, smem);
  transpose_w(p.w_out, p.wt_out, 1024, 1024, bid, nb, smem);
  transpose_w(p.w_mq, p.wt_mq, 1024, 1024, bid, nb, smem);
  transpose_w(p.w_mk, p.wt_mk, 1024, 1024, bid, nb, smem);
  transpose_w(p.w_mv, p.wt_mv, 1024, 1024, bid, nb, smem);
  transpose_w(p.w_mo, p.wt_mo, 1024, 1024, bid, nb, smem);
  transpose_w(p.w_up, p.wt_up, 1024, 4096, bid, nb, smem);
  transpose_w(p.w_down, p.wt_down, 4096, 1024, bid, nb, smem);
  transpose_w(p.w_dec_up, p.wt_dec, 64, 512, bid, nb, smem);
  transpose_w(p.a_up, p.wt_a, 64, 512, bid, nb, smem);
  transpose_w(p.g_up, p.wt_g, 128, 512, bid, nb, smem);
  rmsnorm_phase<true>(p.x, p.norm_mix_w, p.xn, T_TOK, bid, nb);
  rmsnorm_phase<true>(p.mem, p.norm_src_w, p.memn, 2048, bid, nb);
  grid.sync();

  gemm_phase<22>(p.xn, 1024, p.wt_in, 1024, T_TOK, 3328, 1024, EpiWin{p.pr, p.qkd, p.vt}, bid, nb, smem, p.vt);
  gemm_phase<-1>(p.memn, 1024, p.wt_mk, 1024, 2048, 1024, 1024, EpiBf16{p.kmem, 1024}, bid, nb, smem);
  gemm_phase<-1>(p.memn, 1024, p.wt_mv, 1024, 2048, 1024, 1024, EpiVtMem{p.vtmem}, bid, nb, smem);
  grid.sync();

  rwkv_prep_phase(p, bid, nb);
  grid.sync();

  gemm_phase<-1>(p.lora_in, 256, p.wt_dec, 64, T_TOK, 512, 64, EpiDecay{p.e_buf, p.w0}, bid, nb, smem);
  gemm_phase<-1>(p.lora_in + 64, 256, p.wt_a, 64, T_TOK, 512, 64, EpiASig{p.asig, p.a0}, bid, nb, smem);
  gemm_phase<-1>(p.lora_in + 128, 256, p.wt_g, 128, T_TOK, 512, 128, EpiBf16{p.gbuf, 512}, bid, nb, smem);
  grid.sync();

  for (int tile = bid; tile < 4096; tile += nb) rwkv_chunk_prep(p, tile, smem);
  grid.sync();
  if (bid < 64) rwkv_state_pass(p, bid, smem);
  {
    float d1 = 0.f, d2 = 0.f;
    for (int i = 0; i < 64; ++i) { d1 += p.lam_q1[i] * p.lam_k1[i]; d2 += p.lam_q2[i] * p.lam_k2[i]; }
    const float lam = __expf(d1) - __expf(d2) + 0.2f;
    int* qidx = (int*)(smem + SMEM_BYTES - 16);
    for (;;) {
      __syncthreads();
      if (threadIdx.x == 0) *qidx = atomicAdd(p.counter, 1);
      __syncthreads();
      const int idx = *qidx;
      if (idx >= 2048) break;
      const int qc = 63 - (idx >> 5), bh = idx & 31, b = bh >> 2, h = bh & 3;
      const long tq = (long)b * 4096 + qc * 64;
      attn_tile<64, 128, 2, true>(p.qkd + tq * 1024 + h * 128, 1024, p.qkd + (long)b * 4096 * 1024 + 512 + h * 128, 1024,
                                  p.vt + (long)(b * 512 + h * 128) * 4096, 4096, qc + 1, 0.125f,
                                  p.mix + tq * 1024 + 512 + h * 128, 1024, lam, p.subln_w, smem);
    }
  }
  grid.sync();

  gemm_phase<-1>(p.mix, 1024, p.wt_out, 1024, T_TOK, 1024, 1024, EpiResX{p.out, p.x}, bid, nb, smem);
  grid.sync();
  rmsnorm_phase<true>(p.out, p.norm_mem_w, p.xn, T_TOK, bid, nb);
  grid.sync();
  gemm_phase<-1>(p.xn, 1024, p.wt_mq, 1024, T_TOK, 1024, 1024, EpiBf16{p.qmem, 1024}, bid, nb, smem);
  grid.sync();
  for (int idx = bid; idx < 2048; idx += nb) {
    const int tt = idx >> 2, h = idx & 3;
    const long t0 = (long)tt * 64;
    const int b = (int)(t0 >> 12);
    attn_tile<256, 256, 1, false>(p.qmem + t0 * 1024 + h * 256, 1024, p.kmem + (long)b * 256 * 1024 + h * 256, 1024,
                                  p.vtmem + (long)(b * 1024 + h * 256) * 256, 256, 4, 0.0625f,
                                  p.mix + t0 * 1024 + h * 256, 1024, 0.f, p.subln_w, smem);
  }
  grid.sync();
  gemm_phase<-1>(p.mix, 1024, p.wt_mo, 1024, T_TOK, 1024, 1024, EpiResAcc{p.out}, bid, nb, smem);
  grid.sync();
  rmsnorm_phase<true>(p.out, p.norm_mlp_w, p.xn, T_TOK, bid, nb);
  grid.sync();
  gemm_phase<-1>(p.xn, 1024, p.wt_up, 1024, T_TOK, 4096, 1024, EpiRelu2{p.hid}, bid, nb, smem);
  grid.sync();
  gemm_phase<-1>(p.hid, 4096, p.wt_down, 4096, T_TOK, 1024, 4096, EpiResAcc{p.out}, bid, nb, smem);
  grid.sync();
  rmsnorm_phase<false>(p.out, p.norm_final_w, p.out, T_TOK, bid, nb);
}

extern "C" void kernel_launch(void* const* d_in, const int* in_sizes, int n_in, void* d_out, int out_size, void* d_ws,
                              size_t ws_size, hipStream_t stream) {
  static int grid_blocks = 0;
  if (!grid_blocks) {
    int dev = 0, cus = 0, per_cu = 0;
    hipGetDevice(&dev);
    hipDeviceGetAttribute(&cus, hipDeviceAttributeMultiprocessorCount, dev);
    hipOccupancyMaxActiveBlocksPerMultiprocessor(&per_cu, fwd_megakernel, 256, 0);
    if (per_cu > 2) per_cu = 2;
    if (per_cu < 1) per_cu = 1;
    grid_blocks = cus * per_cu;
  }
  Params p{};
  const float* const* in = (const float* const*)d_in;
  p.x = in[0]; p.mem = in[1]; p.norm_mix_w = in[2]; p.w_in = in[3]; p.mu = in[4]; p.w0 = in[5]; p.w_dec_up = in[6];
  p.a0 = in[7]; p.a_up = in[8]; p.g_up = in[9]; p.k_k = in[10]; p.k_a = in[11]; p.r_k = in[12]; p.lnx_w = in[13];
  p.lnx_b = in[14]; p.lam_q1 = in[15]; p.lam_k1 = in[16]; p.lam_q2 = in[17]; p.lam_k2 = in[18]; p.subln_w = in[19];
  p.w_out = in[20]; p.norm_mem_w = in[21]; p.norm_src_w = in[22]; p.w_mq = in[23]; p.w_mk = in[24]; p.w_mv = in[25];
  p.w_mo = in[26]; p.norm_mlp_w = in[27]; p.w_up = in[28]; p.w_down = in[29]; p.norm_final_w = in[30];
  p.out = (float*)d_out;
  char* ws = (char*)d_ws;
  u16* wbase = (u16*)ws;
  long o = 0;
  p.wt_in = wbase + o; o += 3328L * 1024;
  p.wt_out = wbase + o; o += 1024L * 1024;
  p.wt_mq = wbase + o; o += 1024L * 1024;
  p.wt_mk = wbase + o; o += 1024L * 1024;
  p.wt_mv = wbase + o; o += 1024L * 1024;
  p.wt_mo = wbase + o; o += 1024L * 1024;
  p.wt_up = wbase + o; o += 4096L * 1024;
  p.wt_down = wbase + o; o += 4096L * 1024;
  p.wt_dec = wbase + o; o += 512L * 64;
  p.wt_a = wbase + o; o += 512L * 64;
  p.wt_g = wbase + o; o += 512L * 128;
  p.xn = (u16*)(ws + 34 * MiB);
  char* big = ws + 98 * MiB;
  p.pr = (u16*)big;
  p.qkd = (u16*)(big + 112 * MiB);
  p.vt = (u16*)(big + 176 * MiB);
  p.hid = (u16*)big;
  p.mix = (u16*)(ws + 354 * MiB);
  p.qmem = (u16*)(ws + 418 * MiB);
  p.memn = (u16*)(ws + 482 * MiB);
  p.kmem = (u16*)(ws + 486 * MiB);
  p.vtmem = (u16*)(ws + 490 * MiB);
  p.lora_in = (u16*)(ws + 494 * MiB);
  p.e_buf = (float*)d_out;
  p.asig = (u16*)((char*)d_out + 64 * MiB);
  p.gbuf = (u16*)((char*)d_out + 96 * MiB);
  p.c_mp = p.xn; p.c_yh = p.xn + 4096L * 4096;
  p.c_nc = p.qmem; p.c_y0 = p.qmem + 4096L * 4096;
  p.counter = (int*)(ws + 511 * MiB);
  p.c_gc = (float*)p.lora_in;
  void* args[] = {&p};
  hipError_t e = hipLaunchCooperativeKernel((void*)fwd_megakernel, dim3(grid_blocks), dim3(256), args, 0, stream);
  if (e != hipSuccess) fprintf(stderr, "cooperative launch failed: %s (grid %d)\n", hipGetErrorString(e), grid_blocks);
}
```

```cpp
#include <hip/hip_runtime.h>
#include <hip/hip_cooperative_groups.h>
#include <cstdio>
namespace cg = cooperative_groups;

#define DI __device__ __forceinline__
typedef unsigned short u16;
using bf16x8 = __attribute__((ext_vector_type(8))) short;
using f32x4 = __attribute__((ext_vector_type(4))) float;
using u16x4 = __attribute__((ext_vector_type(4))) unsigned short;
using u32x4 = __attribute__((ext_vector_type(4))) unsigned;

constexpr int T_TOK = 32768, SEQ = 4096, DM = 1024;
constexpr long MiB = 1024L * 1024L;

typedef float f32x2_t __attribute__((ext_vector_type(2)));
typedef __bf16 bf16x2_t __attribute__((ext_vector_type(2)));
DI unsigned cvtpk(float lo, float hi) { const f32x2_t v = {lo, hi}; return __builtin_bit_cast(unsigned, __builtin_convertvector(v, bf16x2_t)); }
using u32x2 = __attribute__((ext_vector_type(2))) unsigned;
DI u16 f2bf(float x) { return (u16)(cvtpk(x, x) & 0xffffu); }
DI float bf2f(u16 h) { return __uint_as_float(((unsigned)h) << 16); }
DI float wave_sum(float v) {
#pragma unroll
  for (int o = 32; o > 0; o >>= 1) v += __shfl_xor(v, o);
  return v;
}
DI f32x4 mfma16(bf16x8 a, bf16x8 b, f32x4 c) { return __builtin_amdgcn_mfma_f32_16x16x32_bf16(a, b, c, 0, 0, 0); }
DI u16x4 pack4(f32x4 v) { u32x2 w; w[0] = cvtpk(v[0], v[1]); w[1] = cvtpk(v[2], v[3]); return __builtin_bit_cast(u16x4, w); }
DI void unpack8(uint4 w, float* o) {
  o[0] = __uint_as_float(w.x << 16); o[1] = __uint_as_float(w.x & 0xffff0000u);
  o[2] = __uint_as_float(w.y << 16); o[3] = __uint_as_float(w.y & 0xffff0000u);
  o[4] = __uint_as_float(w.z << 16); o[5] = __uint_as_float(w.z & 0xffff0000u);
  o[6] = __uint_as_float(w.w << 16); o[7] = __uint_as_float(w.w & 0xffff0000u);
}
DI unsigned pk2(float a, float b) { return cvtpk(a, b); }

struct Params {
  const float *x, *mem, *norm_mix_w, *w_in, *mu, *w0, *w_dec_up, *a0, *a_up, *g_up, *k_k, *k_a, *r_k, *lnx_w, *lnx_b;
  const float *lam_q1, *lam_k1, *lam_q2, *lam_k2, *subln_w, *w_out, *norm_mem_w, *norm_src_w, *w_mq, *w_mk, *w_mv, *w_mo;
  const float *norm_mlp_w, *w_up, *w_down, *norm_final_w;
  float* out;
  u16 *wt_in, *wt_out, *wt_mq, *wt_mk, *wt_mv, *wt_mo, *wt_up, *wt_down, *wt_dec, *wt_a, *wt_g;
  u16 *xn, *pr, *qkd, *vt, *hid, *mix, *qmem, *memn, *kmem, *vtmem, *lora_in;
  float* e_buf; u16 *asig, *gbuf;
  u16 *c_mp, *c_yh, *c_nc, *c_y0; float* c_gc;
  int* counter; u16* vrm; float *ss1, *ss2, *ss3; unsigned* gbar;
  long never;
};

__device__ __forceinline__ int tidx_fresh() { int t = (int)(threadIdx.x & 255u); asm volatile("" : "+v"(t)); return t; }
#define TIDX tidx_fresh()

namespace pg8 {
#define PG8_LAS __attribute__((address_space(3)))
typedef unsigned short bf16_t;
typedef short bf16x8 __attribute__((ext_vector_type(8)));
typedef float f32x4 __attribute__((ext_vector_type(4)));
typedef unsigned u32x4 __attribute__((ext_vector_type(4)));
constexpr int BM = 256, BK = 64, HALF = 128, HTB = HALF * BK * 2  , STAGE_BYTES = 8 * HTB, NXCD = 8, WGM = 8;

__host__ __device__ __forceinline__ int lds_byte(int r, int c) { const int st = (r >> 4) * 2 + (c >> 5), rr = r & 15, cc = c & 31, ob = rr * 64 + cc * 2; return st * 1024 + (ob ^ (((ob >> 9) & 1) << 5)); }
__host__ __device__ __forceinline__ void stage_rc(int b, int& R, int& C) { const int st = b / 1024, sb = b % 1024, swz = sb ^ (((sb >> 9) & 1) << 5); R = (st >> 1) * 16 + swz / 64; C = (st & 1) * 32 + (swz % 64) / 2; }
__host__ __device__ __forceinline__ int perm32(int rho) { const int n = rho >> 4, i = rho & 15; return 8 * (i >> 2) + 4 * n + (i & 3); }

struct Unit { int pm, pn; };
struct Gemm { const bf16_t* A; const bf16_t* Bt; int M, N, K; };

struct StaticOrder {
    int nM, nN, nwg, G, c;
    __host__ __device__ void init(int M, int N, int G_, int c_) { nM = M / BM; nN = N / BM; nwg = nM * nN; G = G_; c = c_; }
    __host__ __device__ bool next(int i, Unit& u) const {
        const long L = (long)i * G + c; if (L >= nwg) return false;
        int wgid = (int)L; { const int q = nwg / NXCD, r = nwg % NXCD, xcd = wgid % NXCD, off = wgid / NXCD; wgid = (xcd < r ? xcd * (q + 1) : r * (q + 1) + (xcd - r) * q) + off; }
        const int nig = WGM * nN, gid = wgid / nig, fm = gid * WGM, gsz = (nM - fm) < WGM ? (nM - fm) : WGM;
        u.pm = fm + ((wgid % nig) % gsz); u.pn = (wgid % nig) / gsz; return true;
    }
    __device__ __forceinline__ void a_ready(const Unit&) const {}
    __device__ __forceinline__ void done(const Unit&) const {}
};
__device__ __forceinline__ unsigned cvt_pk_bf16(float lo, float hi) { unsigned r; asm volatile("v_cvt_pk_bf16_f32 %0, %1, %2" : "=v"(r) : "v"(lo), "v"(hi)); return r; }
template <class Epi, class Sched, bool STAMP = false>
__device__ __forceinline__ void gemm_phase(PG8_LAS unsigned char* lds, const Gemm g, const Sched& S, const Epi& E, unsigned long long* stamps) {
    const int tid = threadIdx.x, wid = __builtin_amdgcn_readfirstlane(tid >> 6), lane = tid & 63, wr = wid >> 2, wc = wid & 3, fr = lane & 15, fq = lane >> 4;
    const int K = g.K, nt = K / BK;
    int ts_lo = 0, ts_hi = 0, nts = 0; const unsigned long long rt_entry = STAMP ? (unsigned long long)wall_clock64() : 0ull;
#define PG8_STAMP() do { if (STAMP && wid == 0 && nts < 64) { const unsigned long long _c = (unsigned long long)clock64(); \
        ts_lo = (lane == nts) ? (int)(unsigned)_c : ts_lo; ts_hi = (lane == nts) ? (int)(unsigned)(_c >> 32) : ts_hi; ++nts; } } while (0)
    PG8_STAMP();
    unsigned voffA[2], voffB[2];
#pragma unroll
    for (int i = 0; i < 2; ++i) { int R, C; stage_rc(tid * 16 + i * 8192, R, C); const int Rb = Epi::PERM ? ((R & ~31) + perm32(R & 31)) : R;
        voffA[i] = (unsigned)(R * K + C) * 2u; voffB[i] = (unsigned)(Rb * K + C) * 2u; }
    const size_t kstep = (size_t)(BK * 2);
    const size_t hstep = (size_t)HALF * K * 2;
    const size_t tstep = 2 * hstep;
    const unsigned ldsw = (unsigned)wid * 1024u;
    const int aoff = lds_byte(wr * 64 + fr, fq * 8), boff = lds_byte(wc * 32 + fr, fq * 8);
#define PG8_SA(b, h) (((b) * 2 + (h)) * HTB)
#define PG8_SB(b, h) ((4 + (b) * 2 + (h)) * HTB)
#define PG8_STAGE(bufoff, gbase, voff) do { _Pragma("unroll") for (int _i = 0; _i < 2; ++_i) \
        __builtin_amdgcn_global_load_lds((const unsigned*)((const char*)(gbase) + (voff)[_i]), (PG8_LAS unsigned*)(lds + (bufoff) + ldsw + _i * 8192), 16, 0, 0); } while (0)
#define PG8_LDA(dst, b, h) do { _Pragma("unroll") for (int m = 0; m < 4; ++m) _Pragma("unroll") for (int k = 0; k < 2; ++k) dst[m][k] = *(const PG8_LAS bf16x8*)(lds + PG8_SA(b, h) + aoff + m * 2048 + k * 1024); } while (0)
#define PG8_LDB(dst, b, h) do { _Pragma("unroll") for (int n = 0; n < 2; ++n) _Pragma("unroll") for (int k = 0; k < 2; ++k) dst[n][k] = *(const PG8_LAS bf16x8*)(lds + PG8_SB(b, h) + boff + n * 2048 + k * 1024); } while (0)
#define PG8_MMA(ai, bj, At, Bt) do { __builtin_amdgcn_s_setprio(1); _Pragma("unroll") for (int m = 0; m < 4; ++m) _Pragma("unroll") for (int n = 0; n < 2; ++n) _Pragma("unroll") for (int k = 0; k < 2; ++k) \
        acc[ai][bj][m][n] = __builtin_amdgcn_mfma_f32_16x16x32_bf16(Bt[n][k], At[m][k], acc[ai][bj][m][n], 0, 0, 0); __builtin_amdgcn_s_setprio(0); } while (0)
#define PG8_WAIT_V(n) asm volatile("s_waitcnt vmcnt(" #n ")" ::: "memory")
#define PG8_WAIT_L(n) asm volatile("s_waitcnt lgkmcnt(" #n ")" ::: "memory")
#define PG8_BAR __builtin_amdgcn_s_barrier()
#define PG8_SCHED __builtin_amdgcn_sched_barrier(0)
    Unit cur, nxt; int ui = 0;
    if (!S.next(0, cur)) return;
    f32x4 acc[2][2][4][2];
#pragma unroll
    for (int a = 0; a < 2; ++a)
#pragma unroll
        for (int b = 0; b < 2; ++b)
#pragma unroll
            for (int m = 0; m < 4; ++m)
#pragma unroll
                for (int n = 0; n < 2; ++n) acc[a][b][m][n] = (f32x4){0.f, 0.f, 0.f, 0.f};
    bf16x8 At[4][2], B0[2][2], B1[2][2];
    const char* cA = (const char*)g.A + (size_t)cur.pm * tstep; const char* cB = (const char*)g.Bt + (size_t)cur.pn * tstep;
    S.a_ready(cur);
    PG8_STAGE(PG8_SB(0, 0), cB, voffB); PG8_STAGE(PG8_SA(0, 0), cA, voffA); PG8_STAGE(PG8_SB(0, 1), cB + hstep, voffB); PG8_STAGE(PG8_SA(0, 1), cA + hstep, voffA);
    if (wr == 1) PG8_BAR;
    PG8_WAIT_V(4); PG8_BAR;
    PG8_STAGE(PG8_SB(1, 0), cB + kstep, voffB); PG8_STAGE(PG8_SA(1, 0), cA + kstep, voffA); PG8_STAGE(PG8_SB(1, 1), cB + hstep + kstep, voffB);
    PG8_WAIT_V(6); PG8_BAR;
    PG8_STAMP();
    for (;;) {
        const bool has_next = S.next(ui + 1, nxt);
        const char* nA = has_next ? (const char*)g.A + (size_t)nxt.pm * tstep : cA; const char* nB = has_next ? (const char*)g.Bt + (size_t)nxt.pn * tstep : cB;
        for (int t = 0; t < nt; t += 2) {
            const bool last = (t == nt - 2);
            const char* a1 = cA + (size_t)(t + 1) * kstep;
            const char* a2 = last ? nA : cA + (size_t)(t + 2) * kstep; const char* b2 = last ? nB : cB + (size_t)(t + 2) * kstep;
            const char* a3 = a2 + kstep; const char* b3 = b2 + kstep;
            if (last && has_next) S.a_ready(nxt);
            PG8_LDB(B0, 0, 0); PG8_SCHED; PG8_LDA(At, 0, 0); PG8_STAGE(PG8_SA(1, 1), a1 + hstep, voffA);
            PG8_WAIT_L(8); PG8_BAR; PG8_WAIT_L(0); PG8_MMA(0, 0, At, B0); PG8_BAR; PG8_SCHED;
            PG8_LDB(B1, 0, 1); PG8_STAGE(PG8_SB(0, 0), b2, voffB);
            PG8_BAR; PG8_WAIT_L(0); PG8_MMA(0, 1, At, B1); PG8_BAR;
            PG8_LDA(At, 0, 1); PG8_STAGE(PG8_SA(0, 0), a2, voffA);
            PG8_BAR; PG8_WAIT_L(0); PG8_MMA(1, 0, At, B0); PG8_BAR; PG8_SCHED;
            PG8_STAGE(PG8_SB(0, 1), b2 + hstep, voffB);
            PG8_WAIT_V(6); PG8_BAR; PG8_MMA(1, 1, At, B1); PG8_BAR;
            PG8_LDB(B0, 1, 0); PG8_SCHED; PG8_LDA(At, 1, 0); PG8_STAGE(PG8_SA(0, 1), a2 + hstep, voffA);
            PG8_WAIT_L(8); PG8_BAR; PG8_WAIT_L(0); PG8_MMA(0, 0, At, B0); PG8_BAR; PG8_SCHED;
            PG8_LDB(B1, 1, 1); PG8_STAGE(PG8_SB(1, 0), b3, voffB);
            PG8_BAR; PG8_WAIT_L(0); PG8_MMA(0, 1, At, B1); PG8_BAR;
            PG8_LDA(At, 1, 1); PG8_STAGE(PG8_SA(1, 0), a3, voffA);
            PG8_BAR; PG8_WAIT_L(0); PG8_MMA(1, 0, At, B0); PG8_BAR; PG8_SCHED;
            PG8_STAGE(PG8_SB(1, 1), b3 + hstep, voffB);
            PG8_WAIT_V(6); PG8_BAR; PG8_MMA(1, 1, At, B1); PG8_BAR;
        }
        PG8_STAMP();
        if constexpr (!Epi::AFTER_DRAIN) { E(acc, cur, wr, wc, fr, fq); S.done(cur); }
        PG8_STAMP();
        if (!has_next) break;
#pragma unroll
        for (int a = 0; a < 2; ++a)
#pragma unroll
            for (int b = 0; b < 2; ++b)
#pragma unroll
                for (int m = 0; m < 4; ++m)
#pragma unroll
                    for (int n = 0; n < 2; ++n) acc[a][b][m][n] = (f32x4){0.f, 0.f, 0.f, 0.f};
        cur = nxt; cA = nA; cB = nB; ++ui;
    }
    PG8_WAIT_V(0);
    if (wr == 0) PG8_BAR;
    PG8_BAR;
    if constexpr (Epi::AFTER_DRAIN) { E.fused(acc, cur, wr, wc, fr, fq, lds, wid, lane); S.done(cur); }
    PG8_STAMP();
    if (STAMP && wid == 0) { stamps[lane] = lane < nts ? (((unsigned long long)(unsigned)ts_hi << 32) | (unsigned)ts_lo) : 0ull;
        if (lane == 62) stamps[62] = rt_entry; if (lane == 63) stamps[63] = (unsigned long long)wall_clock64(); }
#undef PG8_STAMP
#undef PG8_SA
#undef PG8_SB
#undef PG8_STAGE
#undef PG8_LDA
#undef PG8_LDB
#undef PG8_MMA
#undef PG8_WAIT_V
#undef PG8_WAIT_L
#undef PG8_BAR
#undef PG8_SCHED
}

struct EpiWinP {
    static constexpr bool PERM = true, AFTER_DRAIN = false;
    bf16_t *pr, *qkd, *vrm;
    __device__ __forceinline__ void operator()(const f32x4 (&acc)[2][2][4][2], const Unit& u, int wr, int wc, int fr, int fq) const {
        const int row0 = u.pm * BM + wr * 64 + fr;
        bf16_t* base; int ldc, colt;
        if (u.pn < 7) { base = pr; ldc = 1792; colt = u.pn * 256; }
        else if (u.pn < 11) { base = qkd; ldc = 1024; colt = (u.pn - 7) * 256; }
        else { base = vrm; ldc = 512; colt = (u.pn - 11) * 256; }
        const int col0 = colt + wc * 32 + 8 * fq;
#pragma unroll
        for (int ai = 0; ai < 2; ++ai)
#pragma unroll
            for (int m = 0; m < 4; ++m) { bf16_t* rowp = base + (size_t)(row0 + ai * HALF + m * 16) * ldc + col0;
#pragma unroll
                for (int bj = 0; bj < 2; ++bj) { const f32x4 v0 = acc[ai][bj][m][0], v1 = acc[ai][bj][m][1];
                    u32x4 w; w.x = cvt_pk_bf16(v0[0], v0[1]); w.y = cvt_pk_bf16(v0[2], v0[3]); w.z = cvt_pk_bf16(v1[0], v1[1]); w.w = cvt_pk_bf16(v1[2], v1[3]);
                    *(u32x4*)(rowp + bj * HALF) = w; } }
    }
};
template <int ACT  > struct EpiBf16P {
    static constexpr bool PERM = true, AFTER_DRAIN = false;
    bf16_t* O; int ldc;
    __device__ __forceinline__ void operator()(const f32x4 (&acc)[2][2][4][2], const Unit& u, int wr, int wc, int fr, int fq) const {
        const int row0 = u.pm * BM + wr * 64 + fr, col0 = u.pn * BM + wc * 32 + 8 * fq;
#pragma unroll
        for (int ai = 0; ai < 2; ++ai)
#pragma unroll
            for (int m = 0; m < 4; ++m) { bf16_t* rowp = O + (size_t)(row0 + ai * HALF + m * 16) * ldc + col0;
#pragma unroll
                for (int bj = 0; bj < 2; ++bj) { f32x4 v0 = acc[ai][bj][m][0], v1 = acc[ai][bj][m][1];
                    if (ACT == 1) {
#pragma unroll
                        for (int j = 0; j < 4; ++j) { const float a = fmaxf(v0[j], 0.f), b = fmaxf(v1[j], 0.f); v0[j] = a * a; v1[j] = b * b; } }
                    u32x4 w; w.x = cvt_pk_bf16(v0[0], v0[1]); w.y = cvt_pk_bf16(v0[2], v0[3]); w.z = cvt_pk_bf16(v1[0], v1[1]); w.w = cvt_pk_bf16(v1[2], v1[3]);
                    *(u32x4*)(rowp + bj * HALF) = w; } }
    }
};
struct EpiResP {
    static constexpr bool PERM = false, AFTER_DRAIN = false;
    float* H; const float* R;
    __device__ __forceinline__ void operator()(const f32x4 (&acc)[2][2][4][2], const Unit& u, int wr, int wc, int fr, int fq) const {
        const int row0 = u.pm * BM + wr * 64 + fr, col0 = u.pn * BM + wc * 32 + 4 * fq;
#pragma unroll
        for (int ai = 0; ai < 2; ++ai)
#pragma unroll
            for (int m = 0; m < 4; ++m) { const size_t ro = (size_t)(row0 + ai * HALF + m * 16) * 1024 + col0;
#pragma unroll
                for (int bj = 0; bj < 2; ++bj)
#pragma unroll
                    for (int n = 0; n < 2; ++n) { const f32x4 rv = *(const f32x4*)(R + ro + bj * HALF + n * 16);
                        *(f32x4*)(H + ro + bj * HALF + n * 16) = rv + acc[ai][bj][m][n]; } }
    }
};

template <bool RBF, bool WF32, bool WBF> struct EpiResNormP {
    static constexpr bool PERM = false, AFTER_DRAIN = false;
    float* H; const void* R; bf16_t* XB; float* SS;
    __device__ __forceinline__ void operator()(const f32x4 (&acc)[2][2][4][2], const Unit& u, int wr, int wc, int fr, int fq) const {
        const int row0 = u.pm * BM + wr * 64 + fr, col0 = u.pn * BM + wc * 32 + 4 * fq;
#pragma unroll
        for (int ai = 0; ai < 2; ++ai)
#pragma unroll
            for (int m = 0; m < 4; ++m) { const int row = row0 + ai * HALF + m * 16; const size_t ro = (size_t)row * 1024 + col0;
                float ss = 0.f;
#pragma unroll
                for (int bj = 0; bj < 2; ++bj)
#pragma unroll
                    for (int n = 0; n < 2; ++n) { const size_t o = ro + bj * HALF + n * 16;
                        f32x4 rv;
                        if (RBF) { const uint2 rb = *(const uint2*)((const bf16_t*)R + o);
                            rv[0] = __uint_as_float(rb.x << 16); rv[1] = __uint_as_float(rb.x & 0xffff0000u); rv[2] = __uint_as_float(rb.y << 16); rv[3] = __uint_as_float(rb.y & 0xffff0000u); }
                        else rv = *(const f32x4*)((const float*)R + o);
                        const f32x4 hv = rv + acc[ai][bj][m][n];
                        if (WF32) *(f32x4*)(H + o) = hv;
                        if (WBF) { uint2 w; w.x = cvt_pk_bf16(hv[0], hv[1]); w.y = cvt_pk_bf16(hv[2], hv[3]);
                            *(uint2*)(XB + o) = w;
                            ss += hv[0] * hv[0] + hv[1] * hv[1] + hv[2] * hv[2] + hv[3] * hv[3]; } }
                if (WBF) { ss += __shfl_xor(ss, 16); ss += __shfl_xor(ss, 32);
                    if (fq == 0) atomicAdd(SS + row, ss); } }
    }
};
template <int ACT  > struct EpiBf16NormP {
    static constexpr bool PERM = true, AFTER_DRAIN = false;
    bf16_t* O; int ldc; const float* SS;
    __device__ __forceinline__ void operator()(const f32x4 (&acc)[2][2][4][2], const Unit& u, int wr, int wc, int fr, int fq) const {
        const int row0 = u.pm * BM + wr * 64 + fr, col0 = u.pn * BM + wc * 32 + 8 * fq;
#pragma unroll
        for (int ai = 0; ai < 2; ++ai)
#pragma unroll
            for (int m = 0; m < 4; ++m) { const int row = row0 + ai * HALF + m * 16; bf16_t* rowp = O + (size_t)row * ldc + col0;
                const float rs = rsqrtf(SS[row] * (1.f / 1024.f) + 1e-5f);
#pragma unroll
                for (int bj = 0; bj < 2; ++bj) { f32x4 v0 = acc[ai][bj][m][0] * rs, v1 = acc[ai][bj][m][1] * rs;
                    if (ACT == 1) {
#pragma unroll
                        for (int j = 0; j < 4; ++j) { const float a = fmaxf(v0[j], 0.f), b = fmaxf(v1[j], 0.f); v0[j] = a * a; v1[j] = b * b; } }
                    u32x4 w; w.x = cvt_pk_bf16(v0[0], v0[1]); w.y = cvt_pk_bf16(v0[2], v0[3]); w.z = cvt_pk_bf16(v1[0], v1[1]); w.w = cvt_pk_bf16(v1[2], v1[3]);
                    *(u32x4*)(rowp + bj * HALF) = w; } }
    }
};
}


DI void transpose_w(const float* __restrict__ W, u16* __restrict__ Wt, int K, int N, int bid, int nb, char* smem,
                    const float* __restrict__ kscale = nullptr) {
  float(*tile)[65] = (float(*)[65])smem;
  const int tid = TIDX;
  const int tn = N / 64, nt = (K / 64) * tn;
  for (int t = bid; t < nt; t += nb) {
    const int k0 = (t / tn) * 64, n0 = (t % tn) * 64;
#pragma unroll
    for (int i = 0; i < 4; ++i) {
      const int r = (tid >> 4) + i * 16, c = (tid & 15) * 4;
      const float4 v = *(const float4*)(W + (long)(k0 + r) * N + n0 + c);
      const float sc = kscale ? kscale[k0 + r] : 1.f;
      tile[r][c] = v.x * sc; tile[r][c + 1] = v.y * sc; tile[r][c + 2] = v.z * sc; tile[r][c + 3] = v.w * sc;
    }
    __syncthreads();
#pragma unroll
    for (int i = 0; i < 2; ++i) {
      const int c = tid + i * 256, n = c >> 3, kk = (c & 7) * 8;
      uint4 o;
      o.x = f2bf(tile[kk][n]) | ((unsigned)f2bf(tile[kk + 1][n]) << 16);
      o.y = f2bf(tile[kk + 2][n]) | ((unsigned)f2bf(tile[kk + 3][n]) << 16);
      o.z = f2bf(tile[kk + 4][n]) | ((unsigned)f2bf(tile[kk + 5][n]) << 16);
      o.w = f2bf(tile[kk + 6][n]) | ((unsigned)f2bf(tile[kk + 7][n]) << 16);
      *(uint4*)(Wt + (long)(n0 + n) * K + k0 + kk) = o;
    }
    __syncthreads();
  }
}

template <bool BF>
DI void rmsnorm_phase(const float* in, const float* __restrict__ w, void* outp, int rows, int bid, int nb) {
  constexpr int RPW = 2;
  const int tid = TIDX, lane = tid & 63;
  const int wave = bid * 4 + (tid >> 6), nw = nb * 4;
  float4 wv[4];
#pragma unroll
  for (int i = 0; i < 4; ++i) wv[i] = ((const float4*)w)[lane + i * 64];
  float4 v[RPW][4], nv[RPW][4];
  int row0 = wave * RPW;
  if (row0 < rows) {
#pragma unroll
    for (int r = 0; r < RPW; ++r)
#pragma unroll
      for (int i = 0; i < 4; ++i) nv[r][i] = ((const float4*)(in + (long)(row0 + r) * 1024))[lane + i * 64];
  }
  for (; row0 < rows; row0 += nw * RPW) {
#pragma unroll
    for (int r = 0; r < RPW; ++r)
#pragma unroll
      for (int i = 0; i < 4; ++i) v[r][i] = nv[r][i];
    const int rown = min(row0 + nw * RPW, rows - RPW);
#pragma unroll
    for (int r = 0; r < RPW; ++r)
#pragma unroll
      for (int i = 0; i < 4; ++i) nv[r][i] = ((const float4*)(in + (long)(rown + r) * 1024))[lane + i * 64];
#pragma unroll
    for (int r = 0; r < RPW; ++r) {
      float ss = 0.f;
#pragma unroll
      for (int i = 0; i < 4; ++i) ss += v[r][i].x * v[r][i].x + v[r][i].y * v[r][i].y + v[r][i].z * v[r][i].z + v[r][i].w * v[r][i].w;
      ss = wave_sum(ss);
      const float rs = rsqrtf(ss * (1.f / 1024.f) + 1e-5f);
#pragma unroll
      for (int i = 0; i < 4; ++i) {
        f32x4 y;
        y[0] = v[r][i].x * rs * wv[i].x; y[1] = v[r][i].y * rs * wv[i].y; y[2] = v[r][i].z * rs * wv[i].z; y[3] = v[r][i].w * rs * wv[i].w;
        if (BF) {
          *(u16x4*)((u16*)outp + (long)(row0 + r) * 1024 + (lane + i * 64) * 4) = pack4(y);
        } else {
          *(f32x4*)((float*)outp + (long)(row0 + r) * 1024 + (lane + i * 64) * 4) = y;
        }
      }
    }
  }
}

constexpr int GBM = 128, GBN = 128, GBK = 64;
constexpr int GTILE = 128 * 64;
template <int VT_FROM, class Epi>
DI void gemm_phase(const u16* __restrict__ A, int lda, const u16* __restrict__ Bt, int ldb, int M, int N, int K, Epi epi,
                   int bid, int nb, char* smem, u16* vt_out = nullptr) {
  u16* sA = (u16*)smem;
  u16* sB = sA + 2 * GTILE;
  const int tid = TIDX, lane = tid & 63, wid = tid >> 6, wr = wid >> 1, wc = wid & 1;
  const int fr = lane & 15, fq = lane >> 4;
  const int ntm = M / GBM, ntn = N / GBN, nk = K / GBK;
  const int lrow = tid >> 3, lkc = (tid & 7) * 8;
  const int st_off = lrow * 64 + (((tid & 7) ^ ((lrow >> 1) & 7)) << 3);
  const int fa_off = (wr * 64 + fr) * 64, fb_off = (wc * 64 + fr) * 64;
  const int fx0 = ((fq ^ (fr >> 1)) << 3), fx1 = (((4 + fq) ^ (fr >> 1)) << 3);
  const int ntiles = ntm * ntn;
  for (int s = bid; s < ntiles; s += nb) {
    const int tm = s / ntn, tn = s % ntn;
    const u16* Ag = A + (long)(tm * GBM) * lda;
    const u16* Bg = Bt + (long)(tn * GBN) * ldb;
    const unsigned voA = (unsigned)(lrow * lda + lkc), voB = (unsigned)(lrow * ldb + lkc);
    f32x4 acc[4][4];
#pragma unroll
    for (int m = 0; m < 4; ++m)
#pragma unroll
      for (int n = 0; n < 4; ++n) acc[m][n] = (f32x4){0.f, 0.f, 0.f, 0.f};
    uint4 ra0_0, ra0_1, ra0_2, ra0_3, rb0_0, rb0_1, rb0_2, rb0_3, ra1_0, ra1_1, ra1_2, ra1_3, rb1_0, rb1_1, rb1_2, rb1_3;
    bf16x8 af0[4], bf0[4], af1[4], bf1[4];
#define G_LOAD1(RA, RB, KT, I)                                                     \
  RA##_##I = *(const uint4*)((Ag + ((long)(I * 32) * lda + (KT) * GBK)) + voA);    \
  RB##_##I = *(const uint4*)((Bg + ((long)(I * 32) * ldb + (KT) * GBK)) + voB);
#define G_LOAD(RA, RB, KT) G_LOAD1(RA, RB, KT, 0) G_LOAD1(RA, RB, KT, 1) G_LOAD1(RA, RB, KT, 2) G_LOAD1(RA, RB, KT, 3)
#define G_STORE1(RA, RB, BUF, I)                                                   \
  *(uint4*)(sA + (BUF) * GTILE + st_off + I * 2048) = RA##_##I;                    \
  *(uint4*)(sB + (BUF) * GTILE + st_off + I * 2048) = RB##_##I;
#define G_STORE(RA, RB, BUF) G_STORE1(RA, RB, BUF, 0) G_STORE1(RA, RB, BUF, 1) G_STORE1(RA, RB, BUF, 2) G_STORE1(RA, RB, BUF, 3)
#define G_LDF(AF, BF, BUF, FX)                                                     \
  _Pragma("unroll") for (int m = 0; m < 4; ++m) {                                  \
    AF[m] = *(const bf16x8*)(sA + (BUF) * GTILE + fa_off + m * 1024 + FX);         \
    BF[m] = *(const bf16x8*)(sB + (BUF) * GTILE + fb_off + m * 1024 + FX);         \
  }
#define G_MMA(AF, BF)                                                              \
  _Pragma("unroll") for (int m = 0; m < 4; ++m)                                    \
    _Pragma("unroll") for (int n = 0; n < 4; ++n) acc[m][n] = mfma16(BF[n], AF[m], acc[m][n]);
    if (nk & 1) {
      G_LOAD(ra0, rb0, 0);
      G_STORE(ra0, rb0, 0);
      __syncthreads();
      for (int kt = 0; kt < nk; ++kt) {
        const int cur = kt & 1;
        if (kt + 1 < nk) { G_LOAD(ra0, rb0, kt + 1); }
        G_LDF(af0, bf0, cur, fx0);
        G_LDF(af1, bf1, cur, fx1);
        G_MMA(af0, bf0);
        G_MMA(af1, bf1);
        if (kt + 1 < nk) { G_STORE(ra0, rb0, cur ^ 1); }
        __syncthreads();
      }
    } else {
      G_LOAD(ra0, rb0, 0);
      G_LOAD(ra1, rb1, 1);
      G_STORE(ra0, rb0, 0);
      __syncthreads();
      G_LDF(af0, bf0, 0, fx0);
      for (int kt = 0; kt < nk; kt += 2) {
        const int k2 = min(kt + 2, nk - 1), k3 = min(kt + 3, nk - 1);
        G_LOAD(ra0, rb0, k2);
        G_LDF(af1, bf1, 0, fx1);
        G_MMA(af0, bf0);
        G_STORE(ra1, rb1, 1);
        __syncthreads();
        G_LDF(af0, bf0, 1, fx0);
        G_MMA(af1, bf1);
        G_LOAD(ra1, rb1, k3);
        G_LDF(af1, bf1, 1, fx1);
        G_MMA(af0, bf0);
        G_STORE(ra0, rb0, 0);
        __syncthreads();
        G_LDF(af0, bf0, 0, fx0);
        G_MMA(af1, bf1);
      }
    }
#undef G_LOAD
#undef G_STORE
#undef G_LOAD1
#undef G_STORE1
#undef G_LDF
#undef G_MMA
    if (VT_FROM >= 0 && tn >= VT_FROM) {
      constexpr int TLD = 136;
      u16* Tt = (u16*)smem;
      __syncthreads();
#pragma unroll
      for (int m = 0; m < 4; ++m)
#pragma unroll
        for (int n = 0; n < 4; ++n)
#pragma unroll
          for (int j = 0; j < 4; ++j)
            Tt[(wc * 64 + n * 16 + fq * 4 + j) * TLD + wr * 64 + m * 16 + fr] = f2bf(acc[m][n][j]);
      __syncthreads();
      const int colL = tid >> 1, half = tid & 1;
      const int row0 = tm * GBM, b = row0 >> 12, s0 = (row0 & 4095) + half * 64;
      const int c = (tn - VT_FROM) * GBN + colL;
      u16* dst = vt_out + ((long)(b * 512 + c)) * 4096 + s0;
#pragma unroll
      for (int i = 0; i < 8; ++i) *(uint4*)(dst + i * 8) = *(const uint4*)(Tt + colL * TLD + half * 64 + i * 8);
      __syncthreads();
    } else {
#pragma unroll
      for (int m = 0; m < 4; ++m)
#pragma unroll
        for (int n = 0; n < 4; ++n)
          epi(tm * GBM + wr * 64 + m * 16 + fr, tn * GBN + wc * 64 + n * 16 + fq * 4, acc[m][n]);
      __syncthreads();
    }
  }
}

struct EpiWin {
  u16 *pr, *qkd, *vt;
  DI void operator()(int row, int col, f32x4 v) const {
    if (col < 1792) {
      *(u16x4*)(pr + (long)row * 1792 + col) = pack4(v);
    } else if (col < 2816) {
      *(u16x4*)(qkd + (long)row * 1024 + (col - 1792)) = pack4(v);
    } else {
      const int b = row >> 12, s = row & 4095, c = col - 2816;
#pragma unroll
      for (int j = 0; j < 4; ++j) vt[((long)(b * 512 + c + j)) * 4096 + s] = f2bf(v[j]);
    }
  }
};
struct EpiBf16 {
  u16* o; int ld;
  DI void operator()(int row, int col, f32x4 v) const { *(u16x4*)(o + (long)row * ld + col) = pack4(v); }
};
struct EpiVtMem {
  u16* o;
  DI void operator()(int row, int col, f32x4 v) const {
    const int b = row >> 8, m = row & 255;
#pragma unroll
    for (int j = 0; j < 4; ++j) o[((long)(b * 1024 + col + j)) * 256 + m] = f2bf(v[j]);
  }
};
struct EpiKVMem {
  u16 *k, *vt;
  DI void operator()(int row, int col, f32x4 v) const {
    if (col < 1024) {
      *(u16x4*)(k + (long)row * 1024 + col) = pack4(v);
    } else {
      const int b = row >> 8, m = row & 255, c = col - 1024;
#pragma unroll
      for (int j = 0; j < 4; ++j) vt[((long)(b * 1024 + c + j)) * 256 + m] = f2bf(v[j]);
    }
  }
};
struct EpiDecay {
  float* e; const float* w0;
  DI void operator()(int row, int col, f32x4 v) const {
    f32x4 r;
#pragma unroll
    for (int j = 0; j < 4; ++j) {
      const float z = -(w0[col + j] + v[j]);
      const float sp = fmaxf(z, 0.f) + __logf(1.f + __expf(-fabsf(z)));
      r[j] = __expf(-sp - 0.5f);
    }
    *(f32x4*)(e + (long)row * 512 + col) = r;
  }
};
struct EpiASig {
  u16* o; const float* a0;
  DI void operator()(int row, int col, f32x4 v) const {
    f32x4 r;
#pragma unroll
    for (int j = 0; j < 4; ++j) r[j] = __builtin_amdgcn_rcpf(1.f + __expf(-(a0[col + j] + v[j])));
    *(u16x4*)(o + (long)row * 512 + col) = pack4(r);
  }
};
struct EpiResX {
  float* h; const float* x;
  DI void operator()(int row, int col, f32x4 v) const {
    const f32x4 xv = *(const f32x4*)(x + (long)row * 1024 + col);
    *(f32x4*)(h + (long)row * 1024 + col) = xv + v;
  }
};
struct EpiResAcc {
  float* h;
  DI void operator()(int row, int col, f32x4 v) const {
    f32x4* p = (f32x4*)(h + (long)row * 1024 + col);
    *p = *p + v;
  }
};
struct EpiRelu2 {
  u16* o;
  DI void operator()(int row, int col, f32x4 v) const {
    f32x4 r;
#pragma unroll
    for (int j = 0; j < 4; ++j) { const float t = fmaxf(v[j], 0.f); r[j] = t * t; }
    *(u16x4*)(o + (long)row * 4096 + col) = pack4(r);
  }
};

DI void rwkv_prep_phase(const Params& p, int bid, int nb) {
  const long total = (long)T_TOK * 32;
  for (long idx = (long)bid * 256 + TIDX; idx < total; idx += (long)nb * 256) {
    const int t = (int)(idx >> 5), c = (int)(idx & 31) * 8;
    float v[8], pv[8];
    unpack8(*(const uint4*)(p.pr + (long)t * 1792 + 1536 + c), v);
    if (t & 4095) unpack8(*(const uint4*)(p.pr + (long)(t - 1) * 1792 + 1536 + c), pv);
    else {
#pragma unroll
      for (int q = 0; q < 8; ++q) pv[q] = 0.f;
    }
    const float4 m0 = *(const float4*)(p.mu + 1536 + c), m1 = *(const float4*)(p.mu + 1536 + c + 4);
    const float mu[8] = {m0.x, m0.y, m0.z, m0.w, m1.x, m1.y, m1.z, m1.w};
    float y[8];
#pragma unroll
    for (int q = 0; q < 8; ++q) {
      const float xx = v[q] + (pv[q] - v[q]) * mu[q];
      if (c < 64) { const float e2 = __expf(2.f * xx); y[q] = 1.f - 2.f * __builtin_amdgcn_rcpf(e2 + 1.f); }
      else if (c < 128) y[q] = xx;
      else y[q] = __builtin_amdgcn_rcpf(1.f + __expf(-xx));
    }
    *(uint4*)(p.lora_in + idx * 8) = make_uint4(pk2(y[0], y[1]), pk2(y[2], y[3]), pk2(y[4], y[5]), pk2(y[6], y[7]));
  }
}

DI void rwkv_scan_seq(const Params& p, int bh, float* sh) {
  const int lane = TIDX & 63;
  const int b = bh >> 3, h = bh & 7, c = h * 64 + lane;
  const float mu_r = p.mu[c], mu_k = p.mu[512 + c], mu_v = p.mu[1024 + c];
  const float kk_w = p.k_k[c], ka_w = p.k_a[c], rk_w = p.r_k[c], lw = p.lnx_w[c], lb = p.lnx_b[c];
  float st[64];
#pragma unroll
  for (int i = 0; i < 64; ++i) st[i] = 0.f;
  float rp = 0.f, kp = 0.f, vp = 0.f;
  const long tok0 = (long)b * 4096;
  u16 nr = p.pr[tok0 * 1792 + c], nk = p.pr[tok0 * 1792 + 512 + c], nv = p.pr[tok0 * 1792 + 1024 + c];
  float ne = p.e_buf[tok0 * 512 + c];
  u16 na = p.asig[tok0 * 512 + c], ng = p.gbuf[tok0 * 512 + c];
  for (int t = 0; t < 4096; ++t) {
    const float r0 = bf2f(nr), k0 = bf2f(nk), v0 = bf2f(nv), e = ne, a = bf2f(na), g = bf2f(ng);
    if (t + 1 < 4096) {
      const long tk = tok0 + t + 1;
      nr = p.pr[tk * 1792 + c]; nk = p.pr[tk * 1792 + 512 + c]; nv = p.pr[tk * 1792 + 1024 + c];
      ne = p.e_buf[tk * 512 + c]; na = p.asig[tk * 512 + c]; ng = p.gbuf[tk * 512 + c];
    }
    const float r = r0 + (rp - r0) * mu_r, k = k0 + (kp - k0) * mu_k, v = v0 + (vp - v0) * mu_v;
    rp = r0; kp = k0; vp = v0;
    const float w = __expf(-e);
    const float kkv = k * kk_w;
    const float n2 = wave_sum(kkv * kkv);
    const float kk = kkv / fmaxf(sqrtf(n2), 1e-12f);
    const float kmod = k * (1.f + (a - 1.f) * ka_w);
    const float bb = kk * a;
    __syncthreads();
    sh[lane] = w; sh[64 + lane] = kk; sh[128 + lane] = bb; sh[192 + lane] = kmod; sh[256 + lane] = r;
    __syncthreads();
    float sa = 0.f;
#pragma unroll
    for (int q = 0; q < 16; ++q) {
      const float4 k4 = *(const float4*)(sh + 64 + q * 4);
      sa += st[q * 4] * k4.x + st[q * 4 + 1] * k4.y + st[q * 4 + 2] * k4.z + st[q * 4 + 3] * k4.w;
      asm volatile("" : "+v"(sa) :: "memory");
    }
    sa = -sa;
    float y = 0.f;
#pragma unroll
    for (int q = 0; q < 16; ++q) {
      const float4 w4 = *(const float4*)(sh + q * 4);
      const float4 b4 = *(const float4*)(sh + 128 + q * 4);
      const float4 m4 = *(const float4*)(sh + 192 + q * 4);
      const float4 r4 = *(const float4*)(sh + 256 + q * 4);
      st[q * 4] = st[q * 4] * w4.x + sa * b4.x + v * m4.x; y += st[q * 4] * r4.x;
      st[q * 4 + 1] = st[q * 4 + 1] * w4.y + sa * b4.y + v * m4.y; y += st[q * 4 + 1] * r4.y;
      st[q * 4 + 2] = st[q * 4 + 2] * w4.z + sa * b4.z + v * m4.z; y += st[q * 4 + 2] * r4.z;
      st[q * 4 + 3] = st[q * 4 + 3] * w4.w + sa * b4.w + v * m4.w; y += st[q * 4 + 3] * r4.w;
      asm volatile("" : "+v"(y) :: "memory");
    }
    const float mean = wave_sum(y) * (1.f / 64.f);
    const float d = y - mean;
    const float var = wave_sum(d * d) * (1.f / 64.f);
    const float yn = d * rsqrtf(var + 64e-5f) * lw + lb;
    const float bonus = wave_sum(r * kmod * rk_w) * v;
    p.mix[(tok0 + t) * 1024 + c] = f2bf((yn + bonus) * g);
  }
}


constexpr int RLD = 72, SLOT = 64 * RLD;
DI bf16x8 ldfrag(const u16* base, int row, int kofs) { return *(const bf16x8*)(base + row * RLD + kofs); }
DI f32x4 unpack4(u16x4 v) { f32x4 r; r[0] = bf2f(v[0]); r[1] = bf2f(v[1]); r[2] = bf2f(v[2]); r[3] = bf2f(v[3]); return r; }
#define ZERO4 ((f32x4){0.f, 0.f, 0.f, 0.f})

DI void ld8f(const float* __restrict__ p, float* o) {
  const float4 a = *(const float4*)p, b = *(const float4*)(p + 4);
  o[0] = a.x; o[1] = a.y; o[2] = a.z; o[3] = a.w; o[4] = b.x; o[5] = b.y; o[6] = b.z; o[7] = b.w;
}
struct RawIn { uint4 R0, R1, K0, K1, V0, V1, A0, A1, pR0, pR1, pK0, pK1, pV0, pV1; float4 E0, E1, E2, E3; };
DI void chunk_load_raw(const Params& p, int tile, int tid, RawIn& w) {
  const int ch = tile & 63, bh = tile >> 6, b = bh >> 3, h = bh & 7;
  const int t = tid >> 2, i0 = (tid & 3) * 16;
  const long tok = (long)b * 4096 + ch * 64 + t;
  const int col = h * 64 + i0;
  const bool first = (ch == 0 && t == 0);
  const u16* pc = p.pr + tok * 1792 + col;
  const uint4 zero4 = make_uint4(0u, 0u, 0u, 0u);
  w.R0 = *(const uint4*)(pc); w.R1 = *(const uint4*)(pc + 8);
  w.K0 = *(const uint4*)(pc + 512); w.K1 = *(const uint4*)(pc + 520);
  w.V0 = *(const uint4*)(pc + 1024); w.V1 = *(const uint4*)(pc + 1032);
  w.A0 = *(const uint4*)(p.asig + tok * 512 + col); w.A1 = *(const uint4*)(p.asig + tok * 512 + col + 8);
  const u16* pp = first ? pc : pc - 1792;
  const uint4 q0 = *(const uint4*)(pp), q1 = *(const uint4*)(pp + 8), q2 = *(const uint4*)(pp + 512), q3 = *(const uint4*)(pp + 520),
              q4 = *(const uint4*)(pp + 1024), q5 = *(const uint4*)(pp + 1032);
  w.pR0 = first ? zero4 : q0; w.pR1 = first ? zero4 : q1; w.pK0 = first ? zero4 : q2; w.pK1 = first ? zero4 : q3;
  w.pV0 = first ? zero4 : q4; w.pV1 = first ? zero4 : q5;
  const float4* ep = (const float4*)(p.e_buf + tok * 512 + col);
  w.E0 = ep[0]; w.E1 = ep[1]; w.E2 = ep[2]; w.E3 = ep[3];
}
DI void rwkv_chunk_prep(const Params& p, int tile, int next_tile, RawIn& raw, char* smem) {
  int tid_ = TIDX;
  asm volatile("" : "+v"(tid_));
  const int tid = tid_, lane = tid & 63, wid = tid >> 6, fr = lane & 15, fq = lane >> 4;
  const int ch = tile & 63, bh = tile >> 6, b = bh >> 3, h = bh & 7;
  u16* S = (u16*)smem;
  u16 *S0 = S, *S1 = S + SLOT, *S2 = S + 2 * SLOT, *S3 = S + 3 * SLOT, *S4 = S + 4 * SLOT, *S5 = S + 5 * SLOT,
      *S6 = S + 6 * SLOT, *S7 = S + 7 * SLOT;
  float* Ef = (float*)S4;
  __syncthreads();
  const int t = tid >> 2, i0 = (tid & 3) * 16;
  const long tok = (long)b * 4096 + ch * 64 + t;
  const int col = h * 64 + i0;
  *(float4*)(Ef + t * 64 + i0) = raw.E0; *(float4*)(Ef + t * 64 + i0 + 4) = raw.E1;
  *(float4*)(Ef + t * 64 + i0 + 8) = raw.E2; *(float4*)(Ef + t * 64 + i0 + 12) = raw.E3;
  __syncthreads();
  {
    const int cc = tid & 63, qq = tid >> 6;
    float s = 0.f;
#pragma unroll
    for (int tt = 0; tt < 16; ++tt) { s += Ef[(qq * 16 + tt) * 64 + cc]; Ef[(qq * 16 + tt) * 64 + cc] = s; }
  }
  __syncthreads();
  float n2 = 0.f, bon = 0.f;
#pragma unroll
  for (int hf = 0; hf < 2; ++hf) {
    const int o = hf * 8;
    float r[8], k[8], a[8], rp[8], kp[8];
    unpack8(hf ? raw.R1 : raw.R0, r); unpack8(hf ? raw.K1 : raw.K0, k); unpack8(hf ? raw.A1 : raw.A0, a);
    unpack8(hf ? raw.pR1 : raw.pR0, rp); unpack8(hf ? raw.pK1 : raw.pK0, kp);
    float mur[8], muk[8], wkk[8], wka[8], wrk[8];
    ld8f(p.mu + col + o, mur); ld8f(p.mu + 512 + col + o, muk); ld8f(p.k_k + col + o, wkk); ld8f(p.k_a + col + o, wka); ld8f(p.r_k + col + o, wrk);
#pragma unroll
    for (int q = 0; q < 8; ++q) {
      const float rr = r[q] + (rp[q] - r[q]) * mur[q];
      const float kx = k[q] + (kp[q] - k[q]) * muk[q];
      const float kkv = kx * wkk[q];
      n2 += kkv * kkv;
      bon += rr * kx * (1.f + (a[q] - 1.f) * wka[q]) * wrk[q];
    }
  }
  n2 += __shfl_xor(n2, 1); n2 += __shfl_xor(n2, 2);
  bon += __shfl_xor(bon, 1); bon += __shfl_xor(bon, 2);
  const float kinv = __builtin_amdgcn_rcpf(fmaxf(__builtin_amdgcn_sqrtf(n2), 1e-12f));
  unsigned pa[8], pbh[8], pkh[8];
  const int tq = t >> 4;
#pragma unroll
  for (int hf = 0; hf < 2; ++hf) {
    const int o = hf * 8;
    float r[8], k[8], v[8], a[8], e[8];
    {
      float rp[8], kp[8], vp[8];
      unpack8(hf ? raw.R1 : raw.R0, r); unpack8(hf ? raw.K1 : raw.K0, k); unpack8(hf ? raw.V1 : raw.V0, v); unpack8(hf ? raw.A1 : raw.A0, a);
      unpack8(hf ? raw.pR1 : raw.pR0, rp); unpack8(hf ? raw.pK1 : raw.pK0, kp); unpack8(hf ? raw.pV1 : raw.pV0, vp);
      float mur[8], muk[8], muv[8];
      ld8f(p.mu + col + o, mur); ld8f(p.mu + 512 + col + o, muk); ld8f(p.mu + 1024 + col + o, muv);
#pragma unroll
      for (int q = 0; q < 8; ++q) {
        r[q] = r[q] + (rp[q] - r[q]) * mur[q];
        k[q] = k[q] + (kp[q] - k[q]) * muk[q];
        v[q] = v[q] + (vp[q] - v[q]) * muv[q];
      }
      const float4 e0 = hf ? raw.E2 : raw.E0, e1 = hf ? raw.E3 : raw.E1;
      e[0] = e0.x; e[1] = e0.y; e[2] = e0.z; e[3] = e0.w; e[4] = e1.x; e[5] = e1.y; e[6] = e1.z; e[7] = e1.w;
    }
    float eq0[8], eq1[8], eq2[8], eq3[8], est[8];
    ld8f(Ef + 15 * 64 + i0 + o, eq0); ld8f(Ef + 31 * 64 + i0 + o, eq1); ld8f(Ef + 47 * 64 + i0 + o, eq2); ld8f(Ef + 63 * 64 + i0 + o, eq3);
    ld8f(Ef + t * 64 + i0 + o, est);
    float At[8], Bt[8], Kt[8], Rt[8], Bh[8], Kh[8], bvv[8], wkk[8], wka[8];
    ld8f(p.k_k + col + o, wkk); ld8f(p.k_a + col + o, wka);
#pragma unroll
    for (int q = 0; q < 8; ++q) {
      const int ii = i0 + o + q;
      const float q0 = eq0[q], q1 = eq1[q], q2 = eq2[q], q3 = eq3[q];
      float Sc = est[q];
      if (tq > 0) Sc += q0;
      if (tq > 1) Sc += q1;
      if (tq > 2) Sc += q2;
      const float SC = q0 + q1 + q2 + q3;
      const float kkn = k[q] * wkk[q] * kinv, bv = kkn * a[q];
      const float km = k[q] * (1.f + (a[q] - 1.f) * wka[q]);
      const float eNS = __expf(-Sc), eS = __builtin_amdgcn_rcpf(eNS), ee = __expf(e[q]), eC = __expf(-SC);
      At[q] = -kkn * ee * eNS;
      Rt[q] = r[q] * eNS;
      Bt[q] = bv * eS;
      Kt[q] = km * eS;
      Bh[q] = bv * (eS * eC);
      Kh[q] = km * (eS * eC);
      bvv[q] = bon * v[q];
      if (t == 63) p.c_gc[(long)tile * 64 + ii] = eC;
      S7[ii * RLD + t] = f2bf(v[q]);
    }
    uint4 w0;
#define PACK8(X) w0 = make_uint4(pk2(X[0], X[1]), pk2(X[2], X[3]), pk2(X[4], X[5]), pk2(X[6], X[7]));
    PACK8(At); *(uint4*)(S0 + t * RLD + i0 + o) = w0;
    pa[hf * 4] = w0.x; pa[hf * 4 + 1] = w0.y; pa[hf * 4 + 2] = w0.z; pa[hf * 4 + 3] = w0.w;
    PACK8(Bt); *(uint4*)(S1 + t * RLD + i0 + o) = w0;
    PACK8(Kt); *(uint4*)(S2 + t * RLD + i0 + o) = w0;
    PACK8(Rt); *(uint4*)(S3 + t * RLD + i0 + o) = w0;
    PACK8(Bh);
    pbh[hf * 4] = w0.x; pbh[hf * 4 + 1] = w0.y; pbh[hf * 4 + 2] = w0.z; pbh[hf * 4 + 3] = w0.w;
    PACK8(Kh);
    pkh[hf * 4] = w0.x; pkh[hf * 4 + 1] = w0.y; pkh[hf * 4 + 2] = w0.z; pkh[hf * 4 + 3] = w0.w;
    PACK8(bvv);
    *(uint4*)(p.asig + tok * 512 + col + o) = w0;
#undef PACK8
  }
  chunk_load_raw(p, next_tile, tid, raw);
  __syncthreads();
  const int trow = wid * 16 + fr;
  f32x4 Pacc[4];
  {
    bf16x8 aF[2], rF[2];
#pragma unroll
    for (int ks = 0; ks < 2; ++ks) { aF[ks] = ldfrag(S0, trow, ks * 32 + fq * 8); rF[ks] = ldfrag(S3, trow, ks * 32 + fq * 8); }
    f32x4 lab[4];
#pragma unroll
    for (int nt = 0; nt < 4; ++nt) {
      f32x4 lak = ZERO4, prb = ZERO4, prk = ZERO4;
      lab[nt] = ZERO4;
#pragma unroll
      for (int ks = 0; ks < 2; ++ks) {
        const bf16x8 bF = ldfrag(S1, nt * 16 + fr, ks * 32 + fq * 8), kF = ldfrag(S2, nt * 16 + fr, ks * 32 + fq * 8);
        lab[nt] = mfma16(bF, aF[ks], lab[nt]);
        lak = mfma16(kF, aF[ks], lak);
        prb = mfma16(bF, rF[ks], prb);
        prk = mfma16(kF, rF[ks], prk);
      }
      const int j0 = nt * 16 + fq * 4;
#pragma unroll
      for (int jj = 0; jj < 4; ++jj) {
        const int j = j0 + jj;
        if (!(j < trow)) { lab[nt][jj] = 0.f; lak[jj] = 0.f; }
        if (!(j <= trow)) { prb[jj] = 0.f; prk[jj] = 0.f; }
      }
      *(u16x4*)(S4 + trow * RLD + j0) = pack4(lak);
      *(u16x4*)(S5 + trow * RLD + j0) = pack4(prb);
      *(u16x4*)(S6 + trow * RLD + j0) = pack4(prk);
    }
    __syncthreads();
#pragma unroll
    for (int nt = 0; nt < 4; ++nt) {
      const int j0 = nt * 16 + fq * 4;
      f32x4 pi;
#pragma unroll
      for (int jj = 0; jj < 4; ++jj) {
        const int j = j0 + jj;
        pi[jj] = (j == trow ? 1.f : 0.f);
        S1[j * RLD + trow] = f2bf(lab[nt][jj]);
      }
      Pacc[nt] = pi;
      *(u16x4*)(S0 + trow * RLD + j0) = pack4(lab[nt]);
      *(u16x4*)(S2 + trow * RLD + j0) = pack4(pi);
    }
    __syncthreads();
  }
#pragma unroll 1
  for (int it = 0; it < 5; ++it) {
    bf16x8 pF[2], xF[2];
#pragma unroll
    for (int ks = 0; ks < 2; ++ks) { pF[ks] = ldfrag(S2, trow, ks * 32 + fq * 8); xF[ks] = ldfrag(S0, trow, ks * 32 + fq * 8); }
    f32x4 xn[4];
#pragma unroll
    for (int nt = 0; nt < 4; ++nt) {
      xn[nt] = ZERO4;
#pragma unroll
      for (int ks = 0; ks < 2; ++ks) {
        const bf16x8 xtF = ldfrag(S1, nt * 16 + fr, ks * 32 + fq * 8);
        Pacc[nt] = mfma16(xtF, pF[ks], Pacc[nt]);
        xn[nt] = mfma16(xtF, xF[ks], xn[nt]);
      }
    }
    __syncthreads();
#pragma unroll
    for (int nt = 0; nt < 4; ++nt) {
      const int j0 = nt * 16 + fq * 4;
      *(u16x4*)(S2 + trow * RLD + j0) = pack4(Pacc[nt]);
      *(u16x4*)(S0 + trow * RLD + j0) = pack4(xn[nt]);
#pragma unroll
      for (int jj = 0; jj < 4; ++jj) S1[(j0 + jj) * RLD + trow] = f2bf(xn[nt][jj]);
    }
    __syncthreads();
  }
  {
    bf16x8 pF[2];
#pragma unroll
    for (int ks = 0; ks < 2; ++ks) pF[ks] = ldfrag(S2, trow, ks * 32 + fq * 8);
#pragma unroll
    for (int nt = 0; nt < 4; ++nt)
#pragma unroll
      for (int ks = 0; ks < 2; ++ks) Pacc[nt] = mfma16(ldfrag(S1, nt * 16 + fr, ks * 32 + fq * 8), pF[ks], Pacc[nt]);
    __syncthreads();
#pragma unroll
    for (int nt = 0; nt < 4; ++nt) *(u16x4*)(S2 + trow * RLD + nt * 16 + fq * 4) = pack4(Pacc[nt]);
#pragma unroll
    for (int q = 0; q < 8; ++q) {
      S0[(i0 + 2 * q) * RLD + t] = (u16)(pa[q] & 0xffffu);
      S0[(i0 + 2 * q + 1) * RLD + t] = (u16)(pa[q] >> 16);
    }
    __syncthreads();
  }
  {
    bf16x8 tF[2], lkF[2];
#pragma unroll
    for (int ks = 0; ks < 2; ++ks) { tF[ks] = ldfrag(S2, trow, ks * 32 + fq * 8); lkF[ks] = ldfrag(S4, trow, ks * 32 + fq * 8); }
    f32x4 z[4];
#pragma unroll
    for (int nt = 0; nt < 4; ++nt) {
      f32x4 w1 = ZERO4;
      z[nt] = ZERO4;
#pragma unroll
      for (int ks = 0; ks < 2; ++ks) {
        w1 = mfma16(tF[ks], ldfrag(S0, nt * 16 + fr, ks * 32 + fq * 8), w1);
        z[nt] = mfma16(lkF[ks], ldfrag(S7, nt * 16 + fr, ks * 32 + fq * 8), z[nt]);
      }
      *(u16x4*)(S1 + (nt * 16 + fr) * RLD + wid * 16 + fq * 4) = pack4(w1);
    }
    __syncthreads();
#pragma unroll
    for (int nt = 0; nt < 4; ++nt) *(u16x4*)(S0 + (nt * 16 + fr) * RLD + wid * 16 + fq * 4) = pack4(z[nt]);
    __syncthreads();
#pragma unroll
    for (int nt = 0; nt < 4; ++nt) {
      f32x4 u0 = ZERO4;
#pragma unroll
      for (int ks = 0; ks < 2; ++ks) u0 = mfma16(tF[ks], ldfrag(S0, nt * 16 + fr, ks * 32 + fq * 8), u0);
      *(u16x4*)(S4 + (nt * 16 + fr) * RLD + wid * 16 + fq * 4) = pack4(u0);
    }
    __syncthreads();
#pragma unroll
    for (int q = 0; q < 8; ++q) {
      S0[(i0 + 2 * q) * RLD + t] = (u16)(pbh[q] & 0xffffu);
      S0[(i0 + 2 * q + 1) * RLD + t] = (u16)(pbh[q] >> 16);
      S2[(i0 + 2 * q) * RLD + t] = (u16)(pkh[q] & 0xffffu);
      S2[(i0 + 2 * q + 1) * RLD + t] = (u16)(pkh[q] >> 16);
    }
    __syncthreads();
  }
  {
    bf16x8 bhF[2], khF[2], pbF[2], pkF[2];
#pragma unroll
    for (int ks = 0; ks < 2; ++ks) {
      bhF[ks] = ldfrag(S0, trow, ks * 32 + fq * 8); khF[ks] = ldfrag(S2, trow, ks * 32 + fq * 8);
      pbF[ks] = ldfrag(S5, trow, ks * 32 + fq * 8); pkF[ks] = ldfrag(S6, trow, ks * 32 + fq * 8);
    }
    u16* mp = p.c_mp + (long)tile * 4096;
    u16* yh = p.c_yh + (long)tile * 4096;
    u16* nc = p.c_nc + (long)tile * 4096;
    u16* y0 = p.c_y0 + (long)tile * 4096;
#pragma unroll
    for (int nt = 0; nt < 4; ++nt) {
      f32x4 m = ZERO4, n = ZERO4, yy = ZERO4, yz = ZERO4;
#pragma unroll
      for (int ks = 0; ks < 2; ++ks) {
        const bf16x8 w1F = ldfrag(S1, nt * 16 + fr, ks * 32 + fq * 8);
        const bf16x8 u0F = ldfrag(S4, nt * 16 + fr, ks * 32 + fq * 8);
        const bf16x8 vF = ldfrag(S7, nt * 16 + fr, ks * 32 + fq * 8);
        m = mfma16(w1F, bhF[ks], m);
        n = mfma16(bhF[ks], u0F, n);
        n = mfma16(khF[ks], vF, n);
        yy = mfma16(w1F, pbF[ks], yy);
        yz = mfma16(u0F, pbF[ks], yz);
        yz = mfma16(vF, pkF[ks], yz);
      }
      yy += unpack4(*(const u16x4*)(S3 + trow * RLD + nt * 16 + fq * 4));
      *(u16x4*)(mp + trow * 64 + nt * 16 + fq * 4) = pack4(m);
      *(u16x4*)(yh + trow * 64 + nt * 16 + fq * 4) = pack4(yy);
      *(u16x4*)(nc + ((wid * 4 + nt) * 64 + lane) * 4) = pack4(n);
      *(u16x4*)(y0 + ((wid * 4 + nt) * 64 + lane) * 4) = pack4(yz);
    }
  }
}

DI bf16x8 ldperm(const u16* rowp, int ks, int fq) {
  const u16x4 lo = *(const u16x4*)(rowp + ks * 32 + fq * 4);
  const u16x4 hi = *(const u16x4*)(rowp + ks * 32 + 16 + fq * 4);
  bf16x8 r;
#pragma unroll
  for (int j = 0; j < 4; ++j) { r[j] = (short)lo[j]; r[4 + j] = (short)hi[j]; }
  return r;
}
DI void rwkv_state_pass(const Params& p, int bh, char* smem) {
  const int tid = TIDX, lane = tid & 63, wid = tid >> 6, fr = lane & 15, fq = lane >> 4;
  const int b = bh >> 3, h = bh & 7;
  constexpr int BUFB = 2 * SLOT * 2 + 2 * 8192;
  float* gcs = (float*)(smem + 2 * BUFB);
  float* stats = gcs + 128;
  f32x4 hacc[4];
#pragma unroll
  for (int i = 0; i < 4; ++i) hacc[i] = ZERO4;
  const int cb = h * 64 + wid * 16 + fq * 4;
  const float4 lw = *(const float4*)(p.lnx_w + cb), lb = *(const float4*)(p.lnx_b + cb);
  const int lrow = tid >> 3, lcol = (tid & 7) * 8;
  uint4 pm0, pm1, py0, py1, pn0, pn1, pz0, pz1;
  float pregc = 0.f;
  __syncthreads();
  {
    const long tile = (long)bh * 64;
    const u16 *mp = p.c_mp + tile * 4096, *yh = p.c_yh + tile * 4096, *nc = p.c_nc + tile * 4096, *y0 = p.c_y0 + tile * 4096;
    pm0 = *(const uint4*)(mp + lrow * 64 + lcol); pm1 = *(const uint4*)(mp + (lrow + 32) * 64 + lcol);
    py0 = *(const uint4*)(yh + lrow * 64 + lcol); py1 = *(const uint4*)(yh + (lrow + 32) * 64 + lcol);
    pn0 = *(const uint4*)(nc + tid * 8); pn1 = *(const uint4*)(nc + (tid + 256) * 8);
    pz0 = *(const uint4*)(y0 + tid * 8); pz1 = *(const uint4*)(y0 + (tid + 256) * 8);
    if (tid < 64) pregc = p.c_gc[tile * 64 + tid];
    u16* bf = (u16*)smem;
    *(uint4*)(bf + lrow * RLD + lcol) = pm0; *(uint4*)(bf + (lrow + 32) * RLD + lcol) = pm1;
    *(uint4*)(bf + SLOT + lrow * RLD + lcol) = py0; *(uint4*)(bf + SLOT + (lrow + 32) * RLD + lcol) = py1;
    *(uint4*)(bf + 2 * SLOT + tid * 8) = pn0; *(uint4*)(bf + 2 * SLOT + (tid + 256) * 8) = pn1;
    *(uint4*)(bf + 2 * SLOT + 4096 + tid * 8) = pz0; *(uint4*)(bf + 2 * SLOT + 4096 + (tid + 256) * 8) = pz1;
    if (tid < 64) gcs[tid] = pregc;
  }
  __syncthreads();
#pragma unroll 1
  for (int c = 0; c < 64; ++c) {
    const int cur = c & 1;
    if (c + 1 < 64) {
      const long tile = (long)bh * 64 + c + 1;
      const u16 *mp = p.c_mp + tile * 4096, *yh = p.c_yh + tile * 4096, *nc = p.c_nc + tile * 4096, *y0 = p.c_y0 + tile * 4096;
      pm0 = *(const uint4*)(mp + lrow * 64 + lcol); pm1 = *(const uint4*)(mp + (lrow + 32) * 64 + lcol);
      py0 = *(const uint4*)(yh + lrow * 64 + lcol); py1 = *(const uint4*)(yh + (lrow + 32) * 64 + lcol);
      pn0 = *(const uint4*)(nc + tid * 8); pn1 = *(const uint4*)(nc + (tid + 256) * 8);
      pz0 = *(const uint4*)(y0 + tid * 8); pz1 = *(const uint4*)(y0 + (tid + 256) * 8);
      if (tid < 64) pregc = p.c_gc[tile * 64 + tid];
    }
    const long tg0 = (long)b * 4096 + c * 64;
    u16x4 bvr[4], gr[4];
#pragma unroll
    for (int tt = 0; tt < 4; ++tt) {
      bvr[tt] = *(const u16x4*)(p.asig + (tg0 + tt * 16 + fr) * 512 + cb);
      gr[tt] = *(const u16x4*)(p.gbuf + (tg0 + tt * 16 + fr) * 512 + cb);
    }
    const u16* bf = (const u16*)(smem + cur * BUFB);
    const u16 *Lmp = bf, *Lyh = bf + SLOT, *Lnc = bf + 2 * SLOT, *Ly0 = bf + 2 * SLOT + 4096;
    bf16x8 hf[2];
#pragma unroll
    for (int ks = 0; ks < 2; ++ks)
#pragma unroll
      for (int j = 0; j < 4; ++j) {
        hf[ks][j] = (short)f2bf(hacc[2 * ks][j]);
        hf[ks][4 + j] = (short)f2bf(hacc[2 * ks + 1][j]);
      }
    f32x4 y[4];
#pragma unroll
    for (int tt = 0; tt < 4; ++tt) {
      y[tt] = unpack4(*(const u16x4*)(Ly0 + ((tt * 4 + wid) * 64 + lane) * 4));
#pragma unroll
      for (int ks = 0; ks < 2; ++ks) {
        const u16x4 lo = *(const u16x4*)(Lyh + (tt * 16 + fr) * RLD + ks * 32 + fq * 4);
        const u16x4 hi = *(const u16x4*)(Lyh + (tt * 16 + fr) * RLD + ks * 32 + 16 + fq * 4);
        bf16x8 yF;
#pragma unroll
        for (int j = 0; j < 4; ++j) { yF[j] = (short)lo[j]; yF[4 + j] = (short)hi[j]; }
        y[tt] = mfma16(hf[ks], yF, y[tt]);
      }
      float s1 = y[tt][0] + y[tt][1] + y[tt][2] + y[tt][3];
      float s2 = y[tt][0] * y[tt][0] + y[tt][1] * y[tt][1] + y[tt][2] * y[tt][2] + y[tt][3] * y[tt][3];
      s1 += __shfl_xor(s1, 16); s1 += __shfl_xor(s1, 32);
      s2 += __shfl_xor(s2, 16); s2 += __shfl_xor(s2, 32);
      if (fq == 0) *(float2*)(stats + ((cur * 4 + wid) * 64 + tt * 16 + fr) * 2) = make_float2(s1, s2);
    }
#pragma unroll
    for (int it = 0; it < 4; ++it) {
      const f32x4 nn = unpack4(*(const u16x4*)(Lnc + ((it * 4 + wid) * 64 + lane) * 4));
      const float4 g4 = *(const float4*)(gcs + cur * 64 + it * 16 + fq * 4);
      f32x4 a;
      a[0] = hacc[it][0] * g4.x + nn[0]; a[1] = hacc[it][1] * g4.y + nn[1];
      a[2] = hacc[it][2] * g4.z + nn[2]; a[3] = hacc[it][3] * g4.w + nn[3];
#pragma unroll
      for (int ks = 0; ks < 2; ++ks) {
        const u16x4 lo = *(const u16x4*)(Lmp + (it * 16 + fr) * RLD + ks * 32 + fq * 4);
        const u16x4 hi = *(const u16x4*)(Lmp + (it * 16 + fr) * RLD + ks * 32 + 16 + fq * 4);
        bf16x8 mF;
#pragma unroll
        for (int j = 0; j < 4; ++j) { mF[j] = (short)lo[j]; mF[4 + j] = (short)hi[j]; }
        a = mfma16(mF, hf[ks], a);
      }
      hacc[it] = a;
    }
    if (c + 1 < 64) {
      u16* nb_ = (u16*)(smem + (cur ^ 1) * BUFB);
      *(uint4*)(nb_ + lrow * RLD + lcol) = pm0; *(uint4*)(nb_ + (lrow + 32) * RLD + lcol) = pm1;
      *(uint4*)(nb_ + SLOT + lrow * RLD + lcol) = py0; *(uint4*)(nb_ + SLOT + (lrow + 32) * RLD + lcol) = py1;
      *(uint4*)(nb_ + 2 * SLOT + tid * 8) = pn0; *(uint4*)(nb_ + 2 * SLOT + (tid + 256) * 8) = pn1;
      *(uint4*)(nb_ + 2 * SLOT + 4096 + tid * 8) = pz0; *(uint4*)(nb_ + 2 * SLOT + 4096 + (tid + 256) * 8) = pz1;
      if (tid < 64) gcs[(cur ^ 1) * 64 + tid] = pregc;
    }
    __syncthreads();
#pragma unroll
    for (int tt = 0; tt < 4; ++tt) {
      float s1 = 0.f, s2 = 0.f;
#pragma unroll
      for (int w = 0; w < 4; ++w) {
        const float2 st = *(const float2*)(stats + ((cur * 4 + w) * 64 + tt * 16 + fr) * 2);
        s1 += st.x; s2 += st.y;
      }
      const float mean = s1 * (1.f / 64.f);
      const float var = fmaxf(s2 * (1.f / 64.f) - mean * mean, 0.f);
      const float rstd = rsqrtf(var + 64e-5f);
      const f32x4 bv = unpack4(bvr[tt]), g = unpack4(gr[tt]);
      f32x4 o;
      o[0] = ((y[tt][0] - mean) * rstd * lw.x + lb.x + bv[0]) * g[0];
      o[1] = ((y[tt][1] - mean) * rstd * lw.y + lb.y + bv[1]) * g[1];
      o[2] = ((y[tt][2] - mean) * rstd * lw.z + lb.z + bv[2]) * g[2];
      o[3] = ((y[tt][3] - mean) * rstd * lw.w + lb.w + bv[3]) * g[3];
      *(u16x4*)(p.mix + (tg0 + tt * 16 + fr) * 1024 + cb) = pack4(o);
    }
  }
}

template <int DQK, int DV, int NMAP, bool DIFF, int KT>
DI void attn_tile(const u16* __restrict__ Q, long q_stride, const u16* __restrict__ Kg, long k_stride,
                  const u16* __restrict__ Vtg, long vt_stride, int nkt, float scale, u16* __restrict__ Out, long o_stride,
                  float lam, const float* __restrict__ subw, char* smem, int lag) {
  constexpr int KW = NMAP * DQK, KLD = KW + 8, VLD = KT + 8;
  constexpr int KCH = KT * (KW / 8) / 256, VCH = DV * (KT / 8) / 256;
  constexpr int BUFE = KT * KLD + DV * VLD;
  constexpr bool DB = (2 * BUFE * 2 <= 79 * 1024);
  constexpr int VRS = 256 / (KT / 8);
  u16* S0 = (u16*)smem;
  const int tid = TIDX, lane = tid & 63, wid = tid >> 6, fr = lane & 15, fq = lane >> 4;
  bf16x8 qf[NMAP][DQK / 32];
#pragma unroll
  for (int m = 0; m < NMAP; ++m)
#pragma unroll
    for (int ks = 0; ks < DQK / 32; ++ks)
      qf[m][ks] = *(const bf16x8*)(Q + (long)(wid * 16 + fr) * q_stride + m * DQK + ks * 32 + fq * 8);
  f32x4 o[NMAP][DV / 16];
  float mrun[NMAP], lrun[NMAP];
#pragma unroll
  for (int m = 0; m < NMAP; ++m) {
    mrun[m] = -1e30f; lrun[m] = 0.f;
#pragma unroll
    for (int dt = 0; dt < DV / 16; ++dt) o[m][dt] = (f32x4){0.f, 0.f, 0.f, 0.f};
  }
  static_assert(DB && KCH == 4 && VCH == 4, "prefetch registers are written out for 4 + 4 chunks");
  uint4 kr0, kr1, kr2, kr3, vr0, vr1, vr2, vr3;
  const int krow = tid / (KW / 8), kcc = (tid % (KW / 8)) * 8;
  constexpr int KRS = 256 / (KW / 8);
  const int vrow = tid / (KT / 8), vcc = (tid % (KT / 8)) * 8;
  const float sl2 = scale * 1.44269504f;
  __syncthreads();
  if (lag) __syncthreads();
#pragma unroll
  for (int i = 0; i < KCH; ++i) *(uint4*)(S0 + (krow + i * KRS) * KLD + kcc) = *(const uint4*)(Kg + (long)(krow + i * KRS) * k_stride + kcc);
#pragma unroll
  for (int i = 0; i < VCH; ++i) *(uint4*)(S0 + KT * KLD + (vrow + i * VRS) * VLD + vcc) = *(const uint4*)(Vtg + (long)(vrow + i * VRS) * vt_stride + vcc);
  __syncthreads();
  for (int kt = 0; kt < nkt; ++kt) {
    const u16* Ks = S0 + (DB ? (kt & 1) * BUFE : 0);
    const u16* Vs = Ks + KT * KLD;
    const int ktn = min(kt + 1, nkt - 1);
    {
      const u16* kp_ = Kg + (long)(ktn * KT + krow) * k_stride + kcc;
      kr0 = *(const uint4*)(kp_); kr1 = *(const uint4*)(kp_ + (long)KRS * k_stride);
      kr2 = *(const uint4*)(kp_ + (long)(2 * KRS) * k_stride); kr3 = *(const uint4*)(kp_ + (long)(3 * KRS) * k_stride);
      const u16* vp_ = Vtg + (long)vrow * vt_stride + ktn * KT + vcc;
      vr0 = *(const uint4*)(vp_); vr1 = *(const uint4*)(vp_ + (long)VRS * vt_stride);
      vr2 = *(const uint4*)(vp_ + (long)(2 * VRS) * vt_stride); vr3 = *(const uint4*)(vp_ + (long)(3 * VRS) * vt_stride);
    }
    f32x4 s[NMAP][KT / 16];
#pragma unroll
    for (int m = 0; m < NMAP; ++m)
#pragma unroll
      for (int c = 0; c < KT / 16; ++c) {
        s[m][c] = (f32x4){0.f, 0.f, 0.f, 0.f};
#pragma unroll
        for (int ks = 0; ks < DQK / 32; ++ks) {
          const bf16x8 kf = *(const bf16x8*)(Ks + (c * 16 + fr) * KLD + m * DQK + ks * 32 + fq * 8);
          s[m][c] = mfma16(kf, qf[m][ks], s[m][c]);
        }
      }
    bf16x8 pb[NMAP][KT / 32];
#pragma unroll
    for (int m = 0; m < NMAP; ++m) {
      float lmx = -1e30f;
#pragma unroll
      for (int c = 0; c < KT / 16; ++c)
#pragma unroll
        for (int j = 0; j < 4; ++j) lmx = fmaxf(lmx, s[m][c][j]);
      lmx *= sl2;
      if (__builtin_amdgcn_readfirstlane(__any(lmx > mrun[m] + 16.f))) {
        float mx = fmaxf(lmx, __shfl_xor(lmx, 16));
        mx = fmaxf(mx, __shfl_xor(mx, 32));
        const float mnew = fmaxf(mrun[m], mx);
        const float alpha = __builtin_amdgcn_exp2f(mrun[m] - mnew);
        mrun[m] = mnew;
        lrun[m] *= alpha;
#pragma unroll
        for (int dt = 0; dt < DV / 16; ++dt) o[m][dt] *= alpha;
      }
      float psum = 0.f;
#pragma unroll
      for (int c = 0; c < KT / 16; ++c)
#pragma unroll
        for (int j = 0; j < 4; ++j) { s[m][c][j] = __builtin_amdgcn_exp2f(s[m][c][j] * sl2 - mrun[m]); psum += s[m][c][j]; }
      lrun[m] += psum;
#pragma unroll
      for (int k2 = 0; k2 < KT / 32; ++k2) {
        u32x4 pw;
        pw[0] = cvtpk(s[m][2 * k2][0], s[m][2 * k2][1]); pw[1] = cvtpk(s[m][2 * k2][2], s[m][2 * k2][3]);
        pw[2] = cvtpk(s[m][2 * k2 + 1][0], s[m][2 * k2 + 1][1]); pw[3] = cvtpk(s[m][2 * k2 + 1][2], s[m][2 * k2 + 1][3]);
        pb[m][k2] = __builtin_bit_cast(bf16x8, pw);
      }
    }
    __syncthreads();
    __builtin_amdgcn_s_setprio(1);
#pragma unroll
    for (int k2 = 0; k2 < KT / 32; ++k2)
#pragma unroll
      for (int dt = 0; dt < DV / 16; ++dt) {
        const u16x4 lo = *(const u16x4*)(Vs + (dt * 16 + fr) * VLD + k2 * 32 + fq * 4);
        const u16x4 hi = *(const u16x4*)(Vs + (dt * 16 + fr) * VLD + k2 * 32 + 16 + fq * 4);
        bf16x8 vf;
#pragma unroll
        for (int j = 0; j < 4; ++j) { vf[j] = (short)lo[j]; vf[4 + j] = (short)hi[j]; }
#pragma unroll
        for (int m = 0; m < NMAP; ++m) o[m][dt] = mfma16(vf, pb[m][k2], o[m][dt]);
      }
    __builtin_amdgcn_s_setprio(0);
    {
      u16* Kd = S0 + ((kt + 1) & 1) * BUFE + krow * KLD + kcc;
      *(uint4*)(Kd) = kr0; *(uint4*)(Kd + KRS * KLD) = kr1; *(uint4*)(Kd + 2 * KRS * KLD) = kr2; *(uint4*)(Kd + 3 * KRS * KLD) = kr3;
      u16* Vd = S0 + ((kt + 1) & 1) * BUFE + KT * KLD + vrow * VLD + vcc;
      *(uint4*)(Vd) = vr0; *(uint4*)(Vd + VRS * VLD) = vr1; *(uint4*)(Vd + 2 * VRS * VLD) = vr2; *(uint4*)(Vd + 3 * VRS * VLD) = vr3;
    }
    __syncthreads();
  }
  if (!lag) __syncthreads();
  float linv[NMAP];
#pragma unroll
  for (int m = 0; m < NMAP; ++m) {
    float l = lrun[m];
    l += __shfl_xor(l, 16);
    l += __shfl_xor(l, 32);
    linv[m] = 1.f / l;
  }
  u16* orow = Out + (long)(wid * 16 + fr) * o_stride;
  if (DIFF) {
    float ss = 0.f;
#pragma unroll
    for (int dt = 0; dt < DV / 16; ++dt)
#pragma unroll
      for (int j = 0; j < 4; ++j) {
        const float val = o[0][dt][j] * linv[0] - lam * o[NMAP - 1][dt][j] * linv[NMAP - 1];
        o[0][dt][j] = val;
        ss += val * val;
      }
    ss += __shfl_xor(ss, 16);
    ss += __shfl_xor(ss, 32);
    const float rstd = rsqrtf(ss * (1.f / DV) + 1e-5f) * 0.8f;
#pragma unroll
    for (int dt = 0; dt < DV / 16; ++dt) {
      f32x4 r;
#pragma unroll
      for (int j = 0; j < 4; ++j) r[j] = o[0][dt][j] * rstd * subw[dt * 16 + fq * 4 + j];
      *(u16x4*)(orow + dt * 16 + fq * 4) = pack4(r);
    }
  } else {
#pragma unroll
    for (int dt = 0; dt < DV / 16; ++dt) {
      f32x4 r = o[0][dt] * linv[0];
      *(u16x4*)(orow + dt * 16 + fq * 4) = pack4(r);
    }
  }
}


DI void transpose_v_phase(const Params& p, int bid, int nb, char* smem) {
  u16* t = (u16*)smem;
  const int tid = TIDX;
  for (int tile = bid; tile < 4096; tile += nb) {
    const int b = tile >> 9, st = (tile >> 3) & 63, ct = tile & 7;
    const int r = tid >> 2, seg = (tid & 3) * 16;
    const u16* src = p.vrm + ((long)(b * 4096 + st * 64 + r)) * 512 + ct * 64 + seg;
    const uint4 a0 = *(const uint4*)(src), a1 = *(const uint4*)(src + 8);
    __syncthreads();
    *(uint4*)(t + r * 72 + seg) = a0; *(uint4*)(t + r * 72 + seg + 8) = a1;
    __syncthreads();
    unsigned w[8];
#pragma unroll
    for (int q = 0; q < 8; ++q) w[q] = (unsigned)t[(seg + 2 * q) * 72 + r] | ((unsigned)t[(seg + 2 * q + 1) * 72 + r] << 16);
    u16* dst = p.vt + ((long)(b * 512 + ct * 64 + r)) * 4096 + st * 64 + seg;
    *(uint4*)(dst) = make_uint4(w[0], w[1], w[2], w[3]);
    *(uint4*)(dst + 8) = make_uint4(w[4], w[5], w[6], w[7]);
  }
}


#define GB_CENSUS(x) (64 * (1 + (x)))
#define GB_XARR(x) (64 * (17 + (x)))
#define GB_XGEN(x) (64 * (33 + (x)))
#define GB_TOP (64 * 49)
DI unsigned gb_ld(unsigned* p) { return __hip_atomic_load(p, __ATOMIC_RELAXED, __HIP_MEMORY_SCOPE_AGENT); }
DI unsigned gb_add(unsigned* p) { return __hip_atomic_fetch_add(p, 1u, __ATOMIC_RELAXED, __HIP_MEMORY_SCOPE_AGENT); }
DI void gsync(unsigned* gw, const unsigned* gl, unsigned& epoch) {
  asm volatile("s_waitcnt vmcnt(0) lgkmcnt(0)" ::: "memory");
  __syncthreads();
  epoch += 1;
  if (threadIdx.x == 0) {
    const unsigned gnmine = gl[0], gnx = gl[1], gxid = gl[2];
    __builtin_amdgcn_fence(__ATOMIC_RELEASE, "agent");
    asm volatile("s_waitcnt vmcnt(0)" ::: "memory");
    const unsigned old = gb_add(gw + GB_XARR(gxid));
    if (old + 1 == gnmine * epoch) {
      const unsigned t = gb_add(gw + GB_TOP);
      if (t + 1 == gnx * epoch) {
        for (unsigned x = 0; x < 16; ++x)
          if (gb_ld(gw + GB_CENSUS(x)) != 0u) __hip_atomic_store(gw + GB_XGEN(x), epoch, __ATOMIC_RELAXED, __HIP_MEMORY_SCOPE_AGENT);
      }
    }
    while (gb_ld(gw + GB_XGEN(gxid)) < epoch) __builtin_amdgcn_s_sleep(1);
    __builtin_amdgcn_fence(__ATOMIC_ACQUIRE, "agent");
    asm volatile("s_waitcnt vmcnt(0)" ::: "memory");
  }
  __syncthreads();
}
DI void gsync_first(unsigned* cnt) {
  asm volatile("s_waitcnt vmcnt(0) lgkmcnt(0)" ::: "memory");
  __syncthreads();
  if (threadIdx.x == 0) {
    __builtin_amdgcn_fence(__ATOMIC_RELEASE, "agent");
    asm volatile("s_waitcnt vmcnt(0)" ::: "memory");
    gb_add(cnt);
    while (gb_ld(cnt) < gridDim.x) __builtin_amdgcn_s_sleep(1);
    __builtin_amdgcn_fence(__ATOMIC_ACQUIRE, "agent");
    asm volatile("s_waitcnt vmcnt(0)" ::: "memory");
  }
  __syncthreads();
}
constexpr int SMEM_HALF = 80 * 1024, SMEM_BYTES = 2 * SMEM_HALF;

template <class Epi>
DI void big_gemm(char* smem, const u16* A, const u16* Bt, int M, int N, int K, const Epi& E) {
  pg8::StaticOrder S;
  S.init(M, N, (int)gridDim.x, (int)blockIdx.x);
  pg8::gemm_phase<Epi, pg8::StaticOrder, false>((PG8_LAS unsigned char*)smem, pg8::Gemm{A, Bt, M, N, K}, S, E, nullptr);
  __syncthreads();
}

__global__ void __launch_bounds__(512, 2) fwd_megakernel(Params p) {
  cg::grid_group grid = cg::this_grid();
  __shared__ __attribute__((aligned(16))) char smem_all[SMEM_BYTES];
  const int half = __builtin_amdgcn_readfirstlane(threadIdx.x >> 8);
  const int bid = blockIdx.x * 2 + half, nb = gridDim.x * 2;
  char* smem = smem_all + half * SMEM_HALF;
  unsigned epoch = 0;

  if (blockIdx.x == 0 && threadIdx.x == 0) *p.counter = 0;
  const unsigned my_xcc = (unsigned)__builtin_amdgcn_s_getreg((3 << 11) | 20) & 0xFu;
  if (threadIdx.x == 0) gb_add(p.gbar + GB_CENSUS(my_xcc));
  for (int i = blockIdx.x * 512 + threadIdx.x; i < 3 * T_TOK; i += gridDim.x * 512) p.ss1[i] = 0.f;
  transpose_w(p.w_in, p.wt_in, 1024, 3328, bid, nb, smem);
  transpose_w(p.w_out, p.wt_out, 1024, 1024, bid, nb, smem);
  transpose_w(p.w_mq, p.wt_mq, 1024, 1024, bid, nb, smem, p.norm_mem_w);
  transpose_w(p.w_mk, p.wt_mk, 1024, 1024, bid, nb, smem);
  transpose_w(p.w_mv, p.wt_mv, 1024, 1024, bid, nb, smem);
  transpose_w(p.w_mo, p.wt_mo, 1024, 1024, bid, nb, smem);
  transpose_w(p.w_up, p.wt_up, 1024, 4096, bid, nb, smem, p.norm_mlp_w);
  transpose_w(p.w_down, p.wt_down, 4096, 1024, bid, nb, smem);
  transpose_w(p.w_dec_up, p.wt_dec, 64, 512, bid, nb, smem);
  transpose_w(p.a_up, p.wt_a, 64, 512, bid, nb, smem);
  transpose_w(p.g_up, p.wt_g, 128, 512, bid, nb, smem);
  rmsnorm_phase<true>(p.x, p.norm_mix_w, p.xn, T_TOK, bid, nb);
  rmsnorm_phase<true>(p.mem, p.norm_src_w, p.memn, 2048, bid, nb);
  if (p.never) grid.sync();
  gsync_first(p.gbar + 64 * 50);
  unsigned* gb_lds = (unsigned*)(smem_all + SMEM_BYTES - 32);
  if (threadIdx.x == 0) {
    unsigned nm = 0, nx = 0;
    for (unsigned x = 0; x < 16; ++x) { const unsigned c = gb_ld(p.gbar + GB_CENSUS(x)); if (c) ++nx; if (x == my_xcc) nm = c; }
    gb_lds[0] = nm; gb_lds[1] = nx; gb_lds[2] = my_xcc;
  }
  __syncthreads();

  big_gemm(smem_all, p.xn, p.wt_in, T_TOK, 3328, 1024, pg8::EpiWinP{p.pr, p.qkd, p.vrm});
  gemm_phase<-1>(p.memn, 1024, p.wt_mk, 1024, 2048, 2048, 1024, EpiKVMem{p.kmem, p.vtmem}, bid >= 256 ? bid - 256 : bid + 256, nb, smem);
  gsync(p.gbar, gb_lds, epoch);

  rwkv_prep_phase(p, bid, nb);
  transpose_v_phase(p, bid, nb, smem);
  gsync(p.gbar, gb_lds, epoch);

  gemm_phase<-1>(p.lora_in, 256, p.wt_dec, 64, T_TOK, 512, 64, EpiDecay{p.e_buf, p.w0}, bid, nb, smem);
  gemm_phase<-1>(p.lora_in + 64, 256, p.wt_a, 64, T_TOK, 512, 64, EpiASig{p.asig, p.a0}, bid, nb, smem);
  gemm_phase<-1>(p.lora_in + 128, 256, p.wt_g, 128, T_TOK, 512, 128, EpiBf16{p.gbuf, 512}, bid, nb, smem);
  gsync(p.gbar, gb_lds, epoch);

  {
    RawIn raw;
    if (bid < 4096) chunk_load_raw(p, bid, TIDX, raw);
    for (int tile = bid; tile < 4096; tile += nb) rwkv_chunk_prep(p, tile, min(tile + nb, 4095), raw, smem);
  }
  gsync(p.gbar, gb_lds, epoch);
  if (bid < 64) rwkv_state_pass(p, bid, smem);
  {
    float d1 = 0.f, d2 = 0.f;
    for (int i = 0; i < 64; ++i) { d1 += p.lam_q1[i] * p.lam_k1[i]; d2 += p.lam_q2[i] * p.lam_k2[i]; }
    const float lam = __expf(d1) - __expf(d2) + 0.2f;
    int* qidx = (int*)(smem_all + SMEM_BYTES - 16);
    for (;;) {
      __syncthreads();
      if (threadIdx.x == 0) *qidx = atomicAdd(p.counter, 1);
      __syncthreads();
      const int idx = *qidx;
      if (idx >= 1024) break;
      const int qc = 63 - (idx >> 4), bh = (idx & 15) * 2 + half, b = bh >> 2, h = bh & 3;
      const long tq = (long)b * 4096 + qc * 64;
      attn_tile<64, 128, 2, true, 64>(p.qkd + tq * 1024 + h * 128, 1024, p.qkd + (long)b * 4096 * 1024 + 512 + h * 128, 1024,
                                  p.vt + (long)(b * 512 + h * 128) * 4096, 4096, qc + 1, 0.125f,
                                  p.mix + tq * 1024 + 512 + h * 128, 1024, lam, p.subln_w, smem, half);
    }
  }
  gsync(p.gbar, gb_lds, epoch);

  big_gemm(smem_all, p.mix, p.wt_out, T_TOK, 1024, 1024, pg8::EpiResNormP<false, false, true>{p.out, p.x, p.xn, p.ss1});
  gsync(p.gbar, gb_lds, epoch);
  big_gemm(smem_all, p.xn, p.wt_mq, T_TOK, 1024, 1024, pg8::EpiBf16NormP<0>{p.qmem, 1024, p.ss1});
  gsync(p.gbar, gb_lds, epoch);
  for (int idx = bid; idx < 2048; idx += nb) {
    const int tt = idx >> 2, h = idx & 3;
    const long t0 = (long)tt * 64;
    const int b = (int)(t0 >> 12);
    attn_tile<256, 256, 1, false, 32>(p.qmem + t0 * 1024 + h * 256, 1024, p.kmem + (long)b * 256 * 1024 + h * 256, 1024,
                                  p.vtmem + (long)(b * 1024 + h * 256) * 256, 256, 8, 0.0625f,
                                  p.mix + t0 * 1024 + h * 256, 1024, 0.f, p.subln_w, smem, half);
  }
  gsync(p.gbar, gb_lds, epoch);
  big_gemm(smem_all, p.mix, p.wt_mo, T_TOK, 1024, 1024, pg8::EpiResNormP<true, false, true>{p.out, p.xn, p.xn, p.ss2});
  gsync(p.gbar, gb_lds, epoch);
  big_gemm(smem_all, p.xn, p.wt_up, T_TOK, 4096, 1024, pg8::EpiBf16NormP<1>{p.hid, 4096, p.ss2});
  gsync(p.gbar, gb_lds, epoch);
  big_gemm(smem_all, p.hid, p.wt_down, T_TOK, 1024, 4096, pg8::EpiResNormP<true, false, true>{p.out, p.xn, p.xn, p.ss3});
  gsync(p.gbar, gb_lds, epoch);
  {
    const long total = (long)T_TOK * 128;
    for (long idx = (long)blockIdx.x * 512 + threadIdx.x; idx < total; idx += (long)gridDim.x * 512) {
      const int row = (int)(idx >> 7), c = (int)(idx & 127) * 8;
      float v[8];
      unpack8(*(const uint4*)(p.xn + (long)row * 1024 + c), v);
      const float rs = rsqrtf(p.ss3[row] * (1.f / 1024.f) + 1e-5f);
      const float4 w0 = *(const float4*)(p.norm_final_w + c), w1 = *(const float4*)(p.norm_final_w + c + 4);
      float* o = p.out + (long)row * 1024 + c;
      const f32x4 o0 = {v[0] * rs * w0.x, v[1] * rs * w0.y, v[2] * rs * w0.z, v[3] * rs * w0.w};
      const f32x4 o1 = {v[4] * rs * w1.x, v[5] * rs * w1.y, v[6] * rs * w1.z, v[7] * rs * w1.w};
      __builtin_nontemporal_store(o0, (f32x4*)(o));
      __builtin_nontemporal_store(o1, (f32x4*)(o + 4));
    }
  }
}

extern "C" void kernel_launch(void* const* d_in, const int* in_sizes, int n_in, void* d_out, int out_size, void* d_ws,
                              size_t ws_size, hipStream_t stream) {
  static int grid_blocks = 0;
  if (!grid_blocks) {
    int dev = 0, cus = 0, per_cu = 0;
    hipGetDevice(&dev);
    hipDeviceGetAttribute(&cus, hipDeviceAttributeMultiprocessorCount, dev);
    hipOccupancyMaxActiveBlocksPerMultiprocessor(&per_cu, fwd_megakernel, 512, 0);
    if (per_cu > 1) per_cu = 1;
    if (per_cu < 1) per_cu = 1;
    grid_blocks = cus * per_cu;
  }
  Params p{};
  const float* const* in = (const float* const*)d_in;
  p.x = in[0]; p.mem = in[1]; p.norm_mix_w = in[2]; p.w_in = in[3]; p.mu = in[4]; p.w0 = in[5]; p.w_dec_up = in[6];
  p.a0 = in[7]; p.a_up = in[8]; p.g_up = in[9]; p.k_k = in[10]; p.k_a = in[11]; p.r_k = in[12]; p.lnx_w = in[13];
  p.lnx_b = in[14]; p.lam_q1 = in[15]; p.lam_k1 = in[16]; p.lam_q2 = in[17]; p.lam_k2 = in[18]; p.subln_w = in[19];
  p.w_out = in[20]; p.norm_mem_w = in[21]; p.norm_src_w = in[22]; p.w_mq = in[23]; p.w_mk = in[24]; p.w_mv = in[25];
  p.w_mo = in[26]; p.norm_mlp_w = in[27]; p.w_up = in[28]; p.w_down = in[29]; p.norm_final_w = in[30];
  p.out = (float*)d_out;
  char* ws = (char*)d_ws;
  u16* wbase = (u16*)ws;
  long o = 0;
  p.wt_in = wbase + o; o += 3328L * 1024;
  p.wt_out = wbase + o; o += 1024L * 1024;
  p.wt_mq = wbase + o; o += 1024L * 1024;
  p.wt_mk = wbase + o; o += 1024L * 1024;
  p.wt_mv = wbase + o; o += 1024L * 1024;
  p.wt_mo = wbase + o; o += 1024L * 1024;
  p.wt_up = wbase + o; o += 4096L * 1024;
  p.wt_down = wbase + o; o += 4096L * 1024;
  p.wt_dec = wbase + o; o += 512L * 64;
  p.wt_a = wbase + o; o += 512L * 64;
  p.wt_g = wbase + o; o += 512L * 128;
  p.xn = (u16*)(ws + 34 * MiB);
  char* big = ws + 98 * MiB;
  p.pr = (u16*)big;
  p.qkd = (u16*)(big + 112 * MiB);
  p.vt = (u16*)(big + 176 * MiB);
  p.vrm = (u16*)(big + 208 * MiB);
  p.hid = (u16*)big;
  p.mix = (u16*)(ws + 354 * MiB);
  p.qmem = (u16*)(ws + 418 * MiB);
  p.memn = (u16*)(ws + 482 * MiB);
  p.kmem = (u16*)(ws + 486 * MiB);
  p.vtmem = (u16*)(ws + 490 * MiB);
  p.lora_in = (u16*)(ws + 494 * MiB);
  p.e_buf = (float*)d_out;
  p.asig = (u16*)((char*)d_out + 64 * MiB);
  p.gbuf = (u16*)((char*)d_out + 96 * MiB);
  p.c_mp = p.xn; p.c_yh = p.xn + 4096L * 4096;
  p.c_nc = p.qmem; p.c_y0 = p.qmem + 4096L * 4096;
  p.counter = (int*)(ws + 511 * MiB);
  p.gbar = (unsigned*)(ws + 511 * MiB + 512 * 1024);
  hipMemsetAsync(p.gbar, 0, 16384, stream);
  p.ss1 = (float*)(ws + 511 * MiB + 65536); p.ss2 = p.ss1 + T_TOK; p.ss3 = p.ss2 + T_TOK;
  p.c_gc = (float*)p.lora_in;
  void* args[] = {&p};
  hipError_t e = hipLaunchCooperativeKernel((void*)fwd_megakernel, dim3(grid_blocks), dim3(512), args, 0, stream);
  if (e != hipSuccess) fprintf(stderr, "cooperative launch failed: %s (grid %d)\n", hipGetErrorString(e), grid_blocks);
}
```

```cpp
#include <hip/hip_runtime.h>
#include <hip/hip_cooperative_groups.h>
#include <cstdio>
namespace cg = cooperative_groups;

#define DI __device__ __forceinline__
typedef unsigned short u16;
using bf16x8 = __attribute__((ext_vector_type(8))) short;
using f32x4 = __attribute__((ext_vector_type(4))) float;
using u16x4 = __attribute__((ext_vector_type(4))) unsigned short;
using u32x4 = __attribute__((ext_vector_type(4))) unsigned;

constexpr int T_TOK = 32768, SEQ = 4096, DM = 1024;
constexpr long MiB = 1024L * 1024L;

typedef float f32x2_t __attribute__((ext_vector_type(2)));
typedef __bf16 bf16x2_t __attribute__((ext_vector_type(2)));
DI unsigned cvtpk(float lo, float hi) { const f32x2_t v = {lo, hi}; return __builtin_bit_cast(unsigned, __builtin_convertvector(v, bf16x2_t)); }
using u32x2 = __attribute__((ext_vector_type(2))) unsigned;
DI u16 f2bf(float x) { return (u16)(cvtpk(x, x) & 0xffffu); }
DI float bf2f(u16 h) { return __uint_as_float(((unsigned)h) << 16); }
DI float wave_sum(float v) {
#pragma unroll
  for (int o = 32; o > 0; o >>= 1) v += __shfl_xor(v, o);
  return v;
}
DI f32x4 mfma16(bf16x8 a, bf16x8 b, f32x4 c) { return __builtin_amdgcn_mfma_f32_16x16x32_bf16(a, b, c, 0, 0, 0); }
DI u16x4 pack4(f32x4 v) { u32x2 w; w[0] = cvtpk(v[0], v[1]); w[1] = cvtpk(v[2], v[3]); return __builtin_bit_cast(u16x4, w); }
DI void unpack8(uint4 w, float* o) {
  o[0] = __uint_as_float(w.x << 16); o[1] = __uint_as_float(w.x & 0xffff0000u);
  o[2] = __uint_as_float(w.y << 16); o[3] = __uint_as_float(w.y & 0xffff0000u);
  o[4] = __uint_as_float(w.z << 16); o[5] = __uint_as_float(w.z & 0xffff0000u);
  o[6] = __uint_as_float(w.w << 16); o[7] = __uint_as_float(w.w & 0xffff0000u);
}
DI unsigned pk2(float a, float b) { return cvtpk(a, b); }

struct Params {
  const float *x, *mem, *norm_mix_w, *w_in, *mu, *w0, *w_dec_up, *a0, *a_up, *g_up, *k_k, *k_a, *r_k, *lnx_w, *lnx_b;
  const float *lam_q1, *lam_k1, *lam_q2, *lam_k2, *subln_w, *w_out, *norm_mem_w, *norm_src_w, *w_mq, *w_mk, *w_mv, *w_mo;
  const float *norm_mlp_w, *w_up, *w_down, *norm_final_w;
  float* out;
  u16 *wt_in, *wt_out, *wt_mq, *wt_mk, *wt_mv, *wt_mo, *wt_up, *wt_down, *wt_dec, *wt_a, *wt_g;
  u16 *xn, *pr, *qkd, *vt, *hid, *mix, *qmem, *memn, *kmem, *vtmem, *lora_in;
  float* e_buf; u16 *asig, *gbuf;
  u16 *c_mp, *c_yh, *c_nc, *c_y0; float* c_gc;
  int* counter; u16* vrm; float *ss1, *ss2, *ss3; unsigned* gbar;
  long never;
};

__device__ __forceinline__ int tidx_fresh() { int t = (int)(threadIdx.x & 255u); asm volatile("" : "+v"(t)); return t; }
#define TIDX tidx_fresh()

namespace pg8 {
#define PG8_LAS __attribute__((address_space(3)))
typedef unsigned short bf16_t;
typedef short bf16x8 __attribute__((ext_vector_type(8)));
typedef float f32x4 __attribute__((ext_vector_type(4)));
typedef unsigned u32x4 __attribute__((ext_vector_type(4)));
constexpr int BM = 256, BK = 64, HALF = 128, HTB = HALF * BK * 2  , STAGE_BYTES = 8 * HTB, NXCD = 8, WGM = 8;

__host__ __device__ __forceinline__ int lds_byte(int r, int c) { const int st = (r >> 4) * 2 + (c >> 5), rr = r & 15, cc = c & 31, ob = rr * 64 + cc * 2; return st * 1024 + (ob ^ (((ob >> 9) & 1) << 5)); }
__host__ __device__ __forceinline__ void stage_rc(int b, int& R, int& C) { const int st = b / 1024, sb = b % 1024, swz = sb ^ (((sb >> 9) & 1) << 5); R = (st >> 1) * 16 + swz / 64; C = (st & 1) * 32 + (swz % 64) / 2; }
__host__ __device__ __forceinline__ int perm32(int rho) { const int n = rho >> 4, i = rho & 15; return 8 * (i >> 2) + 4 * n + (i & 3); }

struct Unit { int pm, pn; };
struct Gemm { const bf16_t* A; const bf16_t* Bt; int M, N, K; };

struct StaticOrder {
    int nM, nN, nwg, G, c;
    __host__ __device__ void init(int M, int N, int G_, int c_) { nM = M / BM; nN = N / BM; nwg = nM * nN; G = G_; c = c_; }
    __host__ __device__ bool next(int i, Unit& u) const {
        const long L = (long)i * G + c; if (L >= nwg) return false;
        int wgid = (int)L; { const int q = nwg / NXCD, r = nwg % NXCD, xcd = wgid % NXCD, off = wgid / NXCD; wgid = (xcd < r ? xcd * (q + 1) : r * (q + 1) + (xcd - r) * q) + off; }
        const int nig = WGM * nN, gid = wgid / nig, fm = gid * WGM, gsz = (nM - fm) < WGM ? (nM - fm) : WGM;
        u.pm = fm + ((wgid % nig) % gsz); u.pn = (wgid % nig) / gsz; return true;
    }
    __device__ __forceinline__ void a_ready(const Unit&) const {}
    __device__ __forceinline__ void done(const Unit&) const {}
};
__device__ __forceinline__ unsigned cvt_pk_bf16(float lo, float hi) { unsigned r; asm volatile("v_cvt_pk_bf16_f32 %0, %1, %2" : "=v"(r) : "v"(lo), "v"(hi)); return r; }
template <class Epi, class Sched, bool STAMP = false>
__device__ __forceinline__ void gemm_phase(PG8_LAS unsigned char* lds, const Gemm g, const Sched& S, const Epi& E, unsigned long long* stamps) {
    const int tid = threadIdx.x, wid = __builtin_amdgcn_readfirstlane(tid >> 6), lane = tid & 63, wr = wid >> 2, wc = wid & 3, fr = lane & 15, fq = lane >> 4;
    const int K = g.K, nt = K / BK;
    int ts_lo = 0, ts_hi = 0, nts = 0; const unsigned long long rt_entry = STAMP ? (unsigned long long)wall_clock64() : 0ull;
#define PG8_STAMP() do { if (STAMP && wid == 0 && nts < 64) { const unsigned long long _c = (unsigned long long)clock64(); \
        ts_lo = (lane == nts) ? (int)(unsigned)_c : ts_lo; ts_hi = (lane == nts) ? (int)(unsigned)(_c >> 32) : ts_hi; ++nts; } } while (0)
    PG8_STAMP();
    unsigned voffA[2], voffB[2];
#pragma unroll
    for (int i = 0; i < 2; ++i) { int R, C; stage_rc(tid * 16 + i * 8192, R, C); const int Rb = Epi::PERM ? ((R & ~31) + perm32(R & 31)) : R;
        voffA[i] = (unsigned)(R * K + C) * 2u; voffB[i] = (unsigned)(Rb * K + C) * 2u; }
    const size_t kstep = (size_t)(BK * 2);
    const size_t hstep = (size_t)HALF * K * 2;
    const size_t tstep = 2 * hstep;
    const unsigned ldsw = (unsigned)wid * 1024u;
    const int aoff = lds_byte(wr * 64 + fr, fq * 8), boff = lds_byte(wc * 32 + fr, fq * 8);
#define PG8_SA(b, h) (((b) * 2 + (h)) * HTB)
#define PG8_SB(b, h) ((4 + (b) * 2 + (h)) * HTB)
#define PG8_STAGE(bufoff, gbase, voff) do { _Pragma("unroll") for (int _i = 0; _i < 2; ++_i) \
        __builtin_amdgcn_global_load_lds((const unsigned*)((const char*)(gbase) + (voff)[_i]), (PG8_LAS unsigned*)(lds + (bufoff) + ldsw + _i * 8192), 16, 0, 0); } while (0)
#define PG8_LDA(dst, b, h) do { _Pragma("unroll") for (int m = 0; m < 4; ++m) _Pragma("unroll") for (int k = 0; k < 2; ++k) dst[m][k] = *(const PG8_LAS bf16x8*)(lds + PG8_SA(b, h) + aoff + m * 2048 + k * 1024); } while (0)
#define PG8_LDB(dst, b, h) do { _Pragma("unroll") for (int n = 0; n < 2; ++n) _Pragma("unroll") for (int k = 0; k < 2; ++k) dst[n][k] = *(const PG8_LAS bf16x8*)(lds + PG8_SB(b, h) + boff + n * 2048 + k * 1024); } while (0)
#define PG8_MMA(ai, bj, At, Bt) do { __builtin_amdgcn_s_setprio(1); _Pragma("unroll") for (int m = 0; m < 4; ++m) _Pragma("unroll") for (int n = 0; n < 2; ++n) _Pragma("unroll") for (int k = 0; k < 2; ++k) \
        acc[ai][bj][m][n] = __builtin_amdgcn_mfma_f32_16x16x32_bf16(Bt[n][k], At[m][k], acc[ai][bj][m][n], 0, 0, 0); __builtin_amdgcn_s_setprio(0); } while (0)
#define PG8_WAIT_V(n) asm volatile("s_waitcnt vmcnt(" #n ")" ::: "memory")
#define PG8_WAIT_L(n) asm volatile("s_waitcnt lgkmcnt(" #n ")" ::: "memory")
#define PG8_BAR __builtin_amdgcn_s_barrier()
#define PG8_SCHED __builtin_amdgcn_sched_barrier(0)
    Unit cur, nxt; int ui = 0;
    if (!S.next(0, cur)) return;
    f32x4 acc[2][2][4][2];
#pragma unroll
    for (int a = 0; a < 2; ++a)
#pragma unroll
        for (int b = 0; b < 2; ++b)
#pragma unroll
            for (int m = 0; m < 4; ++m)
#pragma unroll
                for (int n = 0; n < 2; ++n) acc[a][b][m][n] = (f32x4){0.f, 0.f, 0.f, 0.f};
    bf16x8 At[4][2], B0[2][2], B1[2][2];
    const char* cA = (const char*)g.A + (size_t)cur.pm * tstep; const char* cB = (const char*)g.Bt + (size_t)cur.pn * tstep;
    S.a_ready(cur);
    PG8_STAGE(PG8_SB(0, 0), cB, voffB); PG8_STAGE(PG8_SA(0, 0), cA, voffA); PG8_STAGE(PG8_SB(0, 1), cB + hstep, voffB); PG8_STAGE(PG8_SA(0, 1), cA + hstep, voffA);
    if (wr == 1) PG8_BAR;
    PG8_WAIT_V(4); PG8_BAR;
    PG8_STAGE(PG8_SB(1, 0), cB + kstep, voffB); PG8_STAGE(PG8_SA(1, 0), cA + kstep, voffA); PG8_STAGE(PG8_SB(1, 1), cB + hstep + kstep, voffB);
    PG8_WAIT_V(6); PG8_BAR;
    PG8_STAMP();
    for (;;) {
        const bool has_next = S.next(ui + 1, nxt);
        const char* nA = has_next ? (const char*)g.A + (size_t)nxt.pm * tstep : cA; const char* nB = has_next ? (const char*)g.Bt + (size_t)nxt.pn * tstep : cB;
        for (int t = 0; t < nt; t += 2) {
            const bool last = (t == nt - 2);
            const char* a1 = cA + (size_t)(t + 1) * kstep;
            const char* a2 = last ? nA : cA + (size_t)(t + 2) * kstep; const char* b2 = last ? nB : cB + (size_t)(t + 2) * kstep;
            const char* a3 = a2 + kstep; const char* b3 = b2 + kstep;
            if (last && has_next) S.a_ready(nxt);
            PG8_LDB(B0, 0, 0); PG8_SCHED; PG8_LDA(At, 0, 0); PG8_STAGE(PG8_SA(1, 1), a1 + hstep, voffA);
            PG8_WAIT_L(8); PG8_BAR; PG8_WAIT_L(0); PG8_MMA(0, 0, At, B0); PG8_BAR; PG8_SCHED;
            PG8_LDB(B1, 0, 1); PG8_STAGE(PG8_SB(0, 0), b2, voffB);
            PG8_BAR; PG8_WAIT_L(0); PG8_MMA(0, 1, At, B1); PG8_BAR;
            PG8_LDA(At, 0, 1); PG8_STAGE(PG8_SA(0, 0), a2, voffA);
            PG8_BAR; PG8_WAIT_L(0); PG8_MMA(1, 0, At, B0); PG8_BAR; PG8_SCHED;
            PG8_STAGE(PG8_SB(0, 1), b2 + hstep, voffB);
            PG8_WAIT_V(6); PG8_BAR; PG8_MMA(1, 1, At, B1); PG8_BAR;
            PG8_LDB(B0, 1, 0); PG8_SCHED; PG8_LDA(At, 1, 0); PG8_STAGE(PG8_SA(0, 1), a2 + hstep, voffA);
            PG8_WAIT_L(8); PG8_BAR; PG8_WAIT_L(0); PG8_MMA(0, 0, At, B0); PG8_BAR; PG8_SCHED;
            PG8_LDB(B1, 1, 1); PG8_STAGE(PG8_SB(1, 0), b3, voffB);
            PG8_BAR; PG8_WAIT_L(0); PG8_MMA(0, 1, At, B1); PG8_BAR;
            PG8_LDA(At, 1, 1); PG8_STAGE(PG8_SA(1, 0), a3, voffA);
            PG8_BAR; PG8_WAIT_L(0); PG8_MMA(1, 0, At, B0); PG8_BAR; PG8_SCHED;
            PG8_STAGE(PG8_SB(1, 1), b3 + hstep, voffB);
            PG8_WAIT_V(6); PG8_BAR; PG8_MMA(1, 1, At, B1); PG8_BAR;
        }
        PG8_STAMP();
        if constexpr (!Epi::AFTER_DRAIN) { E(acc, cur, wr, wc, fr, fq); S.done(cur); }
        PG8_STAMP();
        if (!has_next) break;
#pragma unroll
        for (int a = 0; a < 2; ++a)
#pragma unroll
            for (int b = 0; b < 2; ++b)
#pragma unroll
                for (int m = 0; m < 4; ++m)
#pragma unroll
                    for (int n = 0; n < 2; ++n) acc[a][b][m][n] = (f32x4){0.f, 0.f, 0.f, 0.f};
        cur = nxt; cA = nA; cB = nB; ++ui;
    }
    PG8_WAIT_V(0);
    if (wr == 0) PG8_BAR;
    PG8_BAR;
    if constexpr (Epi::AFTER_DRAIN) { E.fused(acc, cur, wr, wc, fr, fq, lds, wid, lane); S.done(cur); }
    PG8_STAMP();
    if (STAMP && wid == 0) { stamps[lane] = lane < nts ? (((unsigned long long)(unsigned)ts_hi << 32) | (unsigned)ts_lo) : 0ull;
        if (lane == 62) stamps[62] = rt_entry; if (lane == 63) stamps[63] = (unsigned long long)wall_clock64(); }
#undef PG8_STAMP
#undef PG8_SA
#undef PG8_SB
#undef PG8_STAGE
#undef PG8_LDA
#undef PG8_LDB
#undef PG8_MMA
#undef PG8_WAIT_V
#undef PG8_WAIT_L
#undef PG8_BAR
#undef PG8_SCHED
}

struct EpiWinP {
    static constexpr bool PERM = true, AFTER_DRAIN = false;
    bf16_t *pr, *qkd, *vrm;
    __device__ __forceinline__ void operator()(const f32x4 (&acc)[2][2][4][2], const Unit& u, int wr, int wc, int fr, int fq) const {
        const int row0 = u.pm * BM + wr * 64 + fr;
        bf16_t* base; int ldc, colt;
        if (u.pn < 7) { base = pr; ldc = 1792; colt = u.pn * 256; }
        else if (u.pn < 11) { base = qkd; ldc = 1024; colt = (u.pn - 7) * 256; }
        else { base = vrm; ldc = 512; colt = (u.pn - 11) * 256; }
        const int col0 = colt + wc * 32 + 8 * fq;
#pragma unroll
        for (int ai = 0; ai < 2; ++ai)
#pragma unroll
            for (int m = 0; m < 4; ++m) { bf16_t* rowp = base + (size_t)(row0 + ai * HALF + m * 16) * ldc + col0;
#pragma unroll
                for (int bj = 0; bj < 2; ++bj) { const f32x4 v0 = acc[ai][bj][m][0], v1 = acc[ai][bj][m][1];
                    u32x4 w; w.x = cvt_pk_bf16(v0[0], v0[1]); w.y = cvt_pk_bf16(v0[2], v0[3]); w.z = cvt_pk_bf16(v1[0], v1[1]); w.w = cvt_pk_bf16(v1[2], v1[3]);
                    *(u32x4*)(rowp + bj * HALF) = w; } }
    }
};
template <int ACT  > struct EpiBf16P {
    static constexpr bool PERM = true, AFTER_DRAIN = false;
    bf16_t* O; int ldc;
    __device__ __forceinline__ void operator()(const f32x4 (&acc)[2][2][4][2], const Unit& u, int wr, int wc, int fr, int fq) const {
        const int row0 = u.pm * BM + wr * 64 + fr, col0 = u.pn * BM + wc * 32 + 8 * fq;
#pragma unroll
        for (int ai = 0; ai < 2; ++ai)
#pragma unroll
            for (int m = 0; m < 4; ++m) { bf16_t* rowp = O + (size_t)(row0 + ai * HALF + m * 16) * ldc + col0;
#pragma unroll
                for (int bj = 0; bj < 2; ++bj) { f32x4 v0 = acc[ai][bj][m][0], v1 = acc[ai][bj][m][1];
                    if (ACT == 1) {
#pragma unroll
                        for (int j = 0; j < 4; ++j) { const float a = fmaxf(v0[j], 0.f), b = fmaxf(v1[j], 0.f); v0[j] = a * a; v1[j] = b * b; } }
                    u32x4 w; w.x = cvt_pk_bf16(v0[0], v0[1]); w.y = cvt_pk_bf16(v0[2], v0[3]); w.z = cvt_pk_bf16(v1[0], v1[1]); w.w = cvt_pk_bf16(v1[2], v1[3]);
                    *(u32x4*)(rowp + bj * HALF) = w; } }
    }
};
struct EpiResP {
    static constexpr bool PERM = false, AFTER_DRAIN = false;
    float* H; const float* R;
    __device__ __forceinline__ void operator()(const f32x4 (&acc)[2][2][4][2], const Unit& u, int wr, int wc, int fr, int fq) const {
        const int row0 = u.pm * BM + wr * 64 + fr, col0 = u.pn * BM + wc * 32 + 4 * fq;
#pragma unroll
        for (int ai = 0; ai < 2; ++ai)
#pragma unroll
            for (int m = 0; m < 4; ++m) { const size_t ro = (size_t)(row0 + ai * HALF + m * 16) * 1024 + col0;
#pragma unroll
                for (int bj = 0; bj < 2; ++bj)
#pragma unroll
                    for (int n = 0; n < 2; ++n) { const f32x4 rv = *(const f32x4*)(R + ro + bj * HALF + n * 16);
                        *(f32x4*)(H + ro + bj * HALF + n * 16) = rv + acc[ai][bj][m][n]; } }
    }
};

template <bool RBF, bool WF32, bool WBF> struct EpiResNormP {
    static constexpr bool PERM = false, AFTER_DRAIN = false;
    float* H; const void* R; bf16_t* XB; float* SS;
    __device__ __forceinline__ void operator()(const f32x4 (&acc)[2][2][4][2], const Unit& u, int wr, int wc, int fr, int fq) const {
        const int row0 = u.pm * BM + wr * 64 + fr, col0 = u.pn * BM + wc * 32 + 4 * fq;
#pragma unroll
        for (int ai = 0; ai < 2; ++ai)
#pragma unroll
            for (int m = 0; m < 4; ++m) { const int row = row0 + ai * HALF + m * 16; const size_t ro = (size_t)row * 1024 + col0;
                float ss = 0.f;
#pragma unroll
                for (int bj = 0; bj < 2; ++bj)
#pragma unroll
                    for (int n = 0; n < 2; ++n) { const size_t o = ro + bj * HALF + n * 16;
                        f32x4 rv;
                        if (RBF) { const uint2 rb = *(const uint2*)((const bf16_t*)R + o);
                            rv[0] = __uint_as_float(rb.x << 16); rv[1] = __uint_as_float(rb.x & 0xffff0000u); rv[2] = __uint_as_float(rb.y << 16); rv[3] = __uint_as_float(rb.y & 0xffff0000u); }
                        else rv = *(const f32x4*)((const float*)R + o);
                        const f32x4 hv = rv + acc[ai][bj][m][n];
                        if (WF32) *(f32x4*)(H + o) = hv;
                        if (WBF) { uint2 w; w.x = cvt_pk_bf16(hv[0], hv[1]); w.y = cvt_pk_bf16(hv[2], hv[3]);
                            *(uint2*)(XB + o) = w;
                            ss += hv[0] * hv[0] + hv[1] * hv[1] + hv[2] * hv[2] + hv[3] * hv[3]; } }
                if (WBF) { ss += __shfl_xor(ss, 16); ss += __shfl_xor(ss, 32);
                    if (fq == 0) atomicAdd(SS + row, ss); } }
    }
};
template <int ACT  > struct EpiBf16NormP {
    static constexpr bool PERM = true, AFTER_DRAIN = false;
    bf16_t* O; int ldc; const float* SS;
    __device__ __forceinline__ void operator()(const f32x4 (&acc)[2][2][4][2], const Unit& u, int wr, int wc, int fr, int fq) const {
        const int row0 = u.pm * BM + wr * 64 + fr, col0 = u.pn * BM + wc * 32 + 8 * fq;
#pragma unroll
        for (int ai = 0; ai < 2; ++ai)
#pragma unroll
            for (int m = 0; m < 4; ++m) { const int row = row0 + ai * HALF + m * 16; bf16_t* rowp = O + (size_t)row * ldc + col0;
                const float rs = rsqrtf(SS[row] * (1.f / 1024.f) + 1e-5f);
#pragma unroll
                for (int bj = 0; bj < 2; ++bj) { f32x4 v0 = acc[ai][bj][m][0] * rs, v1 = acc[ai][bj][m][1] * rs;
                    if (ACT == 1) {
#pragma unroll
                        for (int j = 0; j < 4; ++j) { const float a = fmaxf(v0[j], 0.f), b = fmaxf(v1[j], 0.f); v0[j] = a * a; v1[j] = b * b; } }
                    u32x4 w; w.x = cvt_pk_bf16(v0[0], v0[1]); w.y = cvt_pk_bf16(v0[2], v0[3]); w.z = cvt_pk_bf16(v1[0], v1[1]); w.w = cvt_pk_bf16(v1[2], v1[3]);
                    *(u32x4*)(rowp + bj * HALF) = w; } }
    }
};
}


DI void transpose_w(const float* __restrict__ W, u16* __restrict__ Wt, int K, int N, int bid, int nb, char* smem,
                    const float* __restrict__ kscale = nullptr) {
  float(*tile)[65] = (float(*)[65])smem;
  const int tid = TIDX;
  const int tn = N / 64, nt = (K / 64) * tn;
  for (int t = bid; t < nt; t += nb) {
    const int k0 = (t / tn) * 64, n0 = (t % tn) * 64;
#pragma unroll
    for (int i = 0; i < 4; ++i) {
      const int r = (tid >> 4) + i * 16, c = (tid & 15) * 4;
      const float4 v = *(const float4*)(W + (long)(k0 + r) * N + n0 + c);
      const float sc = kscale ? kscale[k0 + r] : 1.f;
      tile[r][c] = v.x * sc; tile[r][c + 1] = v.y * sc; tile[r][c + 2] = v.z * sc; tile[r][c + 3] = v.w * sc;
    }
    __syncthreads();
#pragma unroll
    for (int i = 0; i < 2; ++i) {
      const int c = tid + i * 256, n = c >> 3, kk = (c & 7) * 8;
      uint4 o;
      o.x = f2bf(tile[kk][n]) | ((unsigned)f2bf(tile[kk + 1][n]) << 16);
      o.y = f2bf(tile[kk + 2][n]) | ((unsigned)f2bf(tile[kk + 3][n]) << 16);
      o.z = f2bf(tile[kk + 4][n]) | ((unsigned)f2bf(tile[kk + 5][n]) << 16);
      o.w = f2bf(tile[kk + 6][n]) | ((unsigned)f2bf(tile[kk + 7][n]) << 16);
      *(uint4*)(Wt + (long)(n0 + n) * K + k0 + kk) = o;
    }
    __syncthreads();
  }
}

template <bool BF>
DI void rmsnorm_phase(const float* in, const float* __restrict__ w, void* outp, int rows, int bid, int nb) {
  constexpr int RPW = 2;
  const int tid = TIDX, lane = tid & 63;
  const int wave = bid * 4 + (tid >> 6), nw = nb * 4;
  float4 wv[4];
#pragma unroll
  for (int i = 0; i < 4; ++i) wv[i] = ((const float4*)w)[lane + i * 64];
  float4 v[RPW][4], nv[RPW][4];
  int row0 = wave * RPW;
  if (row0 < rows) {
#pragma unroll
    for (int r = 0; r < RPW; ++r)
#pragma unroll
      for (int i = 0; i < 4; ++i) nv[r][i] = ((const float4*)(in + (long)(row0 + r) * 1024))[lane + i * 64];
  }
  for (; row0 < rows; row0 += nw * RPW) {
#pragma unroll
    for (int r = 0; r < RPW; ++r)
#pragma unroll
      for (int i = 0; i < 4; ++i) v[r][i] = nv[r][i];
    const int rown = min(row0 + nw * RPW, rows - RPW);
#pragma unroll
    for (int r = 0; r < RPW; ++r)
#pragma unroll
      for (int i = 0; i < 4; ++i) nv[r][i] = ((const float4*)(in + (long)(rown + r) * 1024))[lane + i * 64];
#pragma unroll
    for (int r = 0; r < RPW; ++r) {
      float ss = 0.f;
#pragma unroll
      for (int i = 0; i < 4; ++i) ss += v[r][i].x * v[r][i].x + v[r][i].y * v[r][i].y + v[r][i].z * v[r][i].z + v[r][i].w * v[r][i].w;
      ss = wave_sum(ss);
      const float rs = rsqrtf(ss * (1.f / 1024.f) + 1e-5f);
#pragma unroll
      for (int i = 0; i < 4; ++i) {
        f32x4 y;
        y[0] = v[r][i].x * rs * wv[i].x; y[1] = v[r][i].y * rs * wv[i].y; y[2] = v[r][i].z * rs * wv[i].z; y[3] = v[r][i].w * rs * wv[i].w;
        if (BF) {
          *(u16x4*)((u16*)outp + (long)(row0 + r) * 1024 + (lane + i * 64) * 4) = pack4(y);
        } else {
          *(f32x4*)((float*)outp + (long)(row0 + r) * 1024 + (lane + i * 64) * 4) = y;
        }
      }
    }
  }
}

constexpr int GBM = 128, GBN = 128, GBK = 64;
constexpr int GTILE = 128 * 64;
template <int VT_FROM, class Epi>
DI void gemm_phase(const u16* __restrict__ A, int lda, const u16* __restrict__ Bt, int ldb, int M, int N, int K, Epi epi,
                   int bid, int nb, char* smem, u16* vt_out = nullptr) {
  u16* sA = (u16*)smem;
  u16* sB = sA + 2 * GTILE;
  const int tid = TIDX, lane = tid & 63, wid = tid >> 6, wr = wid >> 1, wc = wid & 1;
  const int fr = lane & 15, fq = lane >> 4;
  const int ntm = M / GBM, ntn = N / GBN, nk = K / GBK;
  const int lrow = tid >> 3, lkc = (tid & 7) * 8;
  const int st_off = lrow * 64 + (((tid & 7) ^ ((lrow >> 1) & 7)) << 3);
  const int fa_off = (wr * 64 + fr) * 64, fb_off = (wc * 64 + fr) * 64;
  const int fx0 = ((fq ^ (fr >> 1)) << 3), fx1 = (((4 + fq) ^ (fr >> 1)) << 3);
  const int ntiles = ntm * ntn;
  for (int s = bid; s < ntiles; s += nb) {
    const int tm = s / ntn, tn = s % ntn;
    const u16* Ag = A + (long)(tm * GBM) * lda;
    const u16* Bg = Bt + (long)(tn * GBN) * ldb;
    const unsigned voA = (unsigned)(lrow * lda + lkc), voB = (unsigned)(lrow * ldb + lkc);
    f32x4 acc[4][4];
#pragma unroll
    for (int m = 0; m < 4; ++m)
#pragma unroll
      for (int n = 0; n < 4; ++n) acc[m][n] = (f32x4){0.f, 0.f, 0.f, 0.f};
    uint4 ra0_0, ra0_1, ra0_2, ra0_3, rb0_0, rb0_1, rb0_2, rb0_3, ra1_0, ra1_1, ra1_2, ra1_3, rb1_0, rb1_1, rb1_2, rb1_3;
    bf16x8 af0[4], bf0[4], af1[4], bf1[4];
#define G_LOAD1(RA, RB, KT, I)                                                     \
  RA##_##I = *(const uint4*)((Ag + ((long)(I * 32) * lda + (KT) * GBK)) + voA);    \
  RB##_##I = *(const uint4*)((Bg + ((long)(I * 32) * ldb + (KT) * GBK)) + voB);
#define G_LOAD(RA, RB, KT) G_LOAD1(RA, RB, KT, 0) G_LOAD1(RA, RB, KT, 1) G_LOAD1(RA, RB, KT, 2) G_LOAD1(RA, RB, KT, 3)
#define G_STORE1(RA, RB, BUF, I)                                                   \
  *(uint4*)(sA + (BUF) * GTILE + st_off + I * 2048) = RA##_##I;                    \
  *(uint4*)(sB + (BUF) * GTILE + st_off + I * 2048) = RB##_##I;
#define G_STORE(RA, RB, BUF) G_STORE1(RA, RB, BUF, 0) G_STORE1(RA, RB, BUF, 1) G_STORE1(RA, RB, BUF, 2) G_STORE1(RA, RB, BUF, 3)
#define G_LDF(AF, BF, BUF, FX)                                                     \
  _Pragma("unroll") for (int m = 0; m < 4; ++m) {                                  \
    AF[m] = *(const bf16x8*)(sA + (BUF) * GTILE + fa_off + m * 1024 + FX);         \
    BF[m] = *(const bf16x8*)(sB + (BUF) * GTILE + fb_off + m * 1024 + FX);         \
  }
#define G_MMA(AF, BF)                                                              \
  _Pragma("unroll") for (int m = 0; m < 4; ++m)                                    \
    _Pragma("unroll") for (int n = 0; n < 4; ++n) acc[m][n] = mfma16(BF[n], AF[m], acc[m][n]);
    if (nk & 1) {
      G_LOAD(ra0, rb0, 0);
      G_STORE(ra0, rb0, 0);
      __syncthreads();
      for (int kt = 0; kt < nk; ++kt) {
        const int cur = kt & 1;
        if (kt + 1 < nk) { G_LOAD(ra0, rb0, kt + 1); }
        G_LDF(af0, bf0, cur, fx0);
        G_LDF(af1, bf1, cur, fx1);
        G_MMA(af0, bf0);
        G_MMA(af1, bf1);
        if (kt + 1 < nk) { G_STORE(ra0, rb0, cur ^ 1); }
        __syncthreads();
      }
    } else {
      G_LOAD(ra0, rb0, 0);
      G_LOAD(ra1, rb1, 1);
      G_STORE(ra0, rb0, 0);
      __syncthreads();
      G_LDF(af0, bf0, 0, fx0);
      for (int kt = 0; kt < nk; kt += 2) {
        const int k2 = min(kt + 2, nk - 1), k3 = min(kt + 3, nk - 1);
        G_LOAD(ra0, rb0, k2);
        G_LDF(af1, bf1, 0, fx1);
        G_MMA(af0, bf0);
        G_STORE(ra1, rb1, 1);
        __syncthreads();
        G_LDF(af0, bf0, 1, fx0);
        G_MMA(af1, bf1);
        G_LOAD(ra1, rb1, k3);
        G_LDF(af1, bf1, 1, fx1);
        G_MMA(af0, bf0);
        G_STORE(ra0, rb0, 0);
        __syncthreads();
        G_LDF(af0, bf0, 0, fx0);
        G_MMA(af1, bf1);
      }
    }
#undef G_LOAD
#undef G_STORE
#undef G_LOAD1
#undef G_STORE1
#undef G_LDF
#undef G_MMA
    if (VT_FROM >= 0 && tn >= VT_FROM) {
      constexpr int TLD = 136;
      u16* Tt = (u16*)smem;
      __syncthreads();
#pragma unroll
      for (int m = 0; m < 4; ++m)
#pragma unroll
        for (int n = 0; n < 4; ++n)
#pragma unroll
          for (int j = 0; j < 4; ++j)
            Tt[(wc * 64 + n * 16 + fq * 4 + j) * TLD + wr * 64 + m * 16 + fr] = f2bf(acc[m][n][j]);
      __syncthreads();
      const int colL = tid >> 1, half = tid & 1;
      const int row0 = tm * GBM, b = row0 >> 12, s0 = (row0 & 4095) + half * 64;
      const int c = (tn - VT_FROM) * GBN + colL;
      u16* dst = vt_out + ((long)(b * 512 + c)) * 4096 + s0;
#pragma unroll
      for (int i = 0; i < 8; ++i) *(uint4*)(dst + i * 8) = *(const uint4*)(Tt + colL * TLD + half * 64 + i * 8);
      __syncthreads();
    } else {
#pragma unroll
      for (int m = 0; m < 4; ++m)
#pragma unroll
        for (int n = 0; n < 4; ++n)
          epi(tm * GBM + wr * 64 + m * 16 + fr, tn * GBN + wc * 64 + n * 16 + fq * 4, acc[m][n]);
      __syncthreads();
    }
  }
}

struct EpiWin {
  u16 *pr, *qkd, *vt;
  DI void operator()(int row, int col, f32x4 v) const {
    if (col < 1792) {
      *(u16x4*)(pr + (long)row * 1792 + col) = pack4(v);
    } else if (col < 2816) {
      *(u16x4*)(qkd + (long)row * 1024 + (col - 1792)) = pack4(v);
    } else {
      const int b = row >> 12, s = row & 4095, c = col - 2816;
#pragma unroll
      for (int j = 0; j < 4; ++j) vt[((long)(b * 512 + c + j)) * 4096 + s] = f2bf(v[j]);
    }
  }
};
struct EpiBf16 {
  u16* o; int ld;
  DI void operator()(int row, int col, f32x4 v) const { *(u16x4*)(o + (long)row * ld + col) = pack4(v); }
};
struct EpiVtMem {
  u16* o;
  DI void operator()(int row, int col, f32x4 v) const {
    const int b = row >> 8, m = row & 255;
#pragma unroll
    for (int j = 0; j < 4; ++j) o[((long)(b * 1024 + col + j)) * 256 + m] = f2bf(v[j]);
  }
};
struct EpiKVMem {
  u16 *k, *vt;
  DI void operator()(int row, int col, f32x4 v) const {
    if (col < 1024) {
      *(u16x4*)(k + (long)row * 1024 + col) = pack4(v);
    } else {
      const int b = row >> 8, m = row & 255, c = col - 1024;
#pragma unroll
      for (int j = 0; j < 4; ++j) vt[((long)(b * 1024 + c + j)) * 256 + m] = f2bf(v[j]);
    }
  }
};
struct EpiDecay {
  float* e; const float* w0;
  DI void operator()(int row, int col, f32x4 v) const {
    f32x4 r;
#pragma unroll
    for (int j = 0; j < 4; ++j) {
      const float z = -(w0[col + j] + v[j]);
      const float sp = fmaxf(z, 0.f) + __logf(1.f + __expf(-fabsf(z)));
      r[j] = __expf(-sp - 0.5f);
    }
    *(f32x4*)(e + (long)row * 512 + col) = r;
  }
};
struct EpiASig {
  u16* o; const float* a0;
  DI void operator()(int row, int col, f32x4 v) const {
    f32x4 r;
#pragma unroll
    for (int j = 0; j < 4; ++j) r[j] = __builtin_amdgcn_rcpf(1.f + __expf(-(a0[col + j] + v[j])));
    *(u16x4*)(o + (long)row * 512 + col) = pack4(r);
  }
};
struct EpiResX {
  float* h; const float* x;
  DI void operator()(int row, int col, f32x4 v) const {
    const f32x4 xv = *(const f32x4*)(x + (long)row * 1024 + col);
    *(f32x4*)(h + (long)row * 1024 + col) = xv + v;
  }
};
struct EpiResAcc {
  float* h;
  DI void operator()(int row, int col, f32x4 v) const {
    f32x4* p = (f32x4*)(h + (long)row * 1024 + col);
    *p = *p + v;
  }
};
struct EpiRelu2 {
  u16* o;
  DI void operator()(int row, int col, f32x4 v) const {
    f32x4 r;
#pragma unroll
    for (int j = 0; j < 4; ++j) { const float t = fmaxf(v[j], 0.f); r[j] = t * t; }
    *(u16x4*)(o + (long)row * 4096 + col) = pack4(r);
  }
};

DI void rwkv_prep_phase(const Params& p, int bid, int nb) {
  const long total = (long)T_TOK * 32;
  for (long idx = (long)bid * 256 + TIDX; idx < total; idx += (long)nb * 256) {
    const int t = (int)(idx >> 5), c = (int)(idx & 31) * 8;
    float v[8], pv[8];
    unpack8(*(const uint4*)(p.pr + (long)t * 1792 + 1536 + c), v);
    if (t & 4095) unpack8(*(const uint4*)(p.pr + (long)(t - 1) * 1792 + 1536 + c), pv);
    else {
#pragma unroll
      for (int q = 0; q < 8; ++q) pv[q] = 0.f;
    }
    const float4 m0 = *(const float4*)(p.mu + 1536 + c), m1 = *(const float4*)(p.mu + 1536 + c + 4);
    const float mu[8] = {m0.x, m0.y, m0.z, m0.w, m1.x, m1.y, m1.z, m1.w};
    float y[8];
#pragma unroll
    for (int q = 0; q < 8; ++q) {
      const float xx = v[q] + (pv[q] - v[q]) * mu[q];
      if (c < 64) { const float e2 = __expf(2.f * xx); y[q] = 1.f - 2.f * __builtin_amdgcn_rcpf(e2 + 1.f); }
      else if (c < 128) y[q] = xx;
      else y[q] = __builtin_amdgcn_rcpf(1.f + __expf(-xx));
    }
    *(uint4*)(p.lora_in + idx * 8) = make_uint4(pk2(y[0], y[1]), pk2(y[2], y[3]), pk2(y[4], y[5]), pk2(y[6], y[7]));
  }
}

DI void rwkv_scan_seq(const Params& p, int bh, float* sh) {
  const int lane = TIDX & 63;
  const int b = bh >> 3, h = bh & 7, c = h * 64 + lane;
  const float mu_r = p.mu[c], mu_k = p.mu[512 + c], mu_v = p.mu[1024 + c];
  const float kk_w = p.k_k[c], ka_w = p.k_a[c], rk_w = p.r_k[c], lw = p.lnx_w[c], lb = p.lnx_b[c];
  float st[64];
#pragma unroll
  for (int i = 0; i < 64; ++i) st[i] = 0.f;
  float rp = 0.f, kp = 0.f, vp = 0.f;
  const long tok0 = (long)b * 4096;
  u16 nr = p.pr[tok0 * 1792 + c], nk = p.pr[tok0 * 1792 + 512 + c], nv = p.pr[tok0 * 1792 + 1024 + c];
  float ne = p.e_buf[tok0 * 512 + c];
  u16 na = p.asig[tok0 * 512 + c], ng = p.gbuf[tok0 * 512 + c];
  for (int t = 0; t < 4096; ++t) {
    const float r0 = bf2f(nr), k0 = bf2f(nk), v0 = bf2f(nv), e = ne, a = bf2f(na), g = bf2f(ng);
    if (t + 1 < 4096) {
      const long tk = tok0 + t + 1;
      nr = p.pr[tk * 1792 + c]; nk = p.pr[tk * 1792 + 512 + c]; nv = p.pr[tk * 1792 + 1024 + c];
      ne = p.e_buf[tk * 512 + c]; na = p.asig[tk * 512 + c]; ng = p.gbuf[tk * 512 + c];
    }
    const float r = r0 + (rp - r0) * mu_r, k = k0 + (kp - k0) * mu_k, v = v0 + (vp - v0) * mu_v;
    rp = r0; kp = k0; vp = v0;
    const float w = __expf(-e);
    const float kkv = k * kk_w;
    const float n2 = wave_sum(kkv * kkv);
    const float kk = kkv / fmaxf(sqrtf(n2), 1e-12f);
    const float kmod = k * (1.f + (a - 1.f) * ka_w);
    const float bb = kk * a;
    __syncthreads();
    sh[lane] = w; sh[64 + lane] = kk; sh[128 + lane] = bb; sh[192 + lane] = kmod; sh[256 + lane] = r;
    __syncthreads();
    float sa = 0.f;
#pragma unroll
    for (int q = 0; q < 16; ++q) {
      const float4 k4 = *(const float4*)(sh + 64 + q * 4);
      sa += st[q * 4] * k4.x + st[q * 4 + 1] * k4.y + st[q * 4 + 2] * k4.z + st[q * 4 + 3] * k4.w;
      asm volatile("" : "+v"(sa) :: "memory");
    }
    sa = -sa;
    float y = 0.f;
#pragma unroll
    for (int q = 0; q < 16; ++q) {
      const float4 w4 = *(const float4*)(sh + q * 4);
      const float4 b4 = *(const float4*)(sh + 128 + q * 4);
      const float4 m4 = *(const float4*)(sh + 192 + q * 4);
      const float4 r4 = *(const float4*)(sh + 256 + q * 4);
      st[q * 4] = st[q * 4] * w4.x + sa * b4.x + v * m4.x; y += st[q * 4] * r4.x;
      st[q * 4 + 1] = st[q * 4 + 1] * w4.y + sa * b4.y + v * m4.y; y += st[q * 4 + 1] * r4.y;
      st[q * 4 + 2] = st[q * 4 + 2] * w4.z + sa * b4.z + v * m4.z; y += st[q * 4 + 2] * r4.z;
      st[q * 4 + 3] = st[q * 4 + 3] * w4.w + sa * b4.w + v * m4.w; y += st[q * 4 + 3] * r4.w;
      asm volatile("" : "+v"(y) :: "memory");
    }
    const float mean = wave_sum(y) * (1.f / 64.f);
    const float d = y - mean;
    const float var = wave_sum(d * d) * (1.f / 64.f);
    const float yn = d * rsqrtf(var + 64e-5f) * lw + lb;
    const float bonus = wave_sum(r * kmod * rk_w) * v;
    p.mix[(tok0 + t) * 1024 + c] = f2bf((yn + bonus) * g);
  }
}


constexpr int RLD = 72, SLOT = 64 * RLD;
DI bf16x8 ldfrag(const u16* base, int row, int kofs) { return *(const bf16x8*)(base + row * RLD + kofs); }
DI f32x4 unpack4(u16x4 v) { f32x4 r; r[0] = bf2f(v[0]); r[1] = bf2f(v[1]); r[2] = bf2f(v[2]); r[3] = bf2f(v[3]); return r; }
#define ZERO4 ((f32x4){0.f, 0.f, 0.f, 0.f})

DI void ld8f(const float* __restrict__ p, float* o) {
  const float4 a = *(const float4*)p, b = *(const float4*)(p + 4);
  o[0] = a.x; o[1] = a.y; o[2] = a.z; o[3] = a.w; o[4] = b.x; o[5] = b.y; o[6] = b.z; o[7] = b.w;
}
struct RawIn { uint4 R0, R1, K0, K1, V0, V1, A0, A1, pR0, pR1, pK0, pK1, pV0, pV1; float4 E0, E1, E2, E3; };
DI void chunk_load_raw(const Params& p, int tile, int tid, RawIn& w) {
  const int ch = tile & 63, bh = tile >> 6, b = bh >> 3, h = bh & 7;
  const int t = tid >> 2, i0 = (tid & 3) * 16;
  const long tok = (long)b * 4096 + ch * 64 + t;
  const int col = h * 64 + i0;
  const bool first = (ch == 0 && t == 0);
  const u16* pc = p.pr + tok * 1792 + col;
  const uint4 zero4 = make_uint4(0u, 0u, 0u, 0u);
  w.R0 = *(const uint4*)(pc); w.R1 = *(const uint4*)(pc + 8);
  w.K0 = *(const uint4*)(pc + 512); w.K1 = *(const uint4*)(pc + 520);
  w.V0 = *(const uint4*)(pc + 1024); w.V1 = *(const uint4*)(pc + 1032);
  w.A0 = *(const uint4*)(p.asig + tok * 512 + col); w.A1 = *(const uint4*)(p.asig + tok * 512 + col + 8);
  const u16* pp = first ? pc : pc - 1792;
  const uint4 q0 = *(const uint4*)(pp), q1 = *(const uint4*)(pp + 8), q2 = *(const uint4*)(pp + 512), q3 = *(const uint4*)(pp + 520),
              q4 = *(const uint4*)(pp + 1024), q5 = *(const uint4*)(pp + 1032);
  w.pR0 = first ? zero4 : q0; w.pR1 = first ? zero4 : q1; w.pK0 = first ? zero4 : q2; w.pK1 = first ? zero4 : q3;
  w.pV0 = first ? zero4 : q4; w.pV1 = first ? zero4 : q5;
  const float4* ep = (const float4*)(p.e_buf + tok * 512 + col);
  w.E0 = ep[0]; w.E1 = ep[1]; w.E2 = ep[2]; w.E3 = ep[3];
}
DI void rwkv_chunk_prep(const Params& p, int tile, int next_tile, RawIn& raw, char* smem) {
  int tid_ = TIDX;
  asm volatile("" : "+v"(tid_));
  const int tid = tid_, lane = tid & 63, wid = tid >> 6, fr = lane & 15, fq = lane >> 4;
  const int ch = tile & 63, bh = tile >> 6, b = bh >> 3, h = bh & 7;
  u16* S = (u16*)smem;
  u16 *S0 = S, *S1 = S + SLOT, *S2 = S + 2 * SLOT, *S3 = S + 3 * SLOT, *S4 = S + 4 * SLOT, *S5 = S + 5 * SLOT,
      *S6 = S + 6 * SLOT, *S7 = S + 7 * SLOT;
  float* Ef = (float*)S4;
  __syncthreads();
  const int t = tid >> 2, i0 = (tid & 3) * 16;
  const long tok = (long)b * 4096 + ch * 64 + t;
  const int col = h * 64 + i0;
  *(float4*)(Ef + t * 64 + i0) = raw.E0; *(float4*)(Ef + t * 64 + i0 + 4) = raw.E1;
  *(float4*)(Ef + t * 64 + i0 + 8) = raw.E2; *(float4*)(Ef + t * 64 + i0 + 12) = raw.E3;
  __syncthreads();
  {
    const int cc = tid & 63, qq = tid >> 6;
    float s = 0.f;
#pragma unroll
    for (int tt = 0; tt < 16; ++tt) { s += Ef[(qq * 16 + tt) * 64 + cc]; Ef[(qq * 16 + tt) * 64 + cc] = s; }
  }
  __syncthreads();
  float n2 = 0.f, bon = 0.f;
#pragma unroll
  for (int hf = 0; hf < 2; ++hf) {
    const int o = hf * 8;
    float r[8], k[8], a[8], rp[8], kp[8];
    unpack8(hf ? raw.R1 : raw.R0, r); unpack8(hf ? raw.K1 : raw.K0, k); unpack8(hf ? raw.A1 : raw.A0, a);
    unpack8(hf ? raw.pR1 : raw.pR0, rp); unpack8(hf ? raw.pK1 : raw.pK0, kp);
    float mur[8], muk[8], wkk[8], wka[8], wrk[8];
    ld8f(p.mu + col + o, mur); ld8f(p.mu + 512 + col + o, muk); ld8f(p.k_k + col + o, wkk); ld8f(p.k_a + col + o, wka); ld8f(p.r_k + col + o, wrk);
#pragma unroll
    for (int q = 0; q < 8; ++q) {
      const float rr = r[q] + (rp[q] - r[q]) * mur[q];
      const float kx = k[q] + (kp[q] - k[q]) * muk[q];
      const float kkv = kx * wkk[q];
      n2 += kkv * kkv;
      bon += rr * kx * (1.f + (a[q] - 1.f) * wka[q]) * wrk[q];
    }
  }
  n2 += __shfl_xor(n2, 1); n2 += __shfl_xor(n2, 2);
  bon += __shfl_xor(bon, 1); bon += __shfl_xor(bon, 2);
  const float kinv = __builtin_amdgcn_rcpf(fmaxf(__builtin_amdgcn_sqrtf(n2), 1e-12f));
  unsigned pa[8], pbh[8], pkh[8];
  const int tq = t >> 4;
#pragma unroll
  for (int hf = 0; hf < 2; ++hf) {
    const int o = hf * 8;
    float r[8], k[8], v[8], a[8], e[8];
    {
      float rp[8], kp[8], vp[8];
      unpack8(hf ? raw.R1 : raw.R0, r); unpack8(hf ? raw.K1 : raw.K0, k); unpack8(hf ? raw.V1 : raw.V0, v); unpack8(hf ? raw.A1 : raw.A0, a);
      unpack8(hf ? raw.pR1 : raw.pR0, rp); unpack8(hf ? raw.pK1 : raw.pK0, kp); unpack8(hf ? raw.pV1 : raw.pV0, vp);
      float mur[8], muk[8], muv[8];
      ld8f(p.mu + col + o, mur); ld8f(p.mu + 512 + col + o, muk); ld8f(p.mu + 1024 + col + o, muv);
#pragma unroll
      for (int q = 0; q < 8; ++q) {
        r[q] = r[q] + (rp[q] - r[q]) * mur[q];
        k[q] = k[q] + (kp[q] - k[q]) * muk[q];
        v[q] = v[q] + (vp[q] - v[q]) * muv[q];
      }
      const float4 e0 = hf ? raw.E2 : raw.E0, e1 = hf ? raw.E3 : raw.E1;
      e[0] = e0.x; e[1] = e0.y; e[2] = e0.z; e[3] = e0.w; e[4] = e1.x; e[5] = e1.y; e[6] = e1.z; e[7] = e1.w;
    }
    float eq0[8], eq1[8], eq2[8], eq3[8], est[8];
    ld8f(Ef + 15 * 64 + i0 + o, eq0); ld8f(Ef + 31 * 64 + i0 + o, eq1); ld8f(Ef + 47 * 64 + i0 + o, eq2); ld8f(Ef + 63 * 64 + i0 + o, eq3);
    ld8f(Ef + t * 64 + i0 + o, est);
    float At[8], Bt[8], Kt[8], Rt[8], Bh[8], Kh[8], bvv[8], wkk[8], wka[8];
    ld8f(p.k_k + col + o, wkk); ld8f(p.k_a + col + o, wka);
#pragma unroll
    for (int q = 0; q < 8; ++q) {
      const int ii = i0 + o + q;
      const float q0 = eq0[q], q1 = eq1[q], q2 = eq2[q], q3 = eq3[q];
      float Sc = est[q];
      if (tq > 0) Sc += q0;
      if (tq > 1) Sc += q1;
      if (tq > 2) Sc += q2;
      const float SC = q0 + q1 + q2 + q3;
      const float kkn = k[q] * wkk[q] * kinv, bv = kkn * a[q];
      const float km = k[q] * (1.f + (a[q] - 1.f) * wka[q]);
      const float eNS = __expf(-Sc), eS = __builtin_amdgcn_rcpf(eNS), ee = __expf(e[q]), eC = __expf(-SC);
      At[q] = -kkn * ee * eNS;
      Rt[q] = r[q] * eNS;
      Bt[q] = bv * eS;
      Kt[q] = km * eS;
      Bh[q] = bv * (eS * eC);
      Kh[q] = km * (eS * eC);
      bvv[q] = bon * v[q];
      if (t == 63) p.c_gc[(long)tile * 64 + ii] = eC;
      S7[ii * RLD + t] = f2bf(v[q]);
    }
    uint4 w0;
#define PACK8(X) w0 = make_uint4(pk2(X[0], X[1]), pk2(X[2], X[3]), pk2(X[4], X[5]), pk2(X[6], X[7]));
    PACK8(At); *(uint4*)(S0 + t * RLD + i0 + o) = w0;
    pa[hf * 4] = w0.x; pa[hf * 4 + 1] = w0.y; pa[hf * 4 + 2] = w0.z; pa[hf * 4 + 3] = w0.w;
    PACK8(Bt); *(uint4*)(S1 + t * RLD + i0 + o) = w0;
    PACK8(Kt); *(uint4*)(S2 + t * RLD + i0 + o) = w0;
    PACK8(Rt); *(uint4*)(S3 + t * RLD + i0 + o) = w0;
    PACK8(Bh);
    pbh[hf * 4] = w0.x; pbh[hf * 4 + 1] = w0.y; pbh[hf * 4 + 2] = w0.z; pbh[hf * 4 + 3] = w0.w;
    PACK8(Kh);
    pkh[hf * 4] = w0.x; pkh[hf * 4 + 1] = w0.y; pkh[hf * 4 + 2] = w0.z; pkh[hf * 4 + 3] = w0.w;
    PACK8(bvv);
    *(uint4*)(p.asig + tok * 512 + col + o) = w0;
#undef PACK8
  }
  chunk_load_raw(p, next_tile, tid, raw);
  __syncthreads();
  const int trow = wid * 16 + fr;
  f32x4 Pacc[4];
  {
    bf16x8 aF[2], rF[2];
#pragma unroll
    for (int ks = 0; ks < 2; ++ks) { aF[ks] = ldfrag(S0, trow, ks * 32 + fq * 8); rF[ks] = ldfrag(S3, trow, ks * 32 + fq * 8); }
    f32x4 lab[4];
#pragma unroll
    for (int nt = 0; nt < 4; ++nt) {
      f32x4 lak = ZERO4, prb = ZERO4, prk = ZERO4;
      lab[nt] = ZERO4;
#pragma unroll
      for (int ks = 0; ks < 2; ++ks) {
        const bf16x8 bF = ldfrag(S1, nt * 16 + fr, ks * 32 + fq * 8), kF = ldfrag(S2, nt * 16 + fr, ks * 32 + fq * 8);
        lab[nt] = mfma16(bF, aF[ks], lab[nt]);
        lak = mfma16(kF, aF[ks], lak);
        prb = mfma16(bF, rF[ks], prb);
        prk = mfma16(kF, rF[ks], prk);
      }
      const int j0 = nt * 16 + fq * 4;
#pragma unroll
      for (int jj = 0; jj < 4; ++jj) {
        const int j = j0 + jj;
        if (!(j < trow)) { lab[nt][jj] = 0.f; lak[jj] = 0.f; }
        if (!(j <= trow)) { prb[jj] = 0.f; prk[jj] = 0.f; }
      }
      *(u16x4*)(S4 + trow * RLD + j0) = pack4(lak);
      *(u16x4*)(S5 + trow * RLD + j0) = pack4(prb);
      *(u16x4*)(S6 + trow * RLD + j0) = pack4(prk);
    }
    __syncthreads();
#pragma unroll
    for (int nt = 0; nt < 4; ++nt) {
      const int j0 = nt * 16 + fq * 4;
      f32x4 pi;
#pragma unroll
      for (int jj = 0; jj < 4; ++jj) {
        const int j = j0 + jj;
        pi[jj] = (j == trow ? 1.f : 0.f);
        S1[j * RLD + trow] = f2bf(lab[nt][jj]);
      }
      Pacc[nt] = pi;
      *(u16x4*)(S0 + trow * RLD + j0) = pack4(lab[nt]);
      *(u16x4*)(S2 + trow * RLD + j0) = pack4(pi);
    }
    __syncthreads();
  }
#pragma unroll 1
  for (int it = 0; it < 5; ++it) {
    bf16x8 pF[2], xF[2];
#pragma unroll
    for (int ks = 0; ks < 2; ++ks) { pF[ks] = ldfrag(S2, trow, ks * 32 + fq * 8); xF[ks] = ldfrag(S0, trow, ks * 32 + fq * 8); }
    f32x4 xn[4];
#pragma unroll
    for (int nt = 0; nt < 4; ++nt) {
      xn[nt] = ZERO4;
#pragma unroll
      for (int ks = 0; ks < 2; ++ks) {
        const bf16x8 xtF = ldfrag(S1, nt * 16 + fr, ks * 32 + fq * 8);
        Pacc[nt] = mfma16(xtF, pF[ks], Pacc[nt]);
        xn[nt] = mfma16(xtF, xF[ks], xn[nt]);
      }
    }
    __syncthreads();
#pragma unroll
    for (int nt = 0; nt < 4; ++nt) {
      const int j0 = nt * 16 + fq * 4;
      *(u16x4*)(S2 + trow * RLD + j0) = pack4(Pacc[nt]);
      *(u16x4*)(S0 + trow * RLD + j0) = pack4(xn[nt]);
#pragma unroll
      for (int jj = 0; jj < 4; ++jj) S1[(j0 + jj) * RLD + trow] = f2bf(xn[nt][jj]);
    }
    __syncthreads();
  }
  {
    bf16x8 pF[2];
#pragma unroll
    for (int ks = 0; ks < 2; ++ks) pF[ks] = ldfrag(S2, trow, ks * 32 + fq * 8);
#pragma unroll
    for (int nt = 0; nt < 4; ++nt)
#pragma unroll
      for (int ks = 0; ks < 2; ++ks) Pacc[nt] = mfma16(ldfrag(S1, nt * 16 + fr, ks * 32 + fq * 8), pF[ks], Pacc[nt]);
    __syncthreads();
#pragma unroll
    for (int nt = 0; nt < 4; ++nt) *(u16x4*)(S2 + trow * RLD + nt * 16 + fq * 4) = pack4(Pacc[nt]);
#pragma unroll
    for (int q = 0; q < 8; ++q) {
      S0[(i0 + 2 * q) * RLD + t] = (u16)(pa[q] & 0xffffu);
      S0[(i0 + 2 * q + 1) * RLD + t] = (u16)(pa[q] >> 16);
    }
    __syncthreads();
  }
  {
    bf16x8 tF[2], lkF[2];
#pragma unroll
    for (int ks = 0; ks < 2; ++ks) { tF[ks] = ldfrag(S2, trow, ks * 32 + fq * 8); lkF[ks] = ldfrag(S4, trow, ks * 32 + fq * 8); }
    f32x4 z[4];
#pragma unroll
    for (int nt = 0; nt < 4; ++nt) {
      f32x4 w1 = ZERO4;
      z[nt] = ZERO4;
#pragma unroll
      for (int ks = 0; ks < 2; ++ks) {
        w1 = mfma16(tF[ks], ldfrag(S0, nt * 16 + fr, ks * 32 + fq * 8), w1);
        z[nt] = mfma16(lkF[ks], ldfrag(S7, nt * 16 + fr, ks * 32 + fq * 8), z[nt]);
      }
      *(u16x4*)(S1 + (nt * 16 + fr) * RLD + wid * 16 + fq * 4) = pack4(w1);
    }
    __syncthreads();
#pragma unroll
    for (int nt = 0; nt < 4; ++nt) *(u16x4*)(S0 + (nt * 16 + fr) * RLD + wid * 16 + fq * 4) = pack4(z[nt]);
    __syncthreads();
#pragma unroll
    for (int nt = 0; nt < 4; ++nt) {
      f32x4 u0 = ZERO4;
#pragma unroll
      for (int ks = 0; ks < 2; ++ks) u0 = mfma16(tF[ks], ldfrag(S0, nt * 16 + fr, ks * 32 + fq * 8), u0);
      *(u16x4*)(S4 + (nt * 16 + fr) * RLD + wid * 16 + fq * 4) = pack4(u0);
    }
    __syncthreads();
#pragma unroll
    for (int q = 0; q < 8; ++q) {
      S0[(i0 + 2 * q) * RLD + t] = (u16)(pbh[q] & 0xffffu);
      S0[(i0 + 2 * q + 1) * RLD + t] = (u16)(pbh[q] >> 16);
      S2[(i0 + 2 * q) * RLD + t] = (u16)(pkh[q] & 0xffffu);
      S2[(i0 + 2 * q + 1) * RLD + t] = (u16)(pkh[q] >> 16);
    }
    __syncthreads();
  }
  {
    bf16x8 bhF[2], khF[2], pbF[2], pkF[2];
#pragma unroll
    for (int ks = 0; ks < 2; ++ks) {
      bhF[ks] = ldfrag(S0, trow, ks * 32 + fq * 8); khF[ks] = ldfrag(S2, trow, ks * 32 + fq * 8);
      pbF[ks] = ldfrag(S5, trow, ks * 32 + fq * 8); pkF[ks] = ldfrag(S6, trow, ks * 32 + fq * 8);
    }
    u16* mp = p.c_mp + (long)tile * 4096;
    u16* yh = p.c_yh + (long)tile * 4096;
    u16* nc = p.c_nc + (long)tile * 4096;
    u16* y0 = p.c_y0 + (long)tile * 4096;
#pragma unroll
    for (int nt = 0; nt < 4; ++nt) {
      f32x4 m = ZERO4, n = ZERO4, yy = ZERO4, yz = ZERO4;
#pragma unroll
      for (int ks = 0; ks < 2; ++ks) {
        const bf16x8 w1F = ldfrag(S1, nt * 16 + fr, ks * 32 + fq * 8);
        const bf16x8 u0F = ldfrag(S4, nt * 16 + fr, ks * 32 + fq * 8);
        const bf16x8 vF = ldfrag(S7, nt * 16 + fr, ks * 32 + fq * 8);
        m = mfma16(w1F, bhF[ks], m);
        n = mfma16(bhF[ks], u0F, n);
        n = mfma16(khF[ks], vF, n);
        yy = mfma16(w1F, pbF[ks], yy);
        yz = mfma16(u0F, pbF[ks], yz);
        yz = mfma16(vF, pkF[ks], yz);
      }
      yy += unpack4(*(const u16x4*)(S3 + trow * RLD + nt * 16 + fq * 4));
      *(u16x4*)(mp + trow * 64 + nt * 16 + fq * 4) = pack4(m);
      *(u16x4*)(yh + trow * 64 + nt * 16 + fq * 4) = pack4(yy);
      *(u16x4*)(nc + ((wid * 4 + nt) * 64 + lane) * 4) = pack4(n);
      *(u16x4*)(y0 + ((wid * 4 + nt) * 64 + lane) * 4) = pack4(yz);
    }
  }
}

DI bf16x8 ldperm(const u16* rowp, int ks, int fq) {
  const u16x4 lo = *(const u16x4*)(rowp + ks * 32 + fq * 4);
  const u16x4 hi = *(const u16x4*)(rowp + ks * 32 + 16 + fq * 4);
  bf16x8 r;
#pragma unroll
  for (int j = 0; j < 4; ++j) { r[j] = (short)lo[j]; r[4 + j] = (short)hi[j]; }
  return r;
}
DI void rwkv_state_pass(const Params& p, int bh, char* smem) {
  const int tid = TIDX, lane = tid & 63, wid = tid >> 6, fr = lane & 15, fq = lane >> 4;
  const int b = bh >> 3, h = bh & 7;
  constexpr int BUFB = 2 * SLOT * 2 + 2 * 8192;
  float* gcs = (float*)(smem + 2 * BUFB);
  float* stats = gcs + 128;
  f32x4 hacc[4];
#pragma unroll
  for (int i = 0; i < 4; ++i) hacc[i] = ZERO4;
  const int cb = h * 64 + wid * 16 + fq * 4;
  const float4 lw = *(const float4*)(p.lnx_w + cb), lb = *(const float4*)(p.lnx_b + cb);
  const int lrow = tid >> 3, lcol = (tid & 7) * 8;
  uint4 pm0, pm1, py0, py1, pn0, pn1, pz0, pz1;
  float pregc = 0.f;
  __syncthreads();
  {
    const long tile = (long)bh * 64;
    const u16 *mp = p.c_mp + tile * 4096, *yh = p.c_yh + tile * 4096, *nc = p.c_nc + tile * 4096, *y0 = p.c_y0 + tile * 4096;
    pm0 = *(const uint4*)(mp + lrow * 64 + lcol); pm1 = *(const uint4*)(mp + (lrow + 32) * 64 + lcol);
    py0 = *(const uint4*)(yh + lrow * 64 + lcol); py1 = *(const uint4*)(yh + (lrow + 32) * 64 + lcol);
    pn0 = *(const uint4*)(nc + tid * 8); pn1 = *(const uint4*)(nc + (tid + 256) * 8);
    pz0 = *(const uint4*)(y0 + tid * 8); pz1 = *(const uint4*)(y0 + (tid + 256) * 8);
    if (tid < 64) pregc = p.c_gc[tile * 64 + tid];
    u16* bf = (u16*)smem;
    *(uint4*)(bf + lrow * RLD + lcol) = pm0; *(uint4*)(bf + (lrow + 32) * RLD + lcol) = pm1;
    *(uint4*)(bf + SLOT + lrow * RLD + lcol) = py0; *(uint4*)(bf + SLOT + (lrow + 32) * RLD + lcol) = py1;
    *(uint4*)(bf + 2 * SLOT + tid * 8) = pn0; *(uint4*)(bf + 2 * SLOT + (tid + 256) * 8) = pn1;
    *(uint4*)(bf + 2 * SLOT + 4096 + tid * 8) = pz0; *(uint4*)(bf + 2 * SLOT + 4096 + (tid + 256) * 8) = pz1;
    if (tid < 64) gcs[tid] = pregc;
  }
  __syncthreads();
#pragma unroll 1
  for (int c = 0; c < 64; ++c) {
    const int cur = c & 1;
    if (c + 1 < 64) {
      const long tile = (long)bh * 64 + c + 1;
      const u16 *mp = p.c_mp + tile * 4096, *yh = p.c_yh + tile * 4096, *nc = p.c_nc + tile * 4096, *y0 = p.c_y0 + tile * 4096;
      pm0 = *(const uint4*)(mp + lrow * 64 + lcol); pm1 = *(const uint4*)(mp + (lrow + 32) * 64 + lcol);
      py0 = *(const uint4*)(yh + lrow * 64 + lcol); py1 = *(const uint4*)(yh + (lrow + 32) * 64 + lcol);
      pn0 = *(const uint4*)(nc + tid * 8); pn1 = *(const uint4*)(nc + (tid + 256) * 8);
      pz0 = *(const uint4*)(y0 + tid * 8); pz1 = *(const uint4*)(y0 + (tid + 256) * 8);
      if (tid < 64) pregc = p.c_gc[tile * 64 + tid];
    }
    const long tg0 = (long)b * 4096 + c * 64;
    u16x4 bvr[4], gr[4];
#pragma unroll
    for (int tt = 0; tt < 4; ++tt) {
      bvr[tt] = *(const u16x4*)(p.asig + (tg0 + tt * 16 + fr) * 512 + cb);
      gr[tt] = *(const u16x4*)(p.gbuf + (tg0 + tt * 16 + fr) * 512 + cb);
    }
    const u16* bf = (const u16*)(smem + cur * BUFB);
    const u16 *Lmp = bf, *Lyh = bf + SLOT, *Lnc = bf + 2 * SLOT, *Ly0 = bf + 2 * SLOT + 4096;
    bf16x8 hf[2];
#pragma unroll
    for (int ks = 0; ks < 2; ++ks)
#pragma unroll
      for (int j = 0; j < 4; ++j) {
        hf[ks][j] = (short)f2bf(hacc[2 * ks][j]);
        hf[ks][4 + j] = (short)f2bf(hacc[2 * ks + 1][j]);
      }
    f32x4 y[4];
#pragma unroll
    for (int tt = 0; tt < 4; ++tt) {
      y[tt] = unpack4(*(const u16x4*)(Ly0 + ((tt * 4 + wid) * 64 + lane) * 4));
#pragma unroll
      for (int ks = 0; ks < 2; ++ks) {
        const u16x4 lo = *(const u16x4*)(Lyh + (tt * 16 + fr) * RLD + ks * 32 + fq * 4);
        const u16x4 hi = *(const u16x4*)(Lyh + (tt * 16 + fr) * RLD + ks * 32 + 16 + fq * 4);
        bf16x8 yF;
#pragma unroll
        for (int j = 0; j < 4; ++j) { yF[j] = (short)lo[j]; yF[4 + j] = (short)hi[j]; }
        y[tt] = mfma16(hf[ks], yF, y[tt]);
      }
      float s1 = y[tt][0] + y[tt][1] + y[tt][2] + y[tt][3];
      float s2 = y[tt][0] * y[tt][0] + y[tt][1] * y[tt][1] + y[tt][2] * y[tt][2] + y[tt][3] * y[tt][3];
      s1 += __shfl_xor(s1, 16); s1 += __shfl_xor(s1, 32);
      s2 += __shfl_xor(s2, 16); s2 += __shfl_xor(s2, 32);
      if (fq == 0) *(float2*)(stats + ((cur * 4 + wid) * 64 + tt * 16 + fr) * 2) = make_float2(s1, s2);
    }
#pragma unroll
    for (int it = 0; it < 4; ++it) {
      const f32x4 nn = unpack4(*(const u16x4*)(Lnc + ((it * 4 + wid) * 64 + lane) * 4));
      const float4 g4 = *(const float4*)(gcs + cur * 64 + it * 16 + fq * 4);
      f32x4 a;
      a[0] = hacc[it][0] * g4.x + nn[0]; a[1] = hacc[it][1] * g4.y + nn[1];
      a[2] = hacc[it][2] * g4.z + nn[2]; a[3] = hacc[it][3] * g4.w + nn[3];
#pragma unroll
      for (int ks = 0; ks < 2; ++ks) {
        const u16x4 lo = *(const u16x4*)(Lmp + (it * 16 + fr) * RLD + ks * 32 + fq * 4);
        const u16x4 hi = *(const u16x4*)(Lmp + (it * 16 + fr) * RLD + ks * 32 + 16 + fq * 4);
        bf16x8 mF;
#pragma unroll
        for (int j = 0; j < 4; ++j) { mF[j] = (short)lo[j]; mF[4 + j] = (short)hi[j]; }
        a = mfma16(mF, hf[ks], a);
      }
      hacc[it] = a;
    }
    if (c + 1 < 64) {
      u16* nb_ = (u16*)(smem + (cur ^ 1) * BUFB);
      *(uint4*)(nb_ + lrow * RLD + lcol) = pm0; *(uint4*)(nb_ + (lrow + 32) * RLD + lcol) = pm1;
      *(uint4*)(nb_ + SLOT + lrow * RLD + lcol) = py0; *(uint4*)(nb_ + SLOT + (lrow + 32) * RLD + lcol) = py1;
      *(uint4*)(nb_ + 2 * SLOT + tid * 8) = pn0; *(uint4*)(nb_ + 2 * SLOT + (tid + 256) * 8) = pn1;
      *(uint4*)(nb_ + 2 * SLOT + 4096 + tid * 8) = pz0; *(uint4*)(nb_ + 2 * SLOT + 4096 + (tid + 256) * 8) = pz1;
      if (tid < 64) gcs[(cur ^ 1) * 64 + tid] = pregc;
    }
    __syncthreads();
#pragma unroll
    for (int tt = 0; tt < 4; ++tt) {
      float s1 = 0.f, s2 = 0.f;
#pragma unroll
      for (int w = 0; w < 4; ++w) {
        const float2 st = *(const float2*)(stats + ((cur * 4 + w) * 64 + tt * 16 + fr) * 2);
        s1 += st.x; s2 += st.y;
      }
      const float mean = s1 * (1.f / 64.f);
      const float var = fmaxf(s2 * (1.f / 64.f) - mean * mean, 0.f);
      const float rstd = rsqrtf(var + 64e-5f);
      const f32x4 bv = unpack4(bvr[tt]), g = unpack4(gr[tt]);
      f32x4 o;
      o[0] = ((y[tt][0] - mean) * rstd * lw.x + lb.x + bv[0]) * g[0];
      o[1] = ((y[tt][1] - mean) * rstd * lw.y + lb.y + bv[1]) * g[1];
      o[2] = ((y[tt][2] - mean) * rstd * lw.z + lb.z + bv[2]) * g[2];
      o[3] = ((y[tt][3] - mean) * rstd * lw.w + lb.w + bv[3]) * g[3];
      *(u16x4*)(p.mix + (tg0 + tt * 16 + fr) * 1024 + cb) = pack4(o);
    }
  }
}

template <int DQK, int DV, int NMAP, bool DIFF, int KT>
DI void attn_tile(const u16* __restrict__ Q, long q_stride, const u16* __restrict__ Kg, long k_stride,
                  const u16* __restrict__ Vtg, long vt_stride, int nkt, float scale, u16* __restrict__ Out, long o_stride,
                  float lam, const float* __restrict__ subw, char* smem, int lag) {
  constexpr int KW = NMAP * DQK, KLD = KW + 8, VLD = KT + 8;
  constexpr int KCH = KT * (KW / 8) / 256, VCH = DV * (KT / 8) / 256;
  constexpr int BUFE = KT * KLD + DV * VLD;
  constexpr bool DB = (2 * BUFE * 2 <= 79 * 1024);
  constexpr int VRS = 256 / (KT / 8);
  u16* S0 = (u16*)smem;
  const int tid = TIDX, lane = tid & 63, wid = tid >> 6, fr = lane & 15, fq = lane >> 4;
  bf16x8 qf[NMAP][DQK / 32];
#pragma unroll
  for (int m = 0; m < NMAP; ++m)
#pragma unroll
    for (int ks = 0; ks < DQK / 32; ++ks)
      qf[m][ks] = *(const bf16x8*)(Q + (long)(wid * 16 + fr) * q_stride + m * DQK + ks * 32 + fq * 8);
  f32x4 o[NMAP][DV / 16];
  float mrun[NMAP], lrun[NMAP];
#pragma unroll
  for (int m = 0; m < NMAP; ++m) {
    mrun[m] = -1e30f; lrun[m] = 0.f;
#pragma unroll
    for (int dt = 0; dt < DV / 16; ++dt) o[m][dt] = (f32x4){0.f, 0.f, 0.f, 0.f};
  }
  static_assert(DB && KCH == 4 && VCH == 4, "prefetch registers are written out for 4 + 4 chunks");
  uint4 kr0, kr1, kr2, kr3, vr0, vr1, vr2, vr3;
  const int krow = tid / (KW / 8), kcc = (tid % (KW / 8)) * 8;
  constexpr int KRS = 256 / (KW / 8);
  const int vrow = tid / (KT / 8), vcc = (tid % (KT / 8)) * 8;
  const float sl2 = scale * 1.44269504f;
  __syncthreads();
  if (lag) __syncthreads();
#pragma unroll
  for (int i = 0; i < KCH; ++i) *(uint4*)(S0 + (krow + i * KRS) * KLD + kcc) = *(const uint4*)(Kg + (long)(krow + i * KRS) * k_stride + kcc);
#pragma unroll
  for (int i = 0; i < VCH; ++i) *(uint4*)(S0 + KT * KLD + (vrow + i * VRS) * VLD + vcc) = *(const uint4*)(Vtg + (long)(vrow + i * VRS) * vt_stride + vcc);
  __syncthreads();
  for (int kt = 0; kt < nkt; ++kt) {
    const u16* Ks = S0 + (DB ? (kt & 1) * BUFE : 0);
    const u16* Vs = Ks + KT * KLD;
    const int ktn = min(kt + 1, nkt - 1);
    {
      const u16* kp_ = Kg + (long)(ktn * KT + krow) * k_stride + kcc;
      kr0 = *(const uint4*)(kp_); kr1 = *(const uint4*)(kp_ + (long)KRS * k_stride);
      kr2 = *(const uint4*)(kp_ + (long)(2 * KRS) * k_stride); kr3 = *(const uint4*)(kp_ + (long)(3 * KRS) * k_stride);
      const u16* vp_ = Vtg + (long)vrow * vt_stride + ktn * KT + vcc;
      vr0 = *(const uint4*)(vp_); vr1 = *(const uint4*)(vp_ + (long)VRS * vt_stride);
      vr2 = *(const uint4*)(vp_ + (long)(2 * VRS) * vt_stride); vr3 = *(const uint4*)(vp_ + (long)(3 * VRS) * vt_stride);
    }
    f32x4 s[NMAP][KT / 16];
#pragma unroll
    for (int m = 0; m < NMAP; ++m)
#pragma unroll
      for (int c = 0; c < KT / 16; ++c) {
        s[m][c] = (f32x4){0.f, 0.f, 0.f, 0.f};
#pragma unroll
        for (int ks = 0; ks < DQK / 32; ++ks) {
          const bf16x8 kf = *(const bf16x8*)(Ks + (c * 16 + fr) * KLD + m * DQK + ks * 32 + fq * 8);
          s[m][c] = mfma16(kf, qf[m][ks], s[m][c]);
        }
      }
    bf16x8 pb[NMAP][KT / 32];
#pragma unroll
    for (int m = 0; m < NMAP; ++m) {
      float lmx = -1e30f;
#pragma unroll
      for (int c = 0; c < KT / 16; ++c)
#pragma unroll
        for (int j = 0; j < 4; ++j) lmx = fmaxf(lmx, s[m][c][j]);
      lmx *= sl2;
      if (__builtin_amdgcn_readfirstlane(__any(lmx > mrun[m] + 16.f))) {
        float mx = fmaxf(lmx, __shfl_xor(lmx, 16));
        mx = fmaxf(mx, __shfl_xor(mx, 32));
        const float mnew = fmaxf(mrun[m], mx);
        const float alpha = __builtin_amdgcn_exp2f(mrun[m] - mnew);
        mrun[m] = mnew;
        lrun[m] *= alpha;
#pragma unroll
        for (int dt = 0; dt < DV / 16; ++dt) o[m][dt] *= alpha;
      }
      float psum = 0.f;
#pragma unroll
      for (int c = 0; c < KT / 16; ++c)
#pragma unroll
        for (int j = 0; j < 4; ++j) { s[m][c][j] = __builtin_amdgcn_exp2f(s[m][c][j] * sl2 - mrun[m]); psum += s[m][c][j]; }
      lrun[m] += psum;
#pragma unroll
      for (int k2 = 0; k2 < KT / 32; ++k2) {
        u32x4 pw;
        pw[0] = cvtpk(s[m][2 * k2][0], s[m][2 * k2][1]); pw[1] = cvtpk(s[m][2 * k2][2], s[m][2 * k2][3]);
        pw[2] = cvtpk(s[m][2 * k2 + 1][0], s[m][2 * k2 + 1][1]); pw[3] = cvtpk(s[m][2 * k2 + 1][2], s[m][2 * k2 + 1][3]);
        pb[m][k2] = __builtin_bit_cast(bf16x8, pw);
      }
    }
    __syncthreads();
    __builtin_amdgcn_s_setprio(1);
#pragma unroll
    for (int k2 = 0; k2 < KT / 32; ++k2)
#pragma unroll
      for (int dt = 0; dt < DV / 16; ++dt) {
        const u16x4 lo = *(const u16x4*)(Vs + (dt * 16 + fr) * VLD + k2 * 32 + fq * 4);
        const u16x4 hi = *(const u16x4*)(Vs + (dt * 16 + fr) * VLD + k2 * 32 + 16 + fq * 4);
        bf16x8 vf;
#pragma unroll
        for (int j = 0; j < 4; ++j) { vf[j] = (short)lo[j]; vf[4 + j] = (short)hi[j]; }
#pragma unroll
        for (int m = 0; m < NMAP; ++m) o[m][dt] = mfma16(vf, pb[m][k2], o[m][dt]);
      }
    __builtin_amdgcn_s_setprio(0);
    {
      u16* Kd = S0 + ((kt + 1) & 1) * BUFE + krow * KLD + kcc;
      *(uint4*)(Kd) = kr0; *(uint4*)(Kd + KRS * KLD) = kr1; *(uint4*)(Kd + 2 * KRS * KLD) = kr2; *(uint4*)(Kd + 3 * KRS * KLD) = kr3;
      u16* Vd = S0 + ((kt + 1) & 1) * BUFE + KT * KLD + vrow * VLD + vcc;
      *(uint4*)(Vd) = vr0; *(uint4*)(Vd + VRS * VLD) = vr1; *(uint4*)(Vd + 2 * VRS * VLD) = vr2; *(uint4*)(Vd + 3 * VRS * VLD) = vr3;
    }
    __syncthreads();
  }
  if (!lag) __syncthreads();
  float linv[NMAP];
#pragma unroll
  for (int m = 0; m < NMAP; ++m) {
    float l = lrun[m];
    l += __shfl_xor(l, 16);
    l += __shfl_xor(l, 32);
    linv[m] = 1.f / l;
  }
  u16* orow = Out + (long)(wid * 16 + fr) * o_stride;
  if (DIFF) {
    float ss = 0.f;
#pragma unroll
    for (int dt = 0; dt < DV / 16; ++dt)
#pragma unroll
      for (int j = 0; j < 4; ++j) {
        const float val = o[0][dt][j] * linv[0] - lam * o[NMAP - 1][dt][j] * linv[NMAP - 1];
        o[0][dt][j] = val;
        ss += val * val;
      }
    ss += __shfl_xor(ss, 16);
    ss += __shfl_xor(ss, 32);
    const float rstd = rsqrtf(ss * (1.f / DV) + 1e-5f) * 0.8f;
#pragma unroll
    for (int dt = 0; dt < DV / 16; ++dt) {
      f32x4 r;
#pragma unroll
      for (int j = 0; j < 4; ++j) r[j] = o[0][dt][j] * rstd * subw[dt * 16 + fq * 4 + j];
      *(u16x4*)(orow + dt * 16 + fq * 4) = pack4(r);
    }
  } else {
#pragma unroll
    for (int dt = 0; dt < DV / 16; ++dt) {
      f32x4 r = o[0][dt] * linv[0];
      *(u16x4*)(orow + dt * 16 + fq * 4) = pack4(r);
    }
  }
}


DI void transpose_v_phase(const Params& p, int bid, int nb, char* smem) {
  u16* t = (u16*)smem;
  const int tid = TIDX;
  for (int tile = bid; tile < 4096; tile += nb) {
    const int b = tile >> 9, st = (tile >> 3) & 63, ct = tile & 7;
    const int r = tid >> 2, seg = (tid & 3) * 16;
    const u16* src = p.vrm + ((long)(b * 4096 + st * 64 + r)) * 512 + ct * 64 + seg;
    const uint4 a0 = *(const uint4*)(src), a1 = *(const uint4*)(src + 8);
    __syncthreads();
    *(uint4*)(t + r * 72 + seg) = a0; *(uint4*)(t + r * 72 + seg + 8) = a1;
    __syncthreads();
    unsigned w[8];
#pragma unroll
    for (int q = 0; q < 8; ++q) w[q] = (unsigned)t[(seg + 2 * q) * 72 + r] | ((unsigned)t[(seg + 2 * q + 1) * 72 + r] << 16);
    u16* dst = p.vt + ((long)(b * 512 + ct * 64 + r)) * 4096 + st * 64 + seg;
    *(uint4*)(dst) = make_uint4(w[0], w[1], w[2], w[3]);
    *(uint4*)(dst + 8) = make_uint4(w[4], w[5], w[6], w[7]);
  }
}


#define GB_CENSUS(x) (64 * (1 + (x)))
#define GB_XARR(x) (64 * (17 + (x)))
#define GB_XGEN(x) (64 * (33 + (x)))
#define GB_TOP (64 * 49)
DI unsigned gb_ld(unsigned* p) { return __hip_atomic_load(p, __ATOMIC_RELAXED, __HIP_MEMORY_SCOPE_AGENT); }
DI unsigned gb_add(unsigned* p) { return __hip_atomic_fetch_add(p, 1u, __ATOMIC_RELAXED, __HIP_MEMORY_SCOPE_AGENT); }
DI void gsync(unsigned* gw, const unsigned* gl, unsigned& epoch) {
  asm volatile("s_waitcnt vmcnt(0) lgkmcnt(0)" ::: "memory");
  __syncthreads();
  epoch += 1;
  if (threadIdx.x == 0) {
    const unsigned gnmine = gl[0], gnx = gl[1], gxid = gl[2];
    __builtin_amdgcn_fence(__ATOMIC_RELEASE, "agent");
    asm volatile("s_waitcnt vmcnt(0)" ::: "memory");
    const unsigned old = gb_add(gw + GB_XARR(gxid));
    if (old + 1 == gnmine * epoch) {
      const unsigned t = gb_add(gw + GB_TOP);
      if (t + 1 == gnx * epoch) {
        const unsigned msk = gl[3];
        for (unsigned x = 0; x < 16; ++x)
          if ((msk >> x) & 1u) __hip_atomic_store(gw + GB_XGEN(x), epoch, __ATOMIC_RELAXED, __HIP_MEMORY_SCOPE_AGENT);
      }
    }
    while (gb_ld(gw + GB_XGEN(gxid)) < epoch) __builtin_amdgcn_s_sleep(1);
    __builtin_amdgcn_fence(__ATOMIC_ACQUIRE, "agent");
    asm volatile("s_waitcnt vmcnt(0)" ::: "memory");
  }
  __syncthreads();
}
DI void gsync_first(unsigned* cnt) {
  asm volatile("s_waitcnt vmcnt(0) lgkmcnt(0)" ::: "memory");
  __syncthreads();
  if (threadIdx.x == 0) {
    __builtin_amdgcn_fence(__ATOMIC_RELEASE, "agent");
    asm volatile("s_waitcnt vmcnt(0)" ::: "memory");
    gb_add(cnt);
    while (gb_ld(cnt) < gridDim.x) __builtin_amdgcn_s_sleep(1);
    __builtin_amdgcn_fence(__ATOMIC_ACQUIRE, "agent");
    asm volatile("s_waitcnt vmcnt(0)" ::: "memory");
  }
  __syncthreads();
}
constexpr int SMEM_HALF = 80 * 1024, SMEM_BYTES = 2 * SMEM_HALF;

template <class Epi>
DI void big_gemm(char* smem, const u16* A, const u16* Bt, int M, int N, int K, const Epi& E) {
  pg8::StaticOrder S;
  S.init(M, N, (int)gridDim.x, (int)blockIdx.x);
  pg8::gemm_phase<Epi, pg8::StaticOrder, false>((PG8_LAS unsigned char*)smem, pg8::Gemm{A, Bt, M, N, K}, S, E, nullptr);
  __syncthreads();
}

__global__ void __launch_bounds__(512, 2) fwd_megakernel(Params p) {
  cg::grid_group grid = cg::this_grid();
  __shared__ __attribute__((aligned(16))) char smem_all[SMEM_BYTES];
  const int half = __builtin_amdgcn_readfirstlane(threadIdx.x >> 8);
  const int bid = blockIdx.x * 2 + half, nb = gridDim.x * 2;
  char* smem = smem_all + half * SMEM_HALF;
  unsigned epoch = 0;

  if (blockIdx.x == 0 && threadIdx.x == 0) *p.counter = 0;
  const unsigned my_xcc = (unsigned)__builtin_amdgcn_s_getreg((3 << 11) | 20) & 0xFu;
  if (threadIdx.x == 0) gb_add(p.gbar + GB_CENSUS(my_xcc));
  for (int i = blockIdx.x * 512 + threadIdx.x; i < 3 * T_TOK; i += gridDim.x * 512) p.ss1[i] = 0.f;
  transpose_w(p.w_in, p.wt_in, 1024, 3328, bid, nb, smem);
  transpose_w(p.w_out, p.wt_out, 1024, 1024, bid, nb, smem);
  transpose_w(p.w_mq, p.wt_mq, 1024, 1024, bid, nb, smem, p.norm_mem_w);
  transpose_w(p.w_mk, p.wt_mk, 1024, 1024, bid, nb, smem);
  transpose_w(p.w_mv, p.wt_mv, 1024, 1024, bid, nb, smem);
  transpose_w(p.w_mo, p.wt_mo, 1024, 1024, bid, nb, smem);
  transpose_w(p.w_up, p.wt_up, 1024, 4096, bid, nb, smem, p.norm_mlp_w);
  transpose_w(p.w_down, p.wt_down, 4096, 1024, bid, nb, smem);
  transpose_w(p.w_dec_up, p.wt_dec, 64, 512, bid, nb, smem);
  transpose_w(p.a_up, p.wt_a, 64, 512, bid, nb, smem);
  transpose_w(p.g_up, p.wt_g, 128, 512, bid, nb, smem);
  rmsnorm_phase<true>(p.x, p.norm_mix_w, p.xn, T_TOK, bid, nb);
  rmsnorm_phase<true>(p.mem, p.norm_src_w, p.memn, 2048, bid, nb);
  if (p.never) grid.sync();
  gsync_first(p.gbar + 64 * 50);
  unsigned* gb_lds = (unsigned*)(smem_all + SMEM_BYTES - 32);
  if (threadIdx.x == 0) {
    unsigned nm = 0, nx = 0, msk = 0;
    for (unsigned x = 0; x < 16; ++x) { const unsigned c = gb_ld(p.gbar + GB_CENSUS(x)); if (c) { ++nx; msk |= 1u << x; } if (x == my_xcc) nm = c; }
    gb_lds[0] = nm; gb_lds[1] = nx; gb_lds[2] = my_xcc; gb_lds[3] = msk;
  }
  __syncthreads();

  big_gemm(smem_all, p.xn, p.wt_in, T_TOK, 3328, 1024, pg8::EpiWinP{p.pr, p.qkd, p.vrm});
  gemm_phase<-1>(p.memn, 1024, p.wt_mk, 1024, 2048, 2048, 1024, EpiKVMem{p.kmem, p.vtmem}, bid >= 256 ? bid - 256 : bid + 256, nb, smem);
  gsync(p.gbar, gb_lds, epoch);

  rwkv_prep_phase(p, bid, nb);
  transpose_v_phase(p, bid, nb, smem);
  gsync(p.gbar, gb_lds, epoch);

  gemm_phase<-1>(p.lora_in, 256, p.wt_dec, 64, T_TOK, 512, 64, EpiDecay{p.e_buf, p.w0}, bid, nb, smem);
  gemm_phase<-1>(p.lora_in + 64, 256, p.wt_a, 64, T_TOK, 512, 64, EpiASig{p.asig, p.a0}, bid, nb, smem);
  gemm_phase<-1>(p.lora_in + 128, 256, p.wt_g, 128, T_TOK, 512, 128, EpiBf16{p.gbuf, 512}, bid, nb, smem);
  gsync(p.gbar, gb_lds, epoch);

  {
    RawIn raw;
    if (bid < 4096) chunk_load_raw(p, bid, TIDX, raw);
    for (int tile = bid; tile < 4096; tile += nb) rwkv_chunk_prep(p, tile, min(tile + nb, 4095), raw, smem);
  }
  gsync(p.gbar, gb_lds, epoch);
  if (bid < 64) rwkv_state_pass(p, bid, smem);
  {
    float d1 = 0.f, d2 = 0.f;
    for (int i = 0; i < 64; ++i) { d1 += p.lam_q1[i] * p.lam_k1[i]; d2 += p.lam_q2[i] * p.lam_k2[i]; }
    const float lam = __expf(d1) - __expf(d2) + 0.2f;
    int* qidx = (int*)(smem_all + SMEM_BYTES - 16);
    for (;;) {
      __syncthreads();
      if (threadIdx.x == 0) *qidx = atomicAdd(p.counter, 1);
      __syncthreads();
      const int idx = *qidx;
      if (idx >= 1024) break;
      const int qc = 63 - (idx >> 4), bh = (idx & 15) * 2 + half, b = bh >> 2, h = bh & 3;
      const long tq = (long)b * 4096 + qc * 64;
      attn_tile<64, 128, 2, true, 64>(p.qkd + tq * 1024 + h * 128, 1024, p.qkd + (long)b * 4096 * 1024 + 512 + h * 128, 1024,
                                  p.vt + (long)(b * 512 + h * 128) * 4096, 4096, qc + 1, 0.125f,
                                  p.mix + tq * 1024 + 512 + h * 128, 1024, lam, p.subln_w, smem, half);
    }
  }
  gsync(p.gbar, gb_lds, epoch);

  big_gemm(smem_all, p.mix, p.wt_out, T_TOK, 1024, 1024, pg8::EpiResNormP<false, false, true>{p.out, p.x, p.xn, p.ss1});
  gsync(p.gbar, gb_lds, epoch);
  big_gemm(smem_all, p.xn, p.wt_mq, T_TOK, 1024, 1024, pg8::EpiBf16NormP<0>{p.qmem, 1024, p.ss1});
  gsync(p.gbar, gb_lds, epoch);
  for (int idx = bid; idx < 2048; idx += nb) {
    const int tt = idx >> 2, h = idx & 3;
    const long t0 = (long)tt * 64;
    const int b = (int)(t0 >> 12);
    attn_tile<256, 256, 1, false, 32>(p.qmem + t0 * 1024 + h * 256, 1024, p.kmem + (long)b * 256 * 1024 + h * 256, 1024,
                                  p.vtmem + (long)(b * 1024 + h * 256) * 256, 256, 8, 0.0625f,
                                  p.mix + t0 * 1024 + h * 256, 1024, 0.f, p.subln_w, smem, half);
  }
  gsync(p.gbar, gb_lds, epoch);
  big_gemm(smem_all, p.mix, p.wt_mo, T_TOK, 1024, 1024, pg8::EpiResNormP<true, false, true>{p.out, p.xn, p.xn, p.ss2});
  gsync(p.gbar, gb_lds, epoch);
  big_gemm(smem_all, p.xn, p.wt_up, T_TOK, 4096, 1024, pg8::EpiBf16NormP<1>{p.hid, 4096, p.ss2});
  gsync(p.gbar, gb_lds, epoch);
  big_gemm(smem_all, p.hid, p.wt_down, T_TOK, 1024, 4096, pg8::EpiResNormP<true, false, true>{p.out, p.xn, p.xn, p.ss3});
  gsync(p.gbar, gb_lds, epoch);
  {
    const long total = (long)T_TOK * 128;
    for (long idx = (long)blockIdx.x * 512 + threadIdx.x; idx < total; idx += (long)gridDim.x * 512) {
      const int row = (int)(idx >> 7), c = (int)(idx & 127) * 8;
      float v[8];
      unpack8(*(const uint4*)(p.xn + (long)row * 1024 + c), v);
      const float rs = rsqrtf(p.ss3[row] * (1.f / 1024.f) + 1e-5f);
      const float4 w0 = *(const float4*)(p.norm_final_w + c), w1 = *(const float4*)(p.norm_final_w + c + 4);
      float* o = p.out + (long)row * 1024 + c;
      *(float4*)(o) = make_float4(v[0] * rs * w0.x, v[1] * rs * w0.y, v[2] * rs * w0.z, v[3] * rs * w0.w);
      *(float4*)(o + 4) = make_float4(v[4] * rs * w1.x, v[5] * rs * w1.y, v[6] * rs * w1.z, v[7] * rs * w1.w);
    }
  }
}

extern "C" void kernel_launch(void* const* d_in, const int* in_sizes, int n_in, void* d_out, int out_size, void* d_ws,
                              size_t ws_size, hipStream_t stream) {
  static int grid_blocks = 0;
  if (!grid_blocks) {
    int dev = 0, cus = 0, per_cu = 0;
    hipGetDevice(&dev);
    hipDeviceGetAttribute(&cus, hipDeviceAttributeMultiprocessorCount, dev);
    hipOccupancyMaxActiveBlocksPerMultiprocessor(&per_cu, fwd_megakernel, 512, 0);
    if (per_cu > 1) per_cu = 1;
    if (per_cu < 1) per_cu = 1;
    grid_blocks = cus * per_cu;
  }
  Params p{};
  const float* const* in = (const float* const*)d_in;
  p.x = in[0]; p.mem = in[1]; p.norm_mix_w = in[2]; p.w_in = in[3]; p.mu = in[4]; p.w0 = in[5]; p.w_dec_up = in[6];
  p.a0 = in[7]; p.a_up = in[8]; p.g_up = in[9]; p.k_k = in[10]; p.k_a = in[11]; p.r_k = in[12]; p.lnx_w = in[13];
  p.lnx_b = in[14]; p.lam_q1 = in[15]; p.lam_k1 = in[16]; p.lam_q2 = in[17]; p.lam_k2 = in[18]; p.subln_w = in[19];
  p.w_out = in[20]; p.norm_mem_w = in[21]; p.norm_src_w = in[22]; p.w_mq = in[23]; p.w_mk = in[24]; p.w_mv = in[25];
  p.w_mo = in[26]; p.norm_mlp_w = in[27]; p.w_up = in[28]; p.w_down = in[29]; p.norm_final_w = in[30];
  p.out = (float*)d_out;
  char* ws = (char*)d_ws;
  u16* wbase = (u16*)ws;
  long o = 0;
  p.wt_in = wbase + o; o += 3328L * 1024;
  p.wt_out = wbase + o; o += 1024L * 1024;
  p.wt_mq = wbase + o; o += 1024L * 1024;
  p.wt_mk = wbase + o; o += 1024L * 1024;
  p.wt_mv = wbase + o; o += 1024L * 1024;
  p.wt_mo = wbase + o; o += 1024L * 1024;
  p.wt_up = wbase + o; o += 4096L * 1024;
  p.wt_down = wbase + o; o += 4096L * 1024;
  p.wt_dec = wbase + o; o += 512L * 64;
  p.wt_a = wbase + o; o += 512L * 64;
  p.wt_g = wbase + o; o += 512L * 128;
  p.xn = (u16*)(ws + 34 * MiB);
  char* big = ws + 98 * MiB;
  p.pr = (u16*)big;
  p.qkd = (u16*)(big + 112 * MiB);
  p.vt = (u16*)(big + 176 * MiB);
  p.vrm = (u16*)(big + 208 * MiB);
  p.hid = (u16*)big;
  p.mix = (u16*)(ws + 354 * MiB);
  p.qmem = (u16*)(ws + 418 * MiB);
  p.memn = (u16*)(ws + 482 * MiB);
  p.kmem = (u16*)(ws + 486 * MiB);
  p.vtmem = (u16*)(ws + 490 * MiB);
  p.lora_in = (u16*)(ws + 494 * MiB);
  p.e_buf = (float*)d_out;
  p.asig = (u16*)((char*)d_out + 64 * MiB);
  p.gbuf = (u16*)((char*)d_out + 96 * MiB);
  p.c_mp = p.xn; p.c_yh = p.xn + 4096L * 4096;
  p.c_nc = p.qmem; p.c_y0 = p.qmem + 4096L * 4096;
  p.counter = (int*)(ws + 511 * MiB);
  p.gbar = (unsigned*)(ws + 511 * MiB + 512 * 1024);
  hipMemsetAsync(p.gbar, 0, 16384, stream);
  p.ss1 = (float*)(ws + 511 * MiB + 65536); p.ss2 = p.ss1 + T_TOK; p.ss3 = p.ss2 + T_TOK;
  p.c_gc = (float*)p.lora_in;
  void* args[] = {&p};
  hipError_t e = hipLaunchCooperativeKernel((void*)fwd_megakernel, dim3(grid_blocks), dim3(512), args, 0, stream);
  if (e != hipSuccess) fprintf(stderr, "cooperative launch failed: %s (grid %d)\n", hipGetErrorString(e), grid_blocks);
}
```

```cpp
#include <hip/hip_runtime.h>
#include <hip/hip_cooperative_groups.h>
#include <cstdio>
namespace cg = cooperative_groups;

#define DI __device__ __forceinline__
typedef unsigned short u16;
using bf16x8 = __attribute__((ext_vector_type(8))) short;
using f32x4 = __attribute__((ext_vector_type(4))) float;
using u16x4 = __attribute__((ext_vector_type(4))) unsigned short;
using u32x4 = __attribute__((ext_vector_type(4))) unsigned;

constexpr int T_TOK = 32768, SEQ = 4096, DM = 1024;
constexpr long MiB = 1024L * 1024L;

typedef float f32x2_t __attribute__((ext_vector_type(2)));
typedef __bf16 bf16x2_t __attribute__((ext_vector_type(2)));
DI unsigned cvtpk(float lo, float hi) { const f32x2_t v = {lo, hi}; return __builtin_bit_cast(unsigned, __builtin_convertvector(v, bf16x2_t)); }
using u32x2 = __attribute__((ext_vector_type(2))) unsigned;
DI u16 f2bf(float x) { return (u16)(cvtpk(x, x) & 0xffffu); }
DI float bf2f(u16 h) { return __uint_as_float(((unsigned)h) << 16); }
DI float wave_sum(float v) {
#pragma unroll
  for (int o = 32; o > 0; o >>= 1) v += __shfl_xor(v, o);
  return v;
}
DI f32x4 mfma16(bf16x8 a, bf16x8 b, f32x4 c) { return __builtin_amdgcn_mfma_f32_16x16x32_bf16(a, b, c, 0, 0, 0); }
DI u16x4 pack4(f32x4 v) { u32x2 w; w[0] = cvtpk(v[0], v[1]); w[1] = cvtpk(v[2], v[3]); return __builtin_bit_cast(u16x4, w); }
DI void unpack8(uint4 w, float* o) {
  o[0] = __uint_as_float(w.x << 16); o[1] = __uint_as_float(w.x & 0xffff0000u);
  o[2] = __uint_as_float(w.y << 16); o[3] = __uint_as_float(w.y & 0xffff0000u);
  o[4] = __uint_as_float(w.z << 16); o[5] = __uint_as_float(w.z & 0xffff0000u);
  o[6] = __uint_as_float(w.w << 16); o[7] = __uint_as_float(w.w & 0xffff0000u);
}
DI unsigned pk2(float a, float b) { return cvtpk(a, b); }

struct Params {
  const float *x, *mem, *norm_mix_w, *w_in, *mu, *w0, *w_dec_up, *a0, *a_up, *g_up, *k_k, *k_a, *r_k, *lnx_w, *lnx_b;
  const float *lam_q1, *lam_k1, *lam_q2, *lam_k2, *subln_w, *w_out, *norm_mem_w, *norm_src_w, *w_mq, *w_mk, *w_mv, *w_mo;
  const float *norm_mlp_w, *w_up, *w_down, *norm_final_w;
  float* out;
  u16 *wt_in, *wt_out, *wt_mq, *wt_mk, *wt_mv, *wt_mo, *wt_up, *wt_down, *wt_dec, *wt_a, *wt_g;
  u16 *xn, *pr, *qkd, *vt, *hid, *mix, *qmem, *memn, *kmem, *vtmem, *lora_in;
  float* e_buf; u16 *asig, *gbuf;
  u16 *c_mp, *c_yh, *c_nc, *c_y0; float* c_gc;
  int* counter; u16* vrm; float *ss1, *ss2, *ss3; unsigned* gbar;
  long never;
};

__device__ __forceinline__ int tidx_fresh() { int t = (int)(threadIdx.x & 255u); asm volatile("" : "+v"(t)); return t; }
#define TIDX tidx_fresh()

namespace pg8 {
#define PG8_LAS __attribute__((address_space(3)))
typedef unsigned short bf16_t;
typedef short bf16x8 __attribute__((ext_vector_type(8)));
typedef float f32x4 __attribute__((ext_vector_type(4)));
typedef unsigned u32x4 __attribute__((ext_vector_type(4)));
constexpr int BM = 256, BK = 64, HALF = 128, HTB = HALF * BK * 2  , STAGE_BYTES = 8 * HTB, NXCD = 8, WGM = 8;

__host__ __device__ __forceinline__ int lds_byte(int r, int c) { const int st = (r >> 4) * 2 + (c >> 5), rr = r & 15, cc = c & 31, ob = rr * 64 + cc * 2; return st * 1024 + (ob ^ (((ob >> 9) & 1) << 5)); }
__host__ __device__ __forceinline__ void stage_rc(int b, int& R, int& C) { const int st = b / 1024, sb = b % 1024, swz = sb ^ (((sb >> 9) & 1) << 5); R = (st >> 1) * 16 + swz / 64; C = (st & 1) * 32 + (swz % 64) / 2; }
__host__ __device__ __forceinline__ int perm32(int rho) { const int n = rho >> 4, i = rho & 15; return 8 * (i >> 2) + 4 * n + (i & 3); }

struct Unit { int pm, pn; };
struct Gemm { const bf16_t* A; const bf16_t* Bt; int M, N, K; };

struct StaticOrder {
    int nM, nN, nwg, G, c;
    __host__ __device__ void init(int M, int N, int G_, int c_) { nM = M / BM; nN = N / BM; nwg = nM * nN; G = G_; c = c_; }
    __host__ __device__ bool next(int i, Unit& u) const {
        const long L = (long)i * G + c; if (L >= nwg) return false;
        int wgid = (int)L; { const int q = nwg / NXCD, r = nwg % NXCD, xcd = wgid % NXCD, off = wgid / NXCD; wgid = (xcd < r ? xcd * (q + 1) : r * (q + 1) + (xcd - r) * q) + off; }
        const int nig = WGM * nN, gid = wgid / nig, fm = gid * WGM, gsz = (nM - fm) < WGM ? (nM - fm) : WGM;
        u.pm = fm + ((wgid % nig) % gsz); u.pn = (wgid % nig) / gsz; return true;
    }
    __device__ __forceinline__ void a_ready(const Unit&) const {}
    __device__ __forceinline__ void done(const Unit&) const {}
};
__device__ __forceinline__ unsigned cvt_pk_bf16(float lo, float hi) { unsigned r; asm volatile("v_cvt_pk_bf16_f32 %0, %1, %2" : "=v"(r) : "v"(lo), "v"(hi)); return r; }
template <class Epi, class Sched, bool STAMP = false>
__device__ __forceinline__ void gemm_phase(PG8_LAS unsigned char* lds, const Gemm g, const Sched& S, const Epi& E, unsigned long long* stamps) {
    const int tid = threadIdx.x, wid = __builtin_amdgcn_readfirstlane(tid >> 6), lane = tid & 63, wr = wid >> 2, wc = wid & 3, fr = lane & 15, fq = lane >> 4;
    const int K = g.K, nt = K / BK;
    int ts_lo = 0, ts_hi = 0, nts = 0; const unsigned long long rt_entry = STAMP ? (unsigned long long)wall_clock64() : 0ull;
#define PG8_STAMP() do { if (STAMP && wid == 0 && nts < 64) { const unsigned long long _c = (unsigned long long)clock64(); \
        ts_lo = (lane == nts) ? (int)(unsigned)_c : ts_lo; ts_hi = (lane == nts) ? (int)(unsigned)(_c >> 32) : ts_hi; ++nts; } } while (0)
    PG8_STAMP();
    unsigned voffA[2], voffB[2];
#pragma unroll
    for (int i = 0; i < 2; ++i) { int R, C; stage_rc(tid * 16 + i * 8192, R, C); const int Rb = Epi::PERM ? ((R & ~31) + perm32(R & 31)) : R;
        voffA[i] = (unsigned)(R * K + C) * 2u; voffB[i] = (unsigned)(Rb * K + C) * 2u; }
    const size_t kstep = (size_t)(BK * 2);
    const size_t hstep = (size_t)HALF * K * 2;
    const size_t tstep = 2 * hstep;
    const unsigned ldsw = (unsigned)wid * 1024u;
    const int aoff = lds_byte(wr * 64 + fr, fq * 8), boff = lds_byte(wc * 32 + fr, fq * 8);
#define PG8_SA(b, h) (((b) * 2 + (h)) * HTB)
#define PG8_SB(b, h) ((4 + (b) * 2 + (h)) * HTB)
#define PG8_STAGE(bufoff, gbase, voff) do { _Pragma("unroll") for (int _i = 0; _i < 2; ++_i) \
        __builtin_amdgcn_global_load_lds((const unsigned*)((const char*)(gbase) + (voff)[_i]), (PG8_LAS unsigned*)(lds + (bufoff) + ldsw + _i * 8192), 16, 0, 0); } while (0)
#define PG8_LDA(dst, b, h) do { _Pragma("unroll") for (int m = 0; m < 4; ++m) _Pragma("unroll") for (int k = 0; k < 2; ++k) dst[m][k] = *(const PG8_LAS bf16x8*)(lds + PG8_SA(b, h) + aoff + m * 2048 + k * 1024); } while (0)
#define PG8_LDB(dst, b, h) do { _Pragma("unroll") for (int n = 0; n < 2; ++n) _Pragma("unroll") for (int k = 0; k < 2; ++k) dst[n][k] = *(const PG8_LAS bf16x8*)(lds + PG8_SB(b, h) + boff + n * 2048 + k * 1024); } while (0)
#define PG8_MMA(ai, bj, At, Bt) do { __builtin_amdgcn_s_setprio(1); _Pragma("unroll") for (int m = 0; m < 4; ++m) _Pragma("unroll") for (int n = 0; n < 2; ++n) _Pragma("unroll") for (int k = 0; k < 2; ++k) \
        acc[ai][bj][m][n] = __builtin_amdgcn_mfma_f32_16x16x32_bf16(Bt[n][k], At[m][k], acc[ai][bj][m][n], 0, 0, 0); __builtin_amdgcn_s_setprio(0); } while (0)
#define PG8_WAIT_V(n) asm volatile("s_waitcnt vmcnt(" #n ")" ::: "memory")
#define PG8_WAIT_L(n) asm volatile("s_waitcnt lgkmcnt(" #n ")" ::: "memory")
#define PG8_BAR __builtin_amdgcn_s_barrier()
#define PG8_SCHED __builtin_amdgcn_sched_barrier(0)
    Unit cur, nxt; int ui = 0;
    if (!S.next(0, cur)) return;
    f32x4 acc[2][2][4][2];
#pragma unroll
    for (int a = 0; a < 2; ++a)
#pragma unroll
        for (int b = 0; b < 2; ++b)
#pragma unroll
            for (int m = 0; m < 4; ++m)
#pragma unroll
                for (int n = 0; n < 2; ++n) acc[a][b][m][n] = (f32x4){0.f, 0.f, 0.f, 0.f};
    bf16x8 At[4][2], B0[2][2], B1[2][2];
    const char* cA = (const char*)g.A + (size_t)cur.pm * tstep; const char* cB = (const char*)g.Bt + (size_t)cur.pn * tstep;
    S.a_ready(cur);
    PG8_STAGE(PG8_SB(0, 0), cB, voffB); PG8_STAGE(PG8_SA(0, 0), cA, voffA); PG8_STAGE(PG8_SB(0, 1), cB + hstep, voffB); PG8_STAGE(PG8_SA(0, 1), cA + hstep, voffA);
    if (wr == 1) PG8_BAR;
    PG8_WAIT_V(4); PG8_BAR;
    PG8_STAGE(PG8_SB(1, 0), cB + kstep, voffB); PG8_STAGE(PG8_SA(1, 0), cA + kstep, voffA); PG8_STAGE(PG8_SB(1, 1), cB + hstep + kstep, voffB);
    PG8_WAIT_V(6); PG8_BAR;
    PG8_STAMP();
    for (;;) {
        const bool has_next = S.next(ui + 1, nxt);
        const char* nA = has_next ? (const char*)g.A + (size_t)nxt.pm * tstep : cA; const char* nB = has_next ? (const char*)g.Bt + (size_t)nxt.pn * tstep : cB;
        for (int t = 0; t < nt; t += 2) {
            const bool last = (t == nt - 2);
            const char* a1 = cA + (size_t)(t + 1) * kstep;
            const char* a2 = last ? nA : cA + (size_t)(t + 2) * kstep; const char* b2 = last ? nB : cB + (size_t)(t + 2) * kstep;
            const char* a3 = a2 + kstep; const char* b3 = b2 + kstep;
            if (last && has_next) S.a_ready(nxt);
            PG8_LDB(B0, 0, 0); PG8_SCHED; PG8_LDA(At, 0, 0); PG8_STAGE(PG8_SA(1, 1), a1 + hstep, voffA);
            PG8_WAIT_L(8); PG8_BAR; PG8_WAIT_L(0); PG8_MMA(0, 0, At, B0); PG8_BAR; PG8_SCHED;
            PG8_LDB(B1, 0, 1); PG8_STAGE(PG8_SB(0, 0), b2, voffB);
            PG8_BAR; PG8_WAIT_L(0); PG8_MMA(0, 1, At, B1); PG8_BAR;
            PG8_LDA(At, 0, 1); PG8_STAGE(PG8_SA(0, 0), a2, voffA);
            PG8_BAR; PG8_WAIT_L(0); PG8_MMA(1, 0, At, B0); PG8_BAR; PG8_SCHED;
            PG8_STAGE(PG8_SB(0, 1), b2 + hstep, voffB);
            PG8_WAIT_V(6); PG8_BAR; PG8_MMA(1, 1, At, B1); PG8_BAR;
            PG8_LDB(B0, 1, 0); PG8_SCHED; PG8_LDA(At, 1, 0); PG8_STAGE(PG8_SA(0, 1), a2 + hstep, voffA);
            PG8_WAIT_L(8); PG8_BAR; PG8_WAIT_L(0); PG8_MMA(0, 0, At, B0); PG8_BAR; PG8_SCHED;
            PG8_LDB(B1, 1, 1); PG8_STAGE(PG8_SB(1, 0), b3, voffB);
            PG8_BAR; PG8_WAIT_L(0); PG8_MMA(0, 1, At, B1); PG8_BAR;
            PG8_LDA(At, 1, 1); PG8_STAGE(PG8_SA(1, 0), a3, voffA);
            PG8_BAR; PG8_WAIT_L(0); PG8_MMA(1, 0, At, B0); PG8_BAR; PG8_SCHED;
            PG8_STAGE(PG8_SB(1, 1), b3 + hstep, voffB);
            PG8_WAIT_V(6); PG8_BAR; PG8_MMA(1, 1, At, B1); PG8_BAR;
        }
        PG8_STAMP();
        if constexpr (!Epi::AFTER_DRAIN) { E(acc, cur, wr, wc, fr, fq); S.done(cur); }
        PG8_STAMP();
        if (!has_next) break;
#pragma unroll
        for (int a = 0; a < 2; ++a)
#pragma unroll
            for (int b = 0; b < 2; ++b)
#pragma unroll
                for (int m = 0; m < 4; ++m)
#pragma unroll
                    for (int n = 0; n < 2; ++n) acc[a][b][m][n] = (f32x4){0.f, 0.f, 0.f, 0.f};
        cur = nxt; cA = nA; cB = nB; ++ui;
    }
    PG8_WAIT_V(0);
    if (wr == 0) PG8_BAR;
    PG8_BAR;
    if constexpr (Epi::AFTER_DRAIN) { E.fused(acc, cur, wr, wc, fr, fq, lds, wid, lane); S.done(cur); }
    PG8_STAMP();
    if (STAMP && wid == 0) { stamps[lane] = lane < nts ? (((unsigned long long)(unsigned)ts_hi << 32) | (unsigned)ts_lo) : 0ull;
        if (lane == 62) stamps[62] = rt_entry; if (lane == 63) stamps[63] = (unsigned long long)wall_clock64(); }
#undef PG8_STAMP
#undef PG8_SA
#undef PG8_SB
#undef PG8_STAGE
#undef PG8_LDA
#undef PG8_LDB
#undef PG8_MMA
#undef PG8_WAIT_V
#undef PG8_WAIT_L
#undef PG8_BAR
#undef PG8_SCHED
}

struct EpiWinP {
    static constexpr bool PERM = true, AFTER_DRAIN = false;
    bf16_t *pr, *qkd, *vrm;
    __device__ __forceinline__ void operator()(const f32x4 (&acc)[2][2][4][2], const Unit& u, int wr, int wc, int fr, int fq) const {
        const int row0 = u.pm * BM + wr * 64 + fr;
        bf16_t* base; int ldc, colt;
        if (u.pn < 7) { base = pr; ldc = 1792; colt = u.pn * 256; }
        else if (u.pn < 11) { base = qkd; ldc = 1024; colt = (u.pn - 7) * 256; }
        else { base = vrm; ldc = 512; colt = (u.pn - 11) * 256; }
        const int col0 = colt + wc * 32 + 8 * fq;
#pragma unroll
        for (int ai = 0; ai < 2; ++ai)
#pragma unroll
            for (int m = 0; m < 4; ++m) { bf16_t* rowp = base + (size_t)(row0 + ai * HALF + m * 16) * ldc + col0;
#pragma unroll
                for (int bj = 0; bj < 2; ++bj) { const f32x4 v0 = acc[ai][bj][m][0], v1 = acc[ai][bj][m][1];
                    u32x4 w; w.x = cvt_pk_bf16(v0[0], v0[1]); w.y = cvt_pk_bf16(v0[2], v0[3]); w.z = cvt_pk_bf16(v1[0], v1[1]); w.w = cvt_pk_bf16(v1[2], v1[3]);
                    *(u32x4*)(rowp + bj * HALF) = w; } }
    }
};
template <int ACT  > struct EpiBf16P {
    static constexpr bool PERM = true, AFTER_DRAIN = false;
    bf16_t* O; int ldc;
    __device__ __forceinline__ void operator()(const f32x4 (&acc)[2][2][4][2], const Unit& u, int wr, int wc, int fr, int fq) const {
        const int row0 = u.pm * BM + wr * 64 + fr, col0 = u.pn * BM + wc * 32 + 8 * fq;
#pragma unroll
        for (int ai = 0; ai < 2; ++ai)
#pragma unroll
            for (int m = 0; m < 4; ++m) { bf16_t* rowp = O + (size_t)(row0 + ai * HALF + m * 16) * ldc + col0;
#pragma unroll
                for (int bj = 0; bj < 2; ++bj) { f32x4 v0 = acc[ai][bj][m][0], v1 = acc[ai][bj][m][1];
                    if (ACT == 1) {
#pragma unroll
                        for (int j = 0; j < 4; ++j) { const float a = fmaxf(v0[j], 0.f), b = fmaxf(v1[j], 0.f); v0[j] = a * a; v1[j] = b * b; } }
                    u32x4 w; w.x = cvt_pk_bf16(v0[0], v0[1]); w.y = cvt_pk_bf16(v0[2], v0[3]); w.z = cvt_pk_bf16(v1[0], v1[1]); w.w = cvt_pk_bf16(v1[2], v1[3]);
                    *(u32x4*)(rowp + bj * HALF) = w; } }
    }
};
struct EpiResP {
    static constexpr bool PERM = false, AFTER_DRAIN = false;
    float* H; const float* R;
    __device__ __forceinline__ void operator()(const f32x4 (&acc)[2][2][4][2], const Unit& u, int wr, int wc, int fr, int fq) const {
        const int row0 = u.pm * BM + wr * 64 + fr, col0 = u.pn * BM + wc * 32 + 4 * fq;
#pragma unroll
        for (int ai = 0; ai < 2; ++ai)
#pragma unroll
            for (int m = 0; m < 4; ++m) { const size_t ro = (size_t)(row0 + ai * HALF + m * 16) * 1024 + col0;
#pragma unroll
                for (int bj = 0; bj < 2; ++bj)
#pragma unroll
                    for (int n = 0; n < 2; ++n) { const f32x4 rv = *(const f32x4*)(R + ro + bj * HALF + n * 16);
                        *(f32x4*)(H + ro + bj * HALF + n * 16) = rv + acc[ai][bj][m][n]; } }
    }
};

template <bool RBF, bool WF32, bool WBF> struct EpiResNormP {
    static constexpr bool PERM = false, AFTER_DRAIN = false;
    float* H; const void* R; bf16_t* XB; float* SS;
    __device__ __forceinline__ void operator()(const f32x4 (&acc)[2][2][4][2], const Unit& u, int wr, int wc, int fr, int fq) const {
        const int row0 = u.pm * BM + wr * 64 + fr, col0 = u.pn * BM + wc * 32 + 4 * fq;
#pragma unroll
        for (int ai = 0; ai < 2; ++ai)
#pragma unroll
            for (int m = 0; m < 4; ++m) { const int row = row0 + ai * HALF + m * 16; const size_t ro = (size_t)row * 1024 + col0;
                float ss = 0.f;
#pragma unroll
                for (int bj = 0; bj < 2; ++bj)
#pragma unroll
                    for (int n = 0; n < 2; ++n) { const size_t o = ro + bj * HALF + n * 16;
                        f32x4 rv;
                        if (RBF) { const uint2 rb = *(const uint2*)((const bf16_t*)R + o);
                            rv[0] = __uint_as_float(rb.x << 16); rv[1] = __uint_as_float(rb.x & 0xffff0000u); rv[2] = __uint_as_float(rb.y << 16); rv[3] = __uint_as_float(rb.y & 0xffff0000u); }
                        else rv = *(const f32x4*)((const float*)R + o);
                        const f32x4 hv = rv + acc[ai][bj][m][n];
                        if (WF32) *(f32x4*)(H + o) = hv;
                        if (WBF) { uint2 w; w.x = cvt_pk_bf16(hv[0], hv[1]); w.y = cvt_pk_bf16(hv[2], hv[3]);
                            *(uint2*)(XB + o) = w;
                            ss += hv[0] * hv[0] + hv[1] * hv[1] + hv[2] * hv[2] + hv[3] * hv[3]; } }
                if (WBF) { ss += __shfl_xor(ss, 16); ss += __shfl_xor(ss, 32);
                    if (fq == 0) atomicAdd(SS + row, ss); } }
    }
};
template <int ACT  > struct EpiBf16NormP {
    static constexpr bool PERM = true, AFTER_DRAIN = false;
    bf16_t* O; int ldc; const float* SS;
    __device__ __forceinline__ void operator()(const f32x4 (&acc)[2][2][4][2], const Unit& u, int wr, int wc, int fr, int fq) const {
        const int row0 = u.pm * BM + wr * 64 + fr, col0 = u.pn * BM + wc * 32 + 8 * fq;
#pragma unroll
        for (int ai = 0; ai < 2; ++ai)
#pragma unroll
            for (int m = 0; m < 4; ++m) { const int row = row0 + ai * HALF + m * 16; bf16_t* rowp = O + (size_t)row * ldc + col0;
                const float rs = rsqrtf(SS[row] * (1.f / 1024.f) + 1e-5f);
#pragma unroll
                for (int bj = 0; bj < 2; ++bj) { f32x4 v0 = acc[ai][bj][m][0] * rs, v1 = acc[ai][bj][m][1] * rs;
                    if (ACT == 1) {
#pragma unroll
                        for (int j = 0; j < 4; ++j) { const float a = fmaxf(v0[j], 0.f), b = fmaxf(v1[j], 0.f); v0[j] = a * a; v1[j] = b * b; } }
                    u32x4 w; w.x = cvt_pk_bf16(v0[0], v0[1]); w.y = cvt_pk_bf16(v0[2], v0[3]); w.z = cvt_pk_bf16(v1[0], v1[1]); w.w = cvt_pk_bf16(v1[2], v1[3]);
                    *(u32x4*)(rowp + bj * HALF) = w; } }
    }
};
}


DI void transpose_w(const float* __restrict__ W, u16* __restrict__ Wt, int K, int N, int bid, int nb, char* smem,
                    const float* __restrict__ kscale = nullptr) {
  float(*tile)[65] = (float(*)[65])smem;
  const int tid = TIDX;
  const int tn = N / 64, nt = (K / 64) * tn;
  for (int t = bid; t < nt; t += nb) {
    const int k0 = (t / tn) * 64, n0 = (t % tn) * 64;
#pragma unroll
    for (int i = 0; i < 4; ++i) {
      const int r = (tid >> 4) + i * 16, c = (tid & 15) * 4;
      const float4 v = *(const float4*)(W + (long)(k0 + r) * N + n0 + c);
      const float sc = kscale ? kscale[k0 + r] : 1.f;
      tile[r][c] = v.x * sc; tile[r][c + 1] = v.y * sc; tile[r][c + 2] = v.z * sc; tile[r][c + 3] = v.w * sc;
    }
    __syncthreads();
#pragma unroll
    for (int i = 0; i < 2; ++i) {
      const int c = tid + i * 256, n = c >> 3, kk = (c & 7) * 8;
      uint4 o;
      o.x = f2bf(tile[kk][n]) | ((unsigned)f2bf(tile[kk + 1][n]) << 16);
      o.y = f2bf(tile[kk + 2][n]) | ((unsigned)f2bf(tile[kk + 3][n]) << 16);
      o.z = f2bf(tile[kk + 4][n]) | ((unsigned)f2bf(tile[kk + 5][n]) << 16);
      o.w = f2bf(tile[kk + 6][n]) | ((unsigned)f2bf(tile[kk + 7][n]) << 16);
      *(uint4*)(Wt + (long)(n0 + n) * K + k0 + kk) = o;
    }
    __syncthreads();
  }
}

template <bool BF>
DI void rmsnorm_phase(const float* in, const float* __restrict__ w, void* outp, int rows, int bid, int nb) {
  constexpr int RPW = 2;
  const int tid = TIDX, lane = tid & 63;
  const int wave = bid * 4 + (tid >> 6), nw = nb * 4;
  float4 wv[4];
#pragma unroll
  for (int i = 0; i < 4; ++i) wv[i] = ((const float4*)w)[lane + i * 64];
  float4 v[RPW][4], nv[RPW][4];
  int row0 = wave * RPW;
  if (row0 < rows) {
#pragma unroll
    for (int r = 0; r < RPW; ++r)
#pragma unroll
      for (int i = 0; i < 4; ++i) nv[r][i] = ((const float4*)(in + (long)(row0 + r) * 1024))[lane + i * 64];
  }
  for (; row0 < rows; row0 += nw * RPW) {
#pragma unroll
    for (int r = 0; r < RPW; ++r)
#pragma unroll
      for (int i = 0; i < 4; ++i) v[r][i] = nv[r][i];
    const int rown = min(row0 + nw * RPW, rows - RPW);
#pragma unroll
    for (int r = 0; r < RPW; ++r)
#pragma unroll
      for (int i = 0; i < 4; ++i) nv[r][i] = ((const float4*)(in + (long)(rown + r) * 1024))[lane + i * 64];
#pragma unroll
    for (int r = 0; r < RPW; ++r) {
      float ss = 0.f;
#pragma unroll
      for (int i = 0; i < 4; ++i) ss += v[r][i].x * v[r][i].x + v[r][i].y * v[r][i].y + v[r][i].z * v[r][i].z + v[r][i].w * v[r][i].w;
      ss = wave_sum(ss);
      const float rs = rsqrtf(ss * (1.f / 1024.f) + 1e-5f);
#pragma unroll
      for (int i = 0; i < 4; ++i) {
        f32x4 y;
        y[0] = v[r][i].x * rs * wv[i].x; y[1] = v[r][i].y * rs * wv[i].y; y[2] = v[r][i].z * rs * wv[i].z; y[3] = v[r][i].w * rs * wv[i].w;
        if (BF) {
          *(u16x4*)((u16*)outp + (long)(row0 + r) * 1024 + (lane + i * 64) * 4) = pack4(y);
        } else {
          *(f32x4*)((float*)outp + (long)(row0 + r) * 1024 + (lane + i * 64) * 4) = y;
        }
      }
    }
  }
}

constexpr int GBM = 128, GBN = 128, GBK = 64;
constexpr int GTILE = 128 * 64;
template <int VT_FROM, class Epi>
DI void gemm_phase(const u16* __restrict__ A, int lda, const u16* __restrict__ Bt, int ldb, int M, int N, int K, Epi epi,
                   int bid, int nb, char* smem, u16* vt_out = nullptr) {
  u16* sA = (u16*)smem;
  u16* sB = sA + 2 * GTILE;
  const int tid = TIDX, lane = tid & 63, wid = tid >> 6, wr = wid >> 1, wc = wid & 1;
  const int fr = lane & 15, fq = lane >> 4;
  const int ntm = M / GBM, ntn = N / GBN, nk = K / GBK;
  const int lrow = tid >> 3, lkc = (tid & 7) * 8;
  const int st_off = lrow * 64 + (((tid & 7) ^ ((lrow >> 1) & 7)) << 3);
  const int fa_off = (wr * 64 + fr) * 64, fb_off = (wc * 64 + fr) * 64;
  const int fx0 = ((fq ^ (fr >> 1)) << 3), fx1 = (((4 + fq) ^ (fr >> 1)) << 3);
  const int ntiles = ntm * ntn;
  for (int s = bid; s < ntiles; s += nb) {
    const int tm = s / ntn, tn = s % ntn;
    const u16* Ag = A + (long)(tm * GBM) * lda;
    const u16* Bg = Bt + (long)(tn * GBN) * ldb;
    const unsigned voA = (unsigned)(lrow * lda + lkc), voB = (unsigned)(lrow * ldb + lkc);
    f32x4 acc[4][4];
#pragma unroll
    for (int m = 0; m < 4; ++m)
#pragma unroll
      for (int n = 0; n < 4; ++n) acc[m][n] = (f32x4){0.f, 0.f, 0.f, 0.f};
    uint4 ra0_0, ra0_1, ra0_2, ra0_3, rb0_0, rb0_1, rb0_2, rb0_3, ra1_0, ra1_1, ra1_2, ra1_3, rb1_0, rb1_1, rb1_2, rb1_3;
    bf16x8 af0[4], bf0[4], af1[4], bf1[4];
#define G_LOAD1(RA, RB, KT, I)                                                     \
  RA##_##I = *(const uint4*)((Ag + ((long)(I * 32) * lda + (KT) * GBK)) + voA);    \
  RB##_##I = *(const uint4*)((Bg + ((long)(I * 32) * ldb + (KT) * GBK)) + voB);
#define G_LOAD(RA, RB, KT) G_LOAD1(RA, RB, KT, 0) G_LOAD1(RA, RB, KT, 1) G_LOAD1(RA, RB, KT, 2) G_LOAD1(RA, RB, KT, 3)
#define G_STORE1(RA, RB, BUF, I)                                                   \
  *(uint4*)(sA + (BUF) * GTILE + st_off + I * 2048) = RA##_##I;                    \
  *(uint4*)(sB + (BUF) * GTILE + st_off + I * 2048) = RB##_##I;
#define G_STORE(RA, RB, BUF) G_STORE1(RA, RB, BUF, 0) G_STORE1(RA, RB, BUF, 1) G_STORE1(RA, RB, BUF, 2) G_STORE1(RA, RB, BUF, 3)
#define G_LDF(AF, BF, BUF, FX)                                                     \
  _Pragma("unroll") for (int m = 0; m < 4; ++m) {                                  \
    AF[m] = *(const bf16x8*)(sA + (BUF) * GTILE + fa_off + m * 1024 + FX);         \
    BF[m] = *(const bf16x8*)(sB + (BUF) * GTILE + fb_off + m * 1024 + FX);         \
  }
#define G_MMA(AF, BF)                                                              \
  _Pragma("unroll") for (int m = 0; m < 4; ++m)                                    \
    _Pragma("unroll") for (int n = 0; n < 4; ++n) acc[m][n] = mfma16(BF[n], AF[m], acc[m][n]);
    if (nk & 1) {
      G_LOAD(ra0, rb0, 0);
      G_STORE(ra0, rb0, 0);
      __syncthreads();
      for (int kt = 0; kt < nk; ++kt) {
        const int cur = kt & 1;
        if (kt + 1 < nk) { G_LOAD(ra0, rb0, kt + 1); }
        G_LDF(af0, bf0, cur, fx0);
        G_LDF(af1, bf1, cur, fx1);
        G_MMA(af0, bf0);
        G_MMA(af1, bf1);
        if (kt + 1 < nk) { G_STORE(ra0, rb0, cur ^ 1); }
        __syncthreads();
      }
    } else {
      G_LOAD(ra0, rb0, 0);
      G_LOAD(ra1, rb1, 1);
      G_STORE(ra0, rb0, 0);
      __syncthreads();
      G_LDF(af0, bf0, 0, fx0);
      for (int kt = 0; kt < nk; kt += 2) {
        const int k2 = min(kt + 2, nk - 1), k3 = min(kt + 3, nk - 1);
        G_LOAD(ra0, rb0, k2);
        G_LDF(af1, bf1, 0, fx1);
        G_MMA(af0, bf0);
        G_STORE(ra1, rb1, 1);
        __syncthreads();
        G_LDF(af0, bf0, 1, fx0);
        G_MMA(af1, bf1);
        G_LOAD(ra1, rb1, k3);
        G_LDF(af1, bf1, 1, fx1);
        G_MMA(af0, bf0);
        G_STORE(ra0, rb0, 0);
        __syncthreads();
        G_LDF(af0, bf0, 0, fx0);
        G_MMA(af1, bf1);
      }
    }
#undef G_LOAD
#undef G_STORE
#undef G_LOAD1
#undef G_STORE1
#undef G_LDF
#undef G_MMA
    if (VT_FROM >= 0 && tn >= VT_FROM) {
      constexpr int TLD = 136;
      u16* Tt = (u16*)smem;
      __syncthreads();
#pragma unroll
      for (int m = 0; m < 4; ++m)
#pragma unroll
        for (int n = 0; n < 4; ++n)
#pragma unroll
          for (int j = 0; j < 4; ++j)
            Tt[(wc * 64 + n * 16 + fq * 4 + j) * TLD + wr * 64 + m * 16 + fr] = f2bf(acc[m][n][j]);
      __syncthreads();
      const int colL = tid >> 1, half = tid & 1;
      const int row0 = tm * GBM, b = row0 >> 12, s0 = (row0 & 4095) + half * 64;
      const int c = (tn - VT_FROM) * GBN + colL;
      u16* dst = vt_out + ((long)(b * 512 + c)) * 4096 + s0;
#pragma unroll
      for (int i = 0; i < 8; ++i) *(uint4*)(dst + i * 8) = *(const uint4*)(Tt + colL * TLD + half * 64 + i * 8);
      __syncthreads();
    } else {
#pragma unroll
      for (int m = 0; m < 4; ++m)
#pragma unroll
        for (int n = 0; n < 4; ++n)
          epi(tm * GBM + wr * 64 + m * 16 + fr, tn * GBN + wc * 64 + n * 16 + fq * 4, acc[m][n]);
      __syncthreads();
    }
  }
}

struct EpiWin {
  u16 *pr, *qkd, *vt;
  DI void operator()(int row, int col, f32x4 v) const {
    if (col < 1792) {
      *(u16x4*)(pr + (long)row * 1792 + col) = pack4(v);
    } else if (col < 2816) {
      *(u16x4*)(qkd + (long)row * 1024 + (col - 1792)) = pack4(v);
    } else {
      const int b = row >> 12, s = row & 4095, c = col - 2816;
#pragma unroll
      for (int j = 0; j < 4; ++j) vt[((long)(b * 512 + c + j)) * 4096 + s] = f2bf(v[j]);
    }
  }
};
struct EpiBf16 {
  u16* o; int ld;
  DI void operator()(int row, int col, f32x4 v) const { *(u16x4*)(o + (long)row * ld + col) = pack4(v); }
};
struct EpiVtMem {
  u16* o;
  DI void operator()(int row, int col, f32x4 v) const {
    const int b = row >> 8, m = row & 255;
#pragma unroll
    for (int j = 0; j < 4; ++j) o[((long)(b * 1024 + col + j)) * 256 + m] = f2bf(v[j]);
  }
};
struct EpiKVMem {
  u16 *k, *vt;
  DI void operator()(int row, int col, f32x4 v) const {
    if (col < 1024) {
      *(u16x4*)(k + (long)row * 1024 + col) = pack4(v);
    } else {
      const int b = row >> 8, m = row & 255, c = col - 1024;
#pragma unroll
      for (int j = 0; j < 4; ++j) vt[((long)(b * 1024 + c + j)) * 256 + m] = f2bf(v[j]);
    }
  }
};
struct EpiDecay {
  float* e; const float* w0;
  DI void operator()(int row, int col, f32x4 v) const {
    f32x4 r;
#pragma unroll
    for (int j = 0; j < 4; ++j) {
      const float z = -(w0[col + j] + v[j]);
      const float sp = fmaxf(z, 0.f) + __logf(1.f + __expf(-fabsf(z)));
      r[j] = __expf(-sp - 0.5f);
    }
    *(f32x4*)(e + (long)row * 512 + col) = r;
  }
};
struct EpiASig {
  u16* o; const float* a0;
  DI void operator()(int row, int col, f32x4 v) const {
    f32x4 r;
#pragma unroll
    for (int j = 0; j < 4; ++j) r[j] = __builtin_amdgcn_rcpf(1.f + __expf(-(a0[col + j] + v[j])));
    *(u16x4*)(o + (long)row * 512 + col) = pack4(r);
  }
};
struct EpiResX {
  float* h; const float* x;
  DI void operator()(int row, int col, f32x4 v) const {
    const f32x4 xv = *(const f32x4*)(x + (long)row * 1024 + col);
    *(f32x4*)(h + (long)row * 1024 + col) = xv + v;
  }
};
struct EpiResAcc {
  float* h;
  DI void operator()(int row, int col, f32x4 v) const {
    f32x4* p = (f32x4*)(h + (long)row * 1024 + col);
    *p = *p + v;
  }
};
struct EpiRelu2 {
  u16* o;
  DI void operator()(int row, int col, f32x4 v) const {
    f32x4 r;
#pragma unroll
    for (int j = 0; j < 4; ++j) { const float t = fmaxf(v[j], 0.f); r[j] = t * t; }
    *(u16x4*)(o + (long)row * 4096 + col) = pack4(r);
  }
};

DI void rwkv_prep_phase(const Params& p, int bid, int nb) {
  const long total = (long)T_TOK * 32;
  for (long idx = (long)bid * 256 + TIDX; idx < total; idx += (long)nb * 256) {
    const int t = (int)(idx >> 5), c = (int)(idx & 31) * 8;
    float v[8], pv[8];
    unpack8(*(const uint4*)(p.pr + (long)t * 1792 + 1536 + c), v);
    if (t & 4095) unpack8(*(const uint4*)(p.pr + (long)(t - 1) * 1792 + 1536 + c), pv);
    else {
#pragma unroll
      for (int q = 0; q < 8; ++q) pv[q] = 0.f;
    }
    const float4 m0 = *(const float4*)(p.mu + 1536 + c), m1 = *(const float4*)(p.mu + 1536 + c + 4);
    const float mu[8] = {m0.x, m0.y, m0.z, m0.w, m1.x, m1.y, m1.z, m1.w};
    float y[8];
#pragma unroll
    for (int q = 0; q < 8; ++q) {
      const float xx = v[q] + (pv[q] - v[q]) * mu[q];
      if (c < 64) { const float e2 = __expf(2.f * xx); y[q] = 1.f - 2.f * __builtin_amdgcn_rcpf(e2 + 1.f); }
      else if (c < 128) y[q] = xx;
      else y[q] = __builtin_amdgcn_rcpf(1.f + __expf(-xx));
    }
    *(uint4*)(p.lora_in + idx * 8) = make_uint4(pk2(y[0], y[1]), pk2(y[2], y[3]), pk2(y[4], y[5]), pk2(y[6], y[7]));
  }
}

DI void rwkv_scan_seq(const Params& p, int bh, float* sh) {
  const int lane = TIDX & 63;
  const int b = bh >> 3, h = bh & 7, c = h * 64 + lane;
  const float mu_r = p.mu[c], mu_k = p.mu[512 + c], mu_v = p.mu[1024 + c];
  const float kk_w = p.k_k[c], ka_w = p.k_a[c], rk_w = p.r_k[c], lw = p.lnx_w[c], lb = p.lnx_b[c];
  float st[64];
#pragma unroll
  for (int i = 0; i < 64; ++i) st[i] = 0.f;
  float rp = 0.f, kp = 0.f, vp = 0.f;
  const long tok0 = (long)b * 4096;
  u16 nr = p.pr[tok0 * 1792 + c], nk = p.pr[tok0 * 1792 + 512 + c], nv = p.pr[tok0 * 1792 + 1024 + c];
  float ne = p.e_buf[tok0 * 512 + c];
  u16 na = p.asig[tok0 * 512 + c], ng = p.gbuf[tok0 * 512 + c];
  for (int t = 0; t < 4096; ++t) {
    const float r0 = bf2f(nr), k0 = bf2f(nk), v0 = bf2f(nv), e = ne, a = bf2f(na), g = bf2f(ng);
    if (t + 1 < 4096) {
      const long tk = tok0 + t + 1;
      nr = p.pr[tk * 1792 + c]; nk = p.pr[tk * 1792 + 512 + c]; nv = p.pr[tk * 1792 + 1024 + c];
      ne = p.e_buf[tk * 512 + c]; na = p.asig[tk * 512 + c]; ng = p.gbuf[tk * 512 + c];
    }
    const float r = r0 + (rp - r0) * mu_r, k = k0 + (kp - k0) * mu_k, v = v0 + (vp - v0) * mu_v;
    rp = r0; kp = k0; vp = v0;
    const float w = __expf(-e);
    const float kkv = k * kk_w;
    const float n2 = wave_sum(kkv * kkv);
    const float kk = kkv / fmaxf(sqrtf(n2), 1e-12f);
    const float kmod = k * (1.f + (a - 1.f) * ka_w);
    const float bb = kk * a;
    __syncthreads();
    sh[lane] = w; sh[64 + lane] = kk; sh[128 + lane] = bb; sh[192 + lane] = kmod; sh[256 + lane] = r;
    __syncthreads();
    float sa = 0.f;
#pragma unroll
    for (int q = 0; q < 16; ++q) {
      const float4 k4 = *(const float4*)(sh + 64 + q * 4);
      sa += st[q * 4] * k4.x + st[q * 4 + 1] * k4.y + st[q * 4 + 2] * k4.z + st[q * 4 + 3] * k4.w;
      asm volatile("" : "+v"(sa) :: "memory");
    }
    sa = -sa;
    float y = 0.f;
#pragma unroll
    for (int q = 0; q < 16; ++q) {
      const float4 w4 = *(const float4*)(sh + q * 4);
      const float4 b4 = *(const float4*)(sh + 128 + q * 4);
      const float4 m4 = *(const float4*)(sh + 192 + q * 4);
      const float4 r4 = *(const float4*)(sh + 256 + q * 4);
      st[q * 4] = st[q * 4] * w4.x + sa * b4.x + v * m4.x; y += st[q * 4] * r4.x;
      st[q * 4 + 1] = st[q * 4 + 1] * w4.y + sa * b4.y + v * m4.y; y += st[q * 4 + 1] * r4.y;
      st[q * 4 + 2] = st[q * 4 + 2] * w4.z + sa * b4.z + v * m4.z; y += st[q * 4 + 2] * r4.z;
      st[q * 4 + 3] = st[q * 4 + 3] * w4.w + sa * b4.w + v * m4.w; y += st[q * 4 + 3] * r4.w;
      asm volatile("" : "+v"(y) :: "memory");
    }
    const float mean = wave_sum(y) * (1.f / 64.f);
    const float d = y - mean;
    const float var = wave_sum(d * d) * (1.f / 64.f);
    const float yn = d * rsqrtf(var + 64e-5f) * lw + lb;
    const float bonus = wave_sum(r * kmod * rk_w) * v;
    p.mix[(tok0 + t) * 1024 + c] = f2bf((yn + bonus) * g);
  }
}


constexpr int RLD = 72, SLOT = 64 * RLD;
DI bf16x8 ldfrag(const u16* base, int row, int kofs) { return *(const bf16x8*)(base + row * RLD + kofs); }
DI f32x4 unpack4(u16x4 v) { f32x4 r; r[0] = bf2f(v[0]); r[1] = bf2f(v[1]); r[2] = bf2f(v[2]); r[3] = bf2f(v[3]); return r; }
#define ZERO4 ((f32x4){0.f, 0.f, 0.f, 0.f})

DI void ld8f(const float* __restrict__ p, float* o) {
  const float4 a = *(const float4*)p, b = *(const float4*)(p + 4);
  o[0] = a.x; o[1] = a.y; o[2] = a.z; o[3] = a.w; o[4] = b.x; o[5] = b.y; o[6] = b.z; o[7] = b.w;
}
struct RawIn { uint4 R0, R1, K0, K1, V0, V1, A0, A1, pR0, pR1, pK0, pK1, pV0, pV1; float4 E0, E1, E2, E3; };
DI void chunk_load_raw(const Params& p, int tile, int tid, RawIn& w) {
  const int ch = tile & 63, bh = tile >> 6, b = bh >> 3, h = bh & 7;
  const int t = tid >> 2, i0 = (tid & 3) * 16;
  const long tok = (long)b * 4096 + ch * 64 + t;
  const int col = h * 64 + i0;
  const bool first = (ch == 0 && t == 0);
  const u16* pc = p.pr + tok * 1792 + col;
  const uint4 zero4 = make_uint4(0u, 0u, 0u, 0u);
  w.R0 = *(const uint4*)(pc); w.R1 = *(const uint4*)(pc + 8);
  w.K0 = *(const uint4*)(pc + 512); w.K1 = *(const uint4*)(pc + 520);
  w.V0 = *(const uint4*)(pc + 1024); w.V1 = *(const uint4*)(pc + 1032);
  w.A0 = *(const uint4*)(p.asig + tok * 512 + col); w.A1 = *(const uint4*)(p.asig + tok * 512 + col + 8);
  const u16* pp = first ? pc : pc - 1792;
  const uint4 q0 = *(const uint4*)(pp), q1 = *(const uint4*)(pp + 8), q2 = *(const uint4*)(pp + 512), q3 = *(const uint4*)(pp + 520),
              q4 = *(const uint4*)(pp + 1024), q5 = *(const uint4*)(pp + 1032);
  w.pR0 = first ? zero4 : q0; w.pR1 = first ? zero4 : q1; w.pK0 = first ? zero4 : q2; w.pK1 = first ? zero4 : q3;
  w.pV0 = first ? zero4 : q4; w.pV1 = first ? zero4 : q5;
  const float4* ep = (const float4*)(p.e_buf + tok * 512 + col);
  w.E0 = ep[0]; w.E1 = ep[1]; w.E2 = ep[2]; w.E3 = ep[3];
}
DI void rwkv_chunk_prep(const Params& p, int tile, int next_tile, RawIn& raw, char* smem) {
  int tid_ = TIDX;
  asm volatile("" : "+v"(tid_));
  const int tid = tid_, lane = tid & 63, wid = tid >> 6, fr = lane & 15, fq = lane >> 4;
  const int ch = tile & 63, bh = tile >> 6, b = bh >> 3, h = bh & 7;
  u16* S = (u16*)smem;
  u16 *S0 = S, *S1 = S + SLOT, *S2 = S + 2 * SLOT, *S3 = S + 3 * SLOT, *S4 = S + 4 * SLOT, *S5 = S + 5 * SLOT,
      *S6 = S + 6 * SLOT, *S7 = S + 7 * SLOT;
  float* Ef = (float*)S4;
  __syncthreads();
  const int t = tid >> 2, i0 = (tid & 3) * 16;
  const long tok = (long)b * 4096 + ch * 64 + t;
  const int col = h * 64 + i0;
  *(float4*)(Ef + t * 64 + i0) = raw.E0; *(float4*)(Ef + t * 64 + i0 + 4) = raw.E1;
  *(float4*)(Ef + t * 64 + i0 + 8) = raw.E2; *(float4*)(Ef + t * 64 + i0 + 12) = raw.E3;
  __syncthreads();
  {
    const int cc = tid & 63, qq = tid >> 6;
    float s = 0.f;
#pragma unroll
    for (int tt = 0; tt < 16; ++tt) { s += Ef[(qq * 16 + tt) * 64 + cc]; Ef[(qq * 16 + tt) * 64 + cc] = s; }
  }
  __syncthreads();
  float n2 = 0.f, bon = 0.f;
#pragma unroll
  for (int hf = 0; hf < 2; ++hf) {
    const int o = hf * 8;
    float r[8], k[8], a[8], rp[8], kp[8];
    unpack8(hf ? raw.R1 : raw.R0, r); unpack8(hf ? raw.K1 : raw.K0, k); unpack8(hf ? raw.A1 : raw.A0, a);
    unpack8(hf ? raw.pR1 : raw.pR0, rp); unpack8(hf ? raw.pK1 : raw.pK0, kp);
    float mur[8], muk[8], wkk[8], wka[8], wrk[8];
    ld8f(p.mu + col + o, mur); ld8f(p.mu + 512 + col + o, muk); ld8f(p.k_k + col + o, wkk); ld8f(p.k_a + col + o, wka); ld8f(p.r_k + col + o, wrk);
#pragma unroll
    for (int q = 0; q < 8; ++q) {
      const float rr = r[q] + (rp[q] - r[q]) * mur[q];
      const float kx = k[q] + (kp[q] - k[q]) * muk[q];
      const float kkv = kx * wkk[q];
      n2 += kkv * kkv;
      bon += rr * kx * (1.f + (a[q] - 1.f) * wka[q]) * wrk[q];
    }
  }
  n2 += __shfl_xor(n2, 1); n2 += __shfl_xor(n2, 2);
  bon += __shfl_xor(bon, 1); bon += __shfl_xor(bon, 2);
  const float kinv = __builtin_amdgcn_rcpf(fmaxf(__builtin_amdgcn_sqrtf(n2), 1e-12f));
  unsigned pa[8], pbh[8], pkh[8];
  const int tq = t >> 4;
#pragma unroll
  for (int hf = 0; hf < 2; ++hf) {
    const int o = hf * 8;
    float r[8], k[8], v[8], a[8], e[8];
    {
      float rp[8], kp[8], vp[8];
      unpack8(hf ? raw.R1 : raw.R0, r); unpack8(hf ? raw.K1 : raw.K0, k); unpack8(hf ? raw.V1 : raw.V0, v); unpack8(hf ? raw.A1 : raw.A0, a);
      unpack8(hf ? raw.pR1 : raw.pR0, rp); unpack8(hf ? raw.pK1 : raw.pK0, kp); unpack8(hf ? raw.pV1 : raw.pV0, vp);
      float mur[8], muk[8], muv[8];
      ld8f(p.mu + col + o, mur); ld8f(p.mu + 512 + col + o, muk); ld8f(p.mu + 1024 + col + o, muv);
#pragma unroll
      for (int q = 0; q < 8; ++q) {
        r[q] = r[q] + (rp[q] - r[q]) * mur[q];
        k[q] = k[q] + (kp[q] - k[q]) * muk[q];
        v[q] = v[q] + (vp[q] - v[q]) * muv[q];
      }
      const float4 e0 = hf ? raw.E2 : raw.E0, e1 = hf ? raw.E3 : raw.E1;
      e[0] = e0.x; e[1] = e0.y; e[2] = e0.z; e[3] = e0.w; e[4] = e1.x; e[5] = e1.y; e[6] = e1.z; e[7] = e1.w;
    }
    float eq0[8], eq1[8], eq2[8], eq3[8], est[8];
    ld8f(Ef + 15 * 64 + i0 + o, eq0); ld8f(Ef + 31 * 64 + i0 + o, eq1); ld8f(Ef + 47 * 64 + i0 + o, eq2); ld8f(Ef + 63 * 64 + i0 + o, eq3);
    ld8f(Ef + t * 64 + i0 + o, est);
    float At[8], Bt[8], Kt[8], Rt[8], Bh[8], Kh[8], bvv[8], wkk[8], wka[8];
    ld8f(p.k_k + col + o, wkk); ld8f(p.k_a + col + o, wka);
#pragma unroll
    for (int q = 0; q < 8; ++q) {
      const int ii = i0 + o + q;
      const float q0 = eq0[q], q1 = eq1[q], q2 = eq2[q], q3 = eq3[q];
      float Sc = est[q];
      if (tq > 0) Sc += q0;
      if (tq > 1) Sc += q1;
      if (tq > 2) Sc += q2;
      const float SC = q0 + q1 + q2 + q3;
      const float kkn = k[q] * wkk[q] * kinv, bv = kkn * a[q];
      const float km = k[q] * (1.f + (a[q] - 1.f) * wka[q]);
      const float eNS = __expf(-Sc), eS = __builtin_amdgcn_rcpf(eNS), ee = __expf(e[q]), eC = __expf(-SC);
      At[q] = -kkn * ee * eNS;
      Rt[q] = r[q] * eNS;
      Bt[q] = bv * eS;
      Kt[q] = km * eS;
      Bh[q] = bv * (eS * eC);
      Kh[q] = km * (eS * eC);
      bvv[q] = bon * v[q];
      if (t == 63) p.c_gc[(long)tile * 64 + ii] = eC;
      S7[ii * RLD + t] = f2bf(v[q]);
    }
    uint4 w0;
#define PACK8(X) w0 = make_uint4(pk2(X[0], X[1]), pk2(X[2], X[3]), pk2(X[4], X[5]), pk2(X[6], X[7]));
    PACK8(At); *(uint4*)(S0 + t * RLD + i0 + o) = w0;
    pa[hf * 4] = w0.x; pa[hf * 4 + 1] = w0.y; pa[hf * 4 + 2] = w0.z; pa[hf * 4 + 3] = w0.w;
    PACK8(Bt); *(uint4*)(S1 + t * RLD + i0 + o) = w0;
    PACK8(Kt); *(uint4*)(S2 + t * RLD + i0 + o) = w0;
    PACK8(Rt); *(uint4*)(S3 + t * RLD + i0 + o) = w0;
    PACK8(Bh);
    pbh[hf * 4] = w0.x; pbh[hf * 4 + 1] = w0.y; pbh[hf * 4 + 2] = w0.z; pbh[hf * 4 + 3] = w0.w;
    PACK8(Kh);
    pkh[hf * 4] = w0.x; pkh[hf * 4 + 1] = w0.y; pkh[hf * 4 + 2] = w0.z; pkh[hf * 4 + 3] = w0.w;
    PACK8(bvv);
    *(uint4*)(p.asig + tok * 512 + col + o) = w0;
#undef PACK8
  }
  chunk_load_raw(p, next_tile, tid, raw);
  __syncthreads();
  const int trow = wid * 16 + fr;
  f32x4 Pacc[4];
  {
    bf16x8 aF[2], rF[2];
#pragma unroll
    for (int ks = 0; ks < 2; ++ks) { aF[ks] = ldfrag(S0, trow, ks * 32 + fq * 8); rF[ks] = ldfrag(S3, trow, ks * 32 + fq * 8); }
    f32x4 lab[4];
#pragma unroll
    for (int nt = 0; nt < 4; ++nt) {
      f32x4 lak = ZERO4, prb = ZERO4, prk = ZERO4;
      lab[nt] = ZERO4;
#pragma unroll
      for (int ks = 0; ks < 2; ++ks) {
        const bf16x8 bF = ldfrag(S1, nt * 16 + fr, ks * 32 + fq * 8), kF = ldfrag(S2, nt * 16 + fr, ks * 32 + fq * 8);
        lab[nt] = mfma16(bF, aF[ks], lab[nt]);
        lak = mfma16(kF, aF[ks], lak);
        prb = mfma16(bF, rF[ks], prb);
        prk = mfma16(kF, rF[ks], prk);
      }
      const int j0 = nt * 16 + fq * 4;
#pragma unroll
      for (int jj = 0; jj < 4; ++jj) {
        const int j = j0 + jj;
        if (!(j < trow)) { lab[nt][jj] = 0.f; lak[jj] = 0.f; }
        if (!(j <= trow)) { prb[jj] = 0.f; prk[jj] = 0.f; }
      }
      *(u16x4*)(S4 + trow * RLD + j0) = pack4(lak);
      *(u16x4*)(S5 + trow * RLD + j0) = pack4(prb);
      *(u16x4*)(S6 + trow * RLD + j0) = pack4(prk);
    }
    __syncthreads();
#pragma unroll
    for (int nt = 0; nt < 4; ++nt) {
      const int j0 = nt * 16 + fq * 4;
      f32x4 pi;
#pragma unroll
      for (int jj = 0; jj < 4; ++jj) {
        const int j = j0 + jj;
        pi[jj] = (j == trow ? 1.f : 0.f);
        S1[j * RLD + trow] = f2bf(lab[nt][jj]);
      }
      Pacc[nt] = pi;
      *(u16x4*)(S0 + trow * RLD + j0) = pack4(lab[nt]);
      *(u16x4*)(S2 + trow * RLD + j0) = pack4(pi);
    }
    __syncthreads();
  }
#pragma unroll 1
  for (int it = 0; it < 5; ++it) {
    bf16x8 pF[2], xF[2];
#pragma unroll
    for (int ks = 0; ks < 2; ++ks) { pF[ks] = ldfrag(S2, trow, ks * 32 + fq * 8); xF[ks] = ldfrag(S0, trow, ks * 32 + fq * 8); }
    f32x4 xn[4];
#pragma unroll
    for (int nt = 0; nt < 4; ++nt) {
      xn[nt] = ZERO4;
#pragma unroll
      for (int ks = 0; ks < 2; ++ks) {
        const bf16x8 xtF = ldfrag(S1, nt * 16 + fr, ks * 32 + fq * 8);
        Pacc[nt] = mfma16(xtF, pF[ks], Pacc[nt]);
        xn[nt] = mfma16(xtF, xF[ks], xn[nt]);
      }
    }
    __syncthreads();
#pragma unroll
    for (int nt = 0; nt < 4; ++nt) {
      const int j0 = nt * 16 + fq * 4;
      *(u16x4*)(S2 + trow * RLD + j0) = pack4(Pacc[nt]);
      *(u16x4*)(S0 + trow * RLD + j0) = pack4(xn[nt]);
#pragma unroll
      for (int jj = 0; jj < 4; ++jj) S1[(j0 + jj) * RLD + trow] = f2bf(xn[nt][jj]);
    }
    __syncthreads();
  }
  {
    bf16x8 pF[2];
#pragma unroll
    for (int ks = 0; ks < 2; ++ks) pF[ks] = ldfrag(S2, trow, ks * 32 + fq * 8);
#pragma unroll
    for (int nt = 0; nt < 4; ++nt)
#pragma unroll
      for (int ks = 0; ks < 2; ++ks) Pacc[nt] = mfma16(ldfrag(S1, nt * 16 + fr, ks * 32 + fq * 8), pF[ks], Pacc[nt]);
    __syncthreads();
#pragma unroll
    for (int nt = 0; nt < 4; ++nt) *(u16x4*)(S2 + trow * RLD + nt * 16 + fq * 4) = pack4(Pacc[nt]);
#pragma unroll
    for (int q = 0; q < 8; ++q) {
      S0[(i0 + 2 * q) * RLD + t] = (u16)(pa[q] & 0xffffu);
      S0[(i0 + 2 * q + 1) * RLD + t] = (u16)(pa[q] >> 16);
    }
    __syncthreads();
  }
  {
    bf16x8 tF[2], lkF[2];
#pragma unroll
    for (int ks = 0; ks < 2; ++ks) { tF[ks] = ldfrag(S2, trow, ks * 32 + fq * 8); lkF[ks] = ldfrag(S4, trow, ks * 32 + fq * 8); }
    f32x4 z[4];
#pragma unroll
    for (int nt = 0; nt < 4; ++nt) {
      f32x4 w1 = ZERO4;
      z[nt] = ZERO4;
#pragma unroll
      for (int ks = 0; ks < 2; ++ks) {
        w1 = mfma16(tF[ks], ldfrag(S0, nt * 16 + fr, ks * 32 + fq * 8), w1);
        z[nt] = mfma16(lkF[ks], ldfrag(S7, nt * 16 + fr, ks * 32 + fq * 8), z[nt]);
      }
      *(u16x4*)(S1 + (nt * 16 + fr) * RLD + wid * 16 + fq * 4) = pack4(w1);
    }
    __syncthreads();
#pragma unroll
    for (int nt = 0; nt < 4; ++nt) *(u16x4*)(S0 + (nt * 16 + fr) * RLD + wid * 16 + fq * 4) = pack4(z[nt]);
    __syncthreads();
#pragma unroll
    for (int nt = 0; nt < 4; ++nt) {
      f32x4 u0 = ZERO4;
#pragma unroll
      for (int ks = 0; ks < 2; ++ks) u0 = mfma16(tF[ks], ldfrag(S0, nt * 16 + fr, ks * 32 + fq * 8), u0);
      *(u16x4*)(S4 + (nt * 16 + fr) * RLD + wid * 16 + fq * 4) = pack4(u0);
    }
    __syncthreads();
#pragma unroll
    for (int q = 0; q < 8; ++q) {
      S0[(i0 + 2 * q) * RLD + t] = (u16)(pbh[q] & 0xffffu);
      S0[(i0 + 2 * q + 1) * RLD + t] = (u16)(pbh[q] >> 16);
      S2[(i0 + 2 * q) * RLD + t] = (u16)(pkh[q] & 0xffffu);
      S2[(i0 + 2 * q + 1) * RLD + t] = (u16)(pkh[q] >> 16);
    }
    __syncthreads();
  }
  {
    bf16x8 bhF[2], khF[2], pbF[2], pkF[2];
#pragma unroll
    for (int ks = 0; ks < 2; ++ks) {
      bhF[ks] = ldfrag(S0, trow, ks * 32 + fq * 8); khF[ks] = ldfrag(S2, trow, ks * 32 + fq * 8);
      pbF[ks] = ldfrag(S5, trow, ks * 32 + fq * 8); pkF[ks] = ldfrag(S6, trow, ks * 32 + fq * 8);
    }
    u16* mp = p.c_mp + (long)tile * 4096;
    u16* yh = p.c_yh + (long)tile * 4096;
    u16* nc = p.c_nc + (long)tile * 4096;
    u16* y0 = p.c_y0 + (long)tile * 4096;
#pragma unroll
    for (int nt = 0; nt < 4; ++nt) {
      f32x4 m = ZERO4, n = ZERO4, yy = ZERO4, yz = ZERO4;
#pragma unroll
      for (int ks = 0; ks < 2; ++ks) {
        const bf16x8 w1F = ldfrag(S1, nt * 16 + fr, ks * 32 + fq * 8);
        const bf16x8 u0F = ldfrag(S4, nt * 16 + fr, ks * 32 + fq * 8);
        const bf16x8 vF = ldfrag(S7, nt * 16 + fr, ks * 32 + fq * 8);
        m = mfma16(w1F, bhF[ks], m);
        n = mfma16(bhF[ks], u0F, n);
        n = mfma16(khF[ks], vF, n);
        yy = mfma16(w1F, pbF[ks], yy);
        yz = mfma16(u0F, pbF[ks], yz);
        yz = mfma16(vF, pkF[ks], yz);
      }
      yy += unpack4(*(const u16x4*)(S3 + trow * RLD + nt * 16 + fq * 4));
      *(u16x4*)(mp + trow * 64 + nt * 16 + fq * 4) = pack4(m);
      *(u16x4*)(yh + trow * 64 + nt * 16 + fq * 4) = pack4(yy);
      *(u16x4*)(nc + ((wid * 4 + nt) * 64 + lane) * 4) = pack4(n);
      *(u16x4*)(y0 + ((wid * 4 + nt) * 64 + lane) * 4) = pack4(yz);
    }
  }
}

DI bf16x8 ldperm(const u16* rowp, int ks, int fq) {
  const u16x4 lo = *(const u16x4*)(rowp + ks * 32 + fq * 4);
  const u16x4 hi = *(const u16x4*)(rowp + ks * 32 + 16 + fq * 4);
  bf16x8 r;
#pragma unroll
  for (int j = 0; j < 4; ++j) { r[j] = (short)lo[j]; r[4 + j] = (short)hi[j]; }
  return r;
}
DI void rwkv_state_pass(const Params& p, int bh, char* smem) {
  const int tid = TIDX, lane = tid & 63, wid = tid >> 6, fr = lane & 15, fq = lane >> 4;
  const int b = bh >> 3, h = bh & 7;
  constexpr int BUFB = 2 * SLOT * 2 + 2 * 8192;
  float* gcs = (float*)(smem + 2 * BUFB);
  float* stats = gcs + 128;
  f32x4 hacc[4];
#pragma unroll
  for (int i = 0; i < 4; ++i) hacc[i] = ZERO4;
  const int cb = h * 64 + wid * 16 + fq * 4;
  const float4 lw = *(const float4*)(p.lnx_w + cb), lb = *(const float4*)(p.lnx_b + cb);
  const int lrow = tid >> 3, lcol = (tid & 7) * 8;
  uint4 pm0, pm1, py0, py1, pn0, pn1, pz0, pz1;
  float pregc = 0.f;
  __syncthreads();
  {
    const long tile = (long)bh * 64;
    const u16 *mp = p.c_mp + tile * 4096, *yh = p.c_yh + tile * 4096, *nc = p.c_nc + tile * 4096, *y0 = p.c_y0 + tile * 4096;
    pm0 = *(const uint4*)(mp + lrow * 64 + lcol); pm1 = *(const uint4*)(mp + (lrow + 32) * 64 + lcol);
    py0 = *(const uint4*)(yh + lrow * 64 + lcol); py1 = *(const uint4*)(yh + (lrow + 32) * 64 + lcol);
    pn0 = *(const uint4*)(nc + tid * 8); pn1 = *(const uint4*)(nc + (tid + 256) * 8);
    pz0 = *(const uint4*)(y0 + tid * 8); pz1 = *(const uint4*)(y0 + (tid + 256) * 8);
    if (tid < 64) pregc = p.c_gc[tile * 64 + tid];
    u16* bf = (u16*)smem;
    *(uint4*)(bf + lrow * RLD + lcol) = pm0; *(uint4*)(bf + (lrow + 32) * RLD + lcol) = pm1;
    *(uint4*)(bf + SLOT + lrow * RLD + lcol) = py0; *(uint4*)(bf + SLOT + (lrow + 32) * RLD + lcol) = py1;
    *(uint4*)(bf + 2 * SLOT + tid * 8) = pn0; *(uint4*)(bf + 2 * SLOT + (tid + 256) * 8) = pn1;
    *(uint4*)(bf + 2 * SLOT + 4096 + tid * 8) = pz0; *(uint4*)(bf + 2 * SLOT + 4096 + (tid + 256) * 8) = pz1;
    if (tid < 64) gcs[tid] = pregc;
  }
  __syncthreads();
#pragma unroll 1
  for (int c = 0; c < 64; ++c) {
    const int cur = c & 1;
    if (c + 1 < 64) {
      const long tile = (long)bh * 64 + c + 1;
      const u16 *mp = p.c_mp + tile * 4096, *yh = p.c_yh + tile * 4096, *nc = p.c_nc + tile * 4096, *y0 = p.c_y0 + tile * 4096;
      pm0 = *(const uint4*)(mp + lrow * 64 + lcol); pm1 = *(const uint4*)(mp + (lrow + 32) * 64 + lcol);
      py0 = *(const uint4*)(yh + lrow * 64 + lcol); py1 = *(const uint4*)(yh + (lrow + 32) * 64 + lcol);
      pn0 = *(const uint4*)(nc + tid * 8); pn1 = *(const uint4*)(nc + (tid + 256) * 8);
      pz0 = *(const uint4*)(y0 + tid * 8); pz1 = *(const uint4*)(y0 + (tid + 256) * 8);
      if (tid < 64) pregc = p.c_gc[tile * 64 + tid];
    }
    const long tg0 = (long)b * 4096 + c * 64;
    u16x4 bvr[4], gr[4];
#pragma unroll
    for (int tt = 0; tt < 4; ++tt) {
      bvr[tt] = *(const u16x4*)(p.asig + (tg0 + tt * 16 + fr) * 512 + cb);
      gr[tt] = *(const u16x4*)(p.gbuf + (tg0 + tt * 16 + fr) * 512 + cb);
    }
    const u16* bf = (const u16*)(smem + cur * BUFB);
    const u16 *Lmp = bf, *Lyh = bf + SLOT, *Lnc = bf + 2 * SLOT, *Ly0 = bf + 2 * SLOT + 4096;
    bf16x8 hf[2];
#pragma unroll
    for (int ks = 0; ks < 2; ++ks)
#pragma unroll
      for (int j = 0; j < 4; ++j) {
        hf[ks][j] = (short)f2bf(hacc[2 * ks][j]);
        hf[ks][4 + j] = (short)f2bf(hacc[2 * ks + 1][j]);
      }
    f32x4 y[4];
#pragma unroll
    for (int tt = 0; tt < 4; ++tt) {
      y[tt] = unpack4(*(const u16x4*)(Ly0 + ((tt * 4 + wid) * 64 + lane) * 4));
#pragma unroll
      for (int ks = 0; ks < 2; ++ks) {
        const u16x4 lo = *(const u16x4*)(Lyh + (tt * 16 + fr) * RLD + ks * 32 + fq * 4);
        const u16x4 hi = *(const u16x4*)(Lyh + (tt * 16 + fr) * RLD + ks * 32 + 16 + fq * 4);
        bf16x8 yF;
#pragma unroll
        for (int j = 0; j < 4; ++j) { yF[j] = (short)lo[j]; yF[4 + j] = (short)hi[j]; }
        y[tt] = mfma16(hf[ks], yF, y[tt]);
      }
      float s1 = y[tt][0] + y[tt][1] + y[tt][2] + y[tt][3];
      float s2 = y[tt][0] * y[tt][0] + y[tt][1] * y[tt][1] + y[tt][2] * y[tt][2] + y[tt][3] * y[tt][3];
      s1 += __shfl_xor(s1, 16); s1 += __shfl_xor(s1, 32);
      s2 += __shfl_xor(s2, 16); s2 += __shfl_xor(s2, 32);
      if (fq == 0) *(float2*)(stats + ((cur * 4 + wid) * 64 + tt * 16 + fr) * 2) = make_float2(s1, s2);
    }
#pragma unroll
    for (int it = 0; it < 4; ++it) {
      const f32x4 nn = unpack4(*(const u16x4*)(Lnc + ((it * 4 + wid) * 64 + lane) * 4));
      const float4 g4 = *(const float4*)(gcs + cur * 64 + it * 16 + fq * 4);
      f32x4 a;
      a[0] = hacc[it][0] * g4.x + nn[0]; a[1] = hacc[it][1] * g4.y + nn[1];
      a[2] = hacc[it][2] * g4.z + nn[2]; a[3] = hacc[it][3] * g4.w + nn[3];
#pragma unroll
      for (int ks = 0; ks < 2; ++ks) {
        const u16x4 lo = *(const u16x4*)(Lmp + (it * 16 + fr) * RLD + ks * 32 + fq * 4);
        const u16x4 hi = *(const u16x4*)(Lmp + (it * 16 + fr) * RLD + ks * 32 + 16 + fq * 4);
        bf16x8 mF;
#pragma unroll
        for (int j = 0; j < 4; ++j) { mF[j] = (short)lo[j]; mF[4 + j] = (short)hi[j]; }
        a = mfma16(mF, hf[ks], a);
      }
      hacc[it] = a;
    }
    if (c + 1 < 64) {
      u16* nb_ = (u16*)(smem + (cur ^ 1) * BUFB);
      *(uint4*)(nb_ + lrow * RLD + lcol) = pm0; *(uint4*)(nb_ + (lrow + 32) * RLD + lcol) = pm1;
      *(uint4*)(nb_ + SLOT + lrow * RLD + lcol) = py0; *(uint4*)(nb_ + SLOT + (lrow + 32) * RLD + lcol) = py1;
      *(uint4*)(nb_ + 2 * SLOT + tid * 8) = pn0; *(uint4*)(nb_ + 2 * SLOT + (tid + 256) * 8) = pn1;
      *(uint4*)(nb_ + 2 * SLOT + 4096 + tid * 8) = pz0; *(uint4*)(nb_ + 2 * SLOT + 4096 + (tid + 256) * 8) = pz1;
      if (tid < 64) gcs[(cur ^ 1) * 64 + tid] = pregc;
    }
    __syncthreads();
#pragma unroll
    for (int tt = 0; tt < 4; ++tt) {
      float s1 = 0.f, s2 = 0.f;
#pragma unroll
      for (int w = 0; w < 4; ++w) {
        const float2 st = *(const float2*)(stats + ((cur * 4 + w) * 64 + tt * 16 + fr) * 2);
        s1 += st.x; s2 += st.y;
      }
      const float mean = s1 * (1.f / 64.f);
      const float var = fmaxf(s2 * (1.f / 64.f) - mean * mean, 0.f);
      const float rstd = rsqrtf(var + 64e-5f);
      const f32x4 bv = unpack4(bvr[tt]), g = unpack4(gr[tt]);
      f32x4 o;
      o[0] = ((y[tt][0] - mean) * rstd * lw.x + lb.x + bv[0]) * g[0];
      o[1] = ((y[tt][1] - mean) * rstd * lw.y + lb.y + bv[1]) * g[1];
      o[2] = ((y[tt][2] - mean) * rstd * lw.z + lb.z + bv[2]) * g[2];
      o[3] = ((y[tt][3] - mean) * rstd * lw.w + lb.w + bv[3]) * g[3];
      *(u16x4*)(p.mix + (tg0 + tt * 16 + fr) * 1024 + cb) = pack4(o);
    }
  }
}

template <int DQK, int DV, int NMAP, bool DIFF, int KT>
DI void attn_tile(const u16* __restrict__ Q, long q_stride, const u16* __restrict__ Kg, long k_stride,
                  const u16* __restrict__ Vtg, long vt_stride, int nkt, float scale, u16* __restrict__ Out, long o_stride,
                  float lam, const float* __restrict__ subw, char* smem, int lag) {
  constexpr int KW = NMAP * DQK, KLD = KW + 8, VLD = KT + 8;
  constexpr int KCH = KT * (KW / 8) / 256, VCH = DV * (KT / 8) / 256;
  constexpr int BUFE = KT * KLD + DV * VLD;
  constexpr bool DB = (2 * BUFE * 2 <= 79 * 1024);
  constexpr int VRS = 256 / (KT / 8);
  u16* S0 = (u16*)smem;
  const int tid = TIDX, lane = tid & 63, wid = tid >> 6, fr = lane & 15, fq = lane >> 4;
  bf16x8 qf[NMAP][DQK / 32];
#pragma unroll
  for (int m = 0; m < NMAP; ++m)
#pragma unroll
    for (int ks = 0; ks < DQK / 32; ++ks)
      qf[m][ks] = *(const bf16x8*)(Q + (long)(wid * 16 + fr) * q_stride + m * DQK + ks * 32 + fq * 8);
  f32x4 o[NMAP][DV / 16];
  float mrun[NMAP], lrun[NMAP];
#pragma unroll
  for (int m = 0; m < NMAP; ++m) {
    mrun[m] = -1e30f; lrun[m] = 0.f;
#pragma unroll
    for (int dt = 0; dt < DV / 16; ++dt) o[m][dt] = (f32x4){0.f, 0.f, 0.f, 0.f};
  }
  static_assert(DB && KCH == 4 && VCH == 4, "prefetch registers are written out for 4 + 4 chunks");
  uint4 kr0, kr1, kr2, kr3, vr0, vr1, vr2, vr3;
  const int krow = tid / (KW / 8), kcc = (tid % (KW / 8)) * 8;
  constexpr int KRS = 256 / (KW / 8);
  const int vrow = tid / (KT / 8), vcc = (tid % (KT / 8)) * 8;
  const float sl2 = scale * 1.44269504f;
  __syncthreads();
  if (lag) __syncthreads();
#pragma unroll
  for (int i = 0; i < KCH; ++i) *(uint4*)(S0 + (krow + i * KRS) * KLD + kcc) = *(const uint4*)(Kg + (long)(krow + i * KRS) * k_stride + kcc);
#pragma unroll
  for (int i = 0; i < VCH; ++i) *(uint4*)(S0 + KT * KLD + (vrow + i * VRS) * VLD + vcc) = *(const uint4*)(Vtg + (long)(vrow + i * VRS) * vt_stride + vcc);
  __syncthreads();
  for (int kt = 0; kt < nkt; ++kt) {
    const u16* Ks = S0 + (DB ? (kt & 1) * BUFE : 0);
    const u16* Vs = Ks + KT * KLD;
    const int ktn = min(kt + 1, nkt - 1);
    {
      const u16* kp_ = Kg + (long)(ktn * KT + krow) * k_stride + kcc;
      kr0 = *(const uint4*)(kp_); kr1 = *(const uint4*)(kp_ + (long)KRS * k_stride);
      kr2 = *(const uint4*)(kp_ + (long)(2 * KRS) * k_stride); kr3 = *(const uint4*)(kp_ + (long)(3 * KRS) * k_stride);
      const u16* vp_ = Vtg + (long)vrow * vt_stride + ktn * KT + vcc;
      vr0 = *(const uint4*)(vp_); vr1 = *(const uint4*)(vp_ + (long)VRS * vt_stride);
      vr2 = *(const uint4*)(vp_ + (long)(2 * VRS) * vt_stride); vr3 = *(const uint4*)(vp_ + (long)(3 * VRS) * vt_stride);
    }
    f32x4 s[NMAP][KT / 16];
#pragma unroll
    for (int m = 0; m < NMAP; ++m)
#pragma unroll
      for (int c = 0; c < KT / 16; ++c) {
        s[m][c] = (f32x4){0.f, 0.f, 0.f, 0.f};
#pragma unroll
        for (int ks = 0; ks < DQK / 32; ++ks) {
          const bf16x8 kf = *(const bf16x8*)(Ks + (c * 16 + fr) * KLD + m * DQK + ks * 32 + fq * 8);
          s[m][c] = mfma16(kf, qf[m][ks], s[m][c]);
        }
      }
    bf16x8 pb[NMAP][KT / 32];
#pragma unroll
    for (int m = 0; m < NMAP; ++m) {
      float lmx = -1e30f;
#pragma unroll
      for (int c = 0; c < KT / 16; ++c)
#pragma unroll
        for (int j = 0; j < 4; ++j) lmx = fmaxf(lmx, s[m][c][j]);
      lmx *= sl2;
      if (__builtin_amdgcn_readfirstlane(__any(lmx > mrun[m] + 16.f))) {
        float mx = fmaxf(lmx, __shfl_xor(lmx, 16));
        mx = fmaxf(mx, __shfl_xor(mx, 32));
        const float mnew = fmaxf(mrun[m], mx);
        const float alpha = __builtin_amdgcn_exp2f(mrun[m] - mnew);
        mrun[m] = mnew;
        lrun[m] *= alpha;
#pragma unroll
        for (int dt = 0; dt < DV / 16; ++dt) o[m][dt] *= alpha;
      }
      float psum = 0.f;
#pragma unroll
      for (int c = 0; c < KT / 16; ++c)
#pragma unroll
        for (int j = 0; j < 4; ++j) { s[m][c][j] = __builtin_amdgcn_exp2f(s[m][c][j] * sl2 - mrun[m]); psum += s[m][c][j]; }
      lrun[m] += psum;
#pragma unroll
      for (int k2 = 0; k2 < KT / 32; ++k2) {
        u32x4 pw;
        pw[0] = cvtpk(s[m][2 * k2][0], s[m][2 * k2][1]); pw[1] = cvtpk(s[m][2 * k2][2], s[m][2 * k2][3]);
        pw[2] = cvtpk(s[m][2 * k2 + 1][0], s[m][2 * k2 + 1][1]); pw[3] = cvtpk(s[m][2 * k2 + 1][2], s[m][2 * k2 + 1][3]);
        pb[m][k2] = __builtin_bit_cast(bf16x8, pw);
      }
    }
    __syncthreads();
    __builtin_amdgcn_s_setprio(1);
#pragma unroll
    for (int k2 = 0; k2 < KT / 32; ++k2)
#pragma unroll
      for (int dt = 0; dt < DV / 16; ++dt) {
        const u16x4 lo = *(const u16x4*)(Vs + (dt * 16 + fr) * VLD + k2 * 32 + fq * 4);
        const u16x4 hi = *(const u16x4*)(Vs + (dt * 16 + fr) * VLD + k2 * 32 + 16 + fq * 4);
        bf16x8 vf;
#pragma unroll
        for (int j = 0; j < 4; ++j) { vf[j] = (short)lo[j]; vf[4 + j] = (short)hi[j]; }
#pragma unroll
        for (int m = 0; m < NMAP; ++m) o[m][dt] = mfma16(vf, pb[m][k2], o[m][dt]);
      }
    __builtin_amdgcn_s_setprio(0);
    {
      u16* Kd = S0 + ((kt + 1) & 1) * BUFE + krow * KLD + kcc;
      *(uint4*)(Kd) = kr0; *(uint4*)(Kd + KRS * KLD) = kr1; *(uint4*)(Kd + 2 * KRS * KLD) = kr2; *(uint4*)(Kd + 3 * KRS * KLD) = kr3;
      u16* Vd = S0 + ((kt + 1) & 1) * BUFE + KT * KLD + vrow * VLD + vcc;
      *(uint4*)(Vd) = vr0; *(uint4*)(Vd + VRS * VLD) = vr1; *(uint4*)(Vd + 2 * VRS * VLD) = vr2; *(uint4*)(Vd + 3 * VRS * VLD) = vr3;
    }
    __syncthreads();
  }
  if (!lag) __syncthreads();
  float linv[NMAP];
#pragma unroll
  for (int m = 0; m < NMAP; ++m) {
    float l = lrun[m];
    l += __shfl_xor(l, 16);
    l += __shfl_xor(l, 32);
    linv[m] = 1.f / l;
  }
  u16* orow = Out + (long)(wid * 16 + fr) * o_stride;
  if (DIFF) {
    float ss = 0.f;
#pragma unroll
    for (int dt = 0; dt < DV / 16; ++dt)
#pragma unroll
      for (int j = 0; j < 4; ++j) {
        const float val = o[0][dt][j] * linv[0] - lam * o[NMAP - 1][dt][j] * linv[NMAP - 1];
        o[0][dt][j] = val;
        ss += val * val;
      }
    ss += __shfl_xor(ss, 16);
    ss += __shfl_xor(ss, 32);
    const float rstd = rsqrtf(ss * (1.f / DV) + 1e-5f) * 0.8f;
#pragma unroll
    for (int dt = 0; dt < DV / 16; ++dt) {
      f32x4 r;
#pragma unroll
      for (int j = 0; j < 4; ++j) r[j] = o[0][dt][j] * rstd * subw[dt * 16 + fq * 4 + j];
      *(u16x4*)(orow + dt * 16 + fq * 4) = pack4(r);
    }
  } else {
#pragma unroll
    for (int dt = 0; dt < DV / 16; ++dt) {
      f32x4 r = o[0][dt] * linv[0];
      *(u16x4*)(orow + dt * 16 + fq * 4) = pack4(r);
    }
  }
}


DI void transpose_v_phase(const Params& p, int bid, int nb, char* smem) {
  u16* t = (u16*)smem;
  const int tid = TIDX;
  for (int tile = bid; tile < 4096; tile += nb) {
    const int b = tile >> 9, st = (tile >> 3) & 63, ct = tile & 7;
    const int r = tid >> 2, seg = (tid & 3) * 16;
    const u16* src = p.vrm + ((long)(b * 4096 + st * 64 + r)) * 512 + ct * 64 + seg;
    const uint4 a0 = *(const uint4*)(src), a1 = *(const uint4*)(src + 8);
    __syncthreads();
    *(uint4*)(t + r * 72 + seg) = a0; *(uint4*)(t + r * 72 + seg + 8) = a1;
    __syncthreads();
    unsigned w[8];
#pragma unroll
    for (int q = 0; q < 8; ++q) w[q] = (unsigned)t[(seg + 2 * q) * 72 + r] | ((unsigned)t[(seg + 2 * q + 1) * 72 + r] << 16);
    u16* dst = p.vt + ((long)(b * 512 + ct * 64 + r)) * 4096 + st * 64 + seg;
    *(uint4*)(dst) = make_uint4(w[0], w[1], w[2], w[3]);
    *(uint4*)(dst + 8) = make_uint4(w[4], w[5], w[6], w[7]);
  }
}


#define GB_CENSUS(x) (64 * (1 + (x)))
#define GB_XARR(x) (64 * (17 + (x)))
#define GB_XGEN(x) (64 * (33 + (x)))
#define GB_TOP (64 * 49)
DI unsigned gb_ld(unsigned* p) { return __hip_atomic_load(p, __ATOMIC_RELAXED, __HIP_MEMORY_SCOPE_AGENT); }
DI unsigned gb_add(unsigned* p) { return __hip_atomic_fetch_add(p, 1u, __ATOMIC_RELAXED, __HIP_MEMORY_SCOPE_AGENT); }
DI void gsync(unsigned* gw, const unsigned* gl, unsigned& epoch) {
  asm volatile("s_waitcnt vmcnt(0) lgkmcnt(0)" ::: "memory");
  __syncthreads();
  epoch += 1;
  if (threadIdx.x == 0) {
    const unsigned gnmine = gl[0], gnx = gl[1], gxid = gl[2];
    __builtin_amdgcn_fence(__ATOMIC_RELEASE, "agent");
    asm volatile("s_waitcnt vmcnt(0)" ::: "memory");
    const unsigned old = gb_add(gw + GB_XARR(gxid));
    if (old + 1 == gnmine * epoch) gb_add(gw + GB_TOP);
    while (gb_ld(gw + GB_TOP) < gnx * epoch) __builtin_amdgcn_s_sleep(1);
    __builtin_amdgcn_fence(__ATOMIC_ACQUIRE, "agent");
    asm volatile("s_waitcnt vmcnt(0)" ::: "memory");
  }
  __syncthreads();
}
DI void gsync_first(unsigned* cnt) {
  asm volatile("s_waitcnt vmcnt(0) lgkmcnt(0)" ::: "memory");
  __syncthreads();
  if (threadIdx.x == 0) {
    __builtin_amdgcn_fence(__ATOMIC_RELEASE, "agent");
    asm volatile("s_waitcnt vmcnt(0)" ::: "memory");
    gb_add(cnt);
    while (gb_ld(cnt) < gridDim.x) __builtin_amdgcn_s_sleep(1);
    __builtin_amdgcn_fence(__ATOMIC_ACQUIRE, "agent");
    asm volatile("s_waitcnt vmcnt(0)" ::: "memory");
  }
  __syncthreads();
}
constexpr int SMEM_HALF = 80 * 1024, SMEM_BYTES = 2 * SMEM_HALF;

template <class Epi>
DI void big_gemm(char* smem, const u16* A, const u16* Bt, int M, int N, int K, const Epi& E) {
  pg8::StaticOrder S;
  S.init(M, N, (int)gridDim.x, (int)blockIdx.x);
  pg8::gemm_phase<Epi, pg8::StaticOrder, false>((PG8_LAS unsigned char*)smem, pg8::Gemm{A, Bt, M, N, K}, S, E, nullptr);
  __syncthreads();
}

__global__ void __launch_bounds__(512, 2) fwd_megakernel(Params p) {
  cg::grid_group grid = cg::this_grid();
  __shared__ __attribute__((aligned(16))) char smem_all[SMEM_BYTES];
  const int half = __builtin_amdgcn_readfirstlane(threadIdx.x >> 8);
  const int bid = blockIdx.x * 2 + half, nb = gridDim.x * 2;
  char* smem = smem_all + half * SMEM_HALF;
  unsigned epoch = 0;

  if (blockIdx.x == 0 && threadIdx.x == 0) *p.counter = 0;
  const unsigned my_xcc = (unsigned)__builtin_amdgcn_s_getreg((3 << 11) | 20) & 0xFu;
  if (threadIdx.x == 0) gb_add(p.gbar + GB_CENSUS(my_xcc));
  for (int i = blockIdx.x * 512 + threadIdx.x; i < 3 * T_TOK; i += gridDim.x * 512) p.ss1[i] = 0.f;
  transpose_w(p.w_in, p.wt_in, 1024, 3328, bid, nb, smem);
  transpose_w(p.w_out, p.wt_out, 1024, 1024, bid, nb, smem);
  transpose_w(p.w_mq, p.wt_mq, 1024, 1024, bid, nb, smem, p.norm_mem_w);
  transpose_w(p.w_mk, p.wt_mk, 1024, 1024, bid, nb, smem);
  transpose_w(p.w_mv, p.wt_mv, 1024, 1024, bid, nb, smem);
  transpose_w(p.w_mo, p.wt_mo, 1024, 1024, bid, nb, smem);
  transpose_w(p.w_up, p.wt_up, 1024, 4096, bid, nb, smem, p.norm_mlp_w);
  transpose_w(p.w_down, p.wt_down, 4096, 1024, bid, nb, smem);
  transpose_w(p.w_dec_up, p.wt_dec, 64, 512, bid, nb, smem);
  transpose_w(p.a_up, p.wt_a, 64, 512, bid, nb, smem);
  transpose_w(p.g_up, p.wt_g, 128, 512, bid, nb, smem);
  rmsnorm_phase<true>(p.x, p.norm_mix_w, p.xn, T_TOK, bid, nb);
  rmsnorm_phase<true>(p.mem, p.norm_src_w, p.memn, 2048, bid, nb);
  if (p.never) grid.sync();
  gsync_first(p.gbar + 64 * 50);
  unsigned* gb_lds = (unsigned*)(smem_all + SMEM_BYTES - 32);
  if (threadIdx.x == 0) {
    unsigned nm = 0, nx = 0, msk = 0;
    for (unsigned x = 0; x < 16; ++x) { const unsigned c = gb_ld(p.gbar + GB_CENSUS(x)); if (c) { ++nx; msk |= 1u << x; } if (x == my_xcc) nm = c; }
    gb_lds[0] = nm; gb_lds[1] = nx; gb_lds[2] = my_xcc; gb_lds[3] = msk;
  }
  __syncthreads();

  big_gemm(smem_all, p.xn, p.wt_in, T_TOK, 3328, 1024, pg8::EpiWinP{p.pr, p.qkd, p.vrm});
  gemm_phase<-1>(p.memn, 1024, p.wt_mk, 1024, 2048, 2048, 1024, EpiKVMem{p.kmem, p.vtmem}, bid >= 256 ? bid - 256 : bid + 256, nb, smem);
  gsync(p.gbar, gb_lds, epoch);

  rwkv_prep_phase(p, bid, nb);
  transpose_v_phase(p, bid, nb, smem);
  gsync(p.gbar, gb_lds, epoch);

  gemm_phase<-1>(p.lora_in, 256, p.wt_dec, 64, T_TOK, 512, 64, EpiDecay{p.e_buf, p.w0}, bid, nb, smem);
  gemm_phase<-1>(p.lora_in + 64, 256, p.wt_a, 64, T_TOK, 512, 64, EpiASig{p.asig, p.a0}, bid, nb, smem);
  gemm_phase<-1>(p.lora_in + 128, 256, p.wt_g, 128, T_TOK, 512, 128, EpiBf16{p.gbuf, 512}, bid, nb, smem);
  gsync(p.gbar, gb_lds, epoch);

  {
    RawIn raw;
    if (bid < 4096) chunk_load_raw(p, bid, TIDX, raw);
    for (int tile = bid; tile < 4096; tile += nb) rwkv_chunk_prep(p, tile, min(tile + nb, 4095), raw, smem);
  }
  gsync(p.gbar, gb_lds, epoch);
  if (bid < 64) rwkv_state_pass(p, bid, smem);
  {
    float d1 = 0.f, d2 = 0.f;
    for (int i = 0; i < 64; ++i) { d1 += p.lam_q1[i] * p.lam_k1[i]; d2 += p.lam_q2[i] * p.lam_k2[i]; }
    const float lam = __expf(d1) - __expf(d2) + 0.2f;
    int* qidx = (int*)(smem_all + SMEM_BYTES - 16);
    for (;;) {
      __syncthreads();
      if (threadIdx.x == 0) *qidx = atomicAdd(p.counter, 1);
      __syncthreads();
      const int idx = *qidx;
      if (idx >= 1024) break;
      const int qc = 63 - (idx >> 4), bh = (idx & 15) * 2 + half, b = bh >> 2, h = bh & 3;
      const long tq = (long)b * 4096 + qc * 64;
      attn_tile<64, 128, 2, true, 64>(p.qkd + tq * 1024 + h * 128, 1024, p.qkd + (long)b * 4096 * 1024 + 512 + h * 128, 1024,
                                  p.vt + (long)(b * 512 + h * 128) * 4096, 4096, qc + 1, 0.125f,
                                  p.mix + tq * 1024 + 512 + h * 128, 1024, lam, p.subln_w, smem, half);
    }
  }
  gsync(p.gbar, gb_lds, epoch);

  big_gemm(smem_all, p.mix, p.wt_out, T_TOK, 1024, 1024, pg8::EpiResNormP<false, false, true>{p.out, p.x, p.xn, p.ss1});
  gsync(p.gbar, gb_lds, epoch);
  big_gemm(smem_all, p.xn, p.wt_mq, T_TOK, 1024, 1024, pg8::EpiBf16NormP<0>{p.qmem, 1024, p.ss1});
  gsync(p.gbar, gb_lds, epoch);
  for (int idx = bid; idx < 2048; idx += nb) {
    const int tt = idx >> 2, h = idx & 3;
    const long t0 = (long)tt * 64;
    const int b = (int)(t0 >> 12);
    attn_tile<256, 256, 1, false, 32>(p.qmem + t0 * 1024 + h * 256, 1024, p.kmem + (long)b * 256 * 1024 + h * 256, 1024,
                                  p.vtmem + (long)(b * 1024 + h * 256) * 256, 256, 8, 0.0625f,
                                  p.mix + t0 * 1024 + h * 256, 1024, 0.f, p.subln_w, smem, half);
  }
  gsync(p.gbar, gb_lds, epoch);
  big_gemm(smem_all, p.mix, p.wt_mo, T_TOK, 1024, 1024, pg8::EpiResNormP<true, false, true>{p.out, p.xn, p.xn, p.ss2});
  gsync(p.gbar, gb_lds, epoch);
  big_gemm(smem_all, p.xn, p.wt_up, T_TOK, 4096, 1024, pg8::EpiBf16NormP<1>{p.hid, 4096, p.ss2});
  gsync(p.gbar, gb_lds, epoch);
  big_gemm(smem_all, p.hid, p.wt_down, T_TOK, 1024, 4096, pg8::EpiResNormP<true, false, true>{p.out, p.xn, p.xn, p.ss3});
  gsync(p.gbar, gb_lds, epoch);
  {
    const long total = (long)T_TOK * 128;
    for (long idx = (long)blockIdx.x * 512 + threadIdx.x; idx < total; idx += (long)gridDim.x * 512) {
      const int row = (int)(idx >> 7), c = (int)(idx & 127) * 8;
      float v[8];
      unpack8(*(const uint4*)(p.xn + (long)row * 1024 + c), v);
      const float rs = rsqrtf(p.ss3[row] * (1.f / 1024.f) + 1e-5f);
      const float4 w0 = *(const float4*)(p.norm_final_w + c), w1 = *(const float4*)(p.norm_final_w + c + 4);
      float* o = p.out + (long)row * 1024 + c;
      *(float4*)(o) = make_float4(v[0] * rs * w0.x, v[1] * rs * w0.y, v[2] * rs * w0.z, v[3] * rs * w0.w);
      *(float4*)(o + 4) = make_float4(v[4] * rs * w1.x, v[5] * rs * w1.y, v[6] * rs * w1.z, v[7] * rs * w1.w);
    }
  }
}

extern "C" void kernel_launch(void* const* d_in, const int* in_sizes, int n_in, void* d_out, int out_size, void* d_ws,
                              size_t ws_size, hipStream_t stream) {
  static int grid_blocks = 0;
  if (!grid_blocks) {
    int dev = 0, cus = 0, per_cu = 0;
    hipGetDevice(&dev);
    hipDeviceGetAttribute(&cus, hipDeviceAttributeMultiprocessorCount, dev);
    hipOccupancyMaxActiveBlocksPerMultiprocessor(&per_cu, fwd_megakernel, 512, 0);
    if (per_cu > 1) per_cu = 1;
    if (per_cu < 1) per_cu = 1;
    grid_blocks = cus * per_cu;
  }
  Params p{};
  const float* const* in = (const float* const*)d_in;
  p.x = in[0]; p.mem = in[1]; p.norm_mix_w = in[2]; p.w_in = in[3]; p.mu = in[4]; p.w0 = in[5]; p.w_dec_up = in[6];
  p.a0 = in[7]; p.a_up = in[8]; p.g_up = in[9]; p.k_k = in[10]; p.k_a = in[11]; p.r_k = in[12]; p.lnx_w = in[13];
  p.lnx_b = in[14]; p.lam_q1 = in[15]; p.lam_k1 = in[16]; p.lam_q2 = in[17]; p.lam_k2 = in[18]; p.subln_w = in[19];
  p.w_out = in[20]; p.norm_mem_w = in[21]; p.norm_src_w = in[22]; p.w_mq = in[23]; p.w_mk = in[24]; p.w_mv = in[25];
  p.w_mo = in[26]; p.norm_mlp_w = in[27]; p.w_up = in[28]; p.w_down = in[29]; p.norm_final_w = in[30];
  p.out = (float*)d_out;
  char* ws = (char*)d_ws;
  u16* wbase = (u16*)ws;
  long o = 0;
  p.wt_in = wbase + o; o += 3328L * 1024;
  p.wt_out = wbase + o; o += 1024L * 1024;
  p.wt_mq = wbase + o; o += 1024L * 1024;
  p.wt_mk = wbase + o; o += 1024L * 1024;
  p.wt_mv = wbase + o; o += 1024L * 1024;
  p.wt_mo = wbase + o; o += 1024L * 1024;
  p.wt_up = wbase + o; o += 4096L * 1024;
  p.wt_down = wbase + o; o += 4096L * 1024;
  p.wt_dec = wbase + o; o += 512L * 64;
  p.wt_a = wbase + o; o += 512L * 64;
  p.wt_g = wbase + o; o += 512L * 128;
  p.xn = (u16*)(ws + 34 * MiB);
  char* big = ws + 98 * MiB;
  p.pr = (u16*)big;
  p.qkd = (u16*)(big + 112 * MiB);
  p.vt = (u16*)(big + 176 * MiB);
  p.vrm = (u16*)(big + 208 * MiB);
  p.hid = (u16*)big;
  p.mix = (u16*)(ws + 354 * MiB);
  p.qmem = (u16*)(ws + 418 * MiB);
  p.memn = (u16*)(ws + 482 * MiB);
  p.kmem = (u16*)(ws + 486 * MiB);
  p.vtmem = (u16*)(ws + 490 * MiB);
  p.lora_in = (u16*)(ws + 494 * MiB);
  p.e_buf = (float*)d_out;
  p.asig = (u16*)((char*)d_out + 64 * MiB);
  p.gbuf = (u16*)((char*)d_out + 96 * MiB);
  p.c_mp = p.xn; p.c_yh = p.xn + 4096L * 4096;
  p.c_nc = p.qmem; p.c_y0 = p.qmem + 4096L * 4096;
  p.counter = (int*)(ws + 511 * MiB);
  p.gbar = (unsigned*)(ws + 511 * MiB + 512 * 1024);
  hipMemsetAsync(p.gbar, 0, 16384, stream);
  p.ss1 = (float*)(ws + 511 * MiB + 65536); p.ss2 = p.ss1 + T_TOK; p.ss3 = p.ss2 + T_TOK;
  p.c_gc = (float*)p.lora_in;
  void* args[] = {&p};
  hipError_t e = hipLaunchCooperativeKernel((void*)fwd_megakernel, dim3(grid_blocks), dim3(512), args, 0, stream);
  if (e != hipSuccess) fprintf(stderr, "cooperative launch failed: %s (grid %d)\n", hipGetErrorString(e), grid_blocks);
}
```
